# Optimizing an MI355X kernel written in HIP

```python
import jax
import jax.numpy as jnp
from jax import lax
import numpy as np


D_MODEL = 1024
BATCH = 8
SEQ = 4096
DEPTH = 2

GRID_W = 64
CTX_LEN = 256
HEAD_DIM = 64
FOURIER_GROUPS = 4
FOURIER_GROUP_DIM = 64
FOURIER_WIDTH = FOURIER_GROUPS * FOURIER_GROUP_DIM
SWA_HEADS = 6
SWA_KV_HEADS = 2
SWA_Q_WIDTH = SWA_HEADS * HEAD_DIM
SWA_KV_WIDTH = SWA_KV_HEADS * HEAD_DIM
WINDOW = 128
BLOCK = 128
MLA_HEADS = 6
MLA_NOPE_DIM = 64
MLA_ROPE_DIM = 32
MLA_V_DIM = 64
MLA_Q_RANK = 256
MLA_KV_RANK = 128
MLA_SCALE = (MLA_NOPE_DIM + MLA_ROPE_DIM) ** -0.5
D_MIX = FOURIER_WIDTH + SWA_Q_WIDTH + MLA_HEADS * MLA_V_DIM
OFF_SWA_Q = FOURIER_WIDTH
OFF_SWA_K = OFF_SWA_Q + SWA_Q_WIDTH
OFF_SWA_V = OFF_SWA_K + SWA_KV_WIDTH
OFF_MLA_CQ = OFF_SWA_V + SWA_KV_WIDTH
OFF_MLA_CKV = OFF_MLA_CQ + MLA_Q_RANK
OFF_MLA_KR = OFF_MLA_CKV + MLA_KV_RANK
D_IN = OFF_MLA_KR + MLA_ROPE_DIM
IN_SPLITS = (OFF_SWA_Q, OFF_SWA_K, OFF_SWA_V, OFF_MLA_CQ, OFF_MLA_CKV, OFF_MLA_KR)
D_FF = 4 * D_MODEL
ROPE_THETA = 10000.0
NORM_EPS = 1e-6
NEG_INF = -1e30

kernel_name = 'hybrid_dit_fourier_swa_mla'


def rms_norm(x, g):
    xf = x.astype(jnp.float32)
    y = xf * lax.rsqrt(jnp.mean(xf * xf, axis=-1, keepdims=True) + NORM_EPS)
    return (y * g.astype(jnp.float32)).astype(x.dtype)


def modulate(h, shift, scale):
    return h * (1 + scale) + shift


def axial_rope_tables(rows, dim):
    r, col = jnp.meshgrid(jnp.arange(rows, dtype=jnp.float32), jnp.arange(GRID_W, dtype=jnp.float32), indexing='ij')
    r = r.reshape(-1)
    col = col.reshape(-1)
    n_freq = dim // 4
    inv_freq = ROPE_THETA ** (-jnp.arange(n_freq, dtype=jnp.float32) / n_freq)
    ang = jnp.concatenate([r[:, None] * inv_freq[None, :], col[:, None] * inv_freq[None, :]], axis=-1)
    return jnp.cos(ang), jnp.sin(ang)


def apply_rope(x, cos, sin):
    half = x.shape[-1] // 2
    xf = x.astype(jnp.float32)
    x1, x2 = xf[..., :half], xf[..., half:]
    c, s = cos[:, None, :], sin[:, None, :]
    return jnp.concatenate([x1 * c - x2 * s, x1 * s + x2 * c], axis=-1).astype(x.dtype)


def fourier_mix(f, w_f):
    B_, S_, _ = f.shape
    fg = f.reshape(B_, S_, FOURIER_GROUPS, FOURIER_GROUP_DIM).astype(jnp.float32)
    spec = jnp.fft.fft2(fg, axes=(1, 3), norm='ortho').real.astype(f.dtype)
    out = jnp.einsum('bsgc,gcd->bsgd', spec, w_f)
    return out.reshape(B_, S_, FOURIER_WIDTH)


def softmax_with_sink(logits, sink_kg):
    sk = jnp.broadcast_to(sink_kg.astype(jnp.float32)[:, :, None, None], logits.shape[:-1] + (1,))
    p = jax.nn.softmax(jnp.concatenate([logits, sk], axis=-1), axis=-1)
    return p[..., :-1]


def swa_latent(q, k, v, k_ctx, v_ctx, sink):
    B_, S_, H, d = q.shape
    G = H // SWA_KV_HEADS
    nb = S_ // BLOCK
    qb = q.reshape(B_, nb, BLOCK, SWA_KV_HEADS, G, d)
    pad = ((0, 0), (BLOCK, BLOCK), (0, 0), (0, 0))
    kp = jnp.pad(k, pad).reshape(B_, nb + 2, BLOCK, SWA_KV_HEADS, d)
    vp = jnp.pad(v, pad).reshape(B_, nb + 2, BLOCK, SWA_KV_HEADS, d)
    kb = jnp.concatenate([kp[:, :-2], kp[:, 1:-1], kp[:, 2:]], axis=2)
    vb = jnp.concatenate([vp[:, :-2], vp[:, 1:-1], vp[:, 2:]], axis=2)
    scale = d ** -0.5
    s_loc = jnp.einsum('bnqkgd,bnjkd->bnkgqj', qb, kb).astype(jnp.float32) * scale
    s_ctx = jnp.einsum('bnqkgd,bckd->bnkgqc', qb, k_ctx).astype(jnp.float32) * scale
    qpos = jnp.arange(nb)[:, None] * BLOCK + jnp.arange(BLOCK)[None, :]
    kpos = jnp.arange(nb)[:, None] * BLOCK - BLOCK + jnp.arange(3 * BLOCK)[None, :]
    rel = kpos[:, None, :] - qpos[:, :, None]
    valid = (jnp.abs(rel) <= WINDOW) & (kpos[:, None, :] >= 0) & (kpos[:, None, :] < S_)
    s_loc = jnp.where(valid[None, :, None, None, :, :], s_loc, NEG_INF)
    p = softmax_with_sink(jnp.concatenate([s_loc, s_ctx], axis=-1), sink.reshape(SWA_KV_HEADS, G)).astype(v.dtype)
    o = (jnp.einsum('bnkgqj,bnjkd->bnqkgd', p[..., :3 * BLOCK], vb)
         + jnp.einsum('bnkgqc,bckd->bnqkgd', p[..., 3 * BLOCK:], v_ctx))
    return o.reshape(B_, S_, H * d)


def swa_context(q, k, v, sink):
    B_, L, H, d = q.shape
    G = H // SWA_KV_HEADS
    qg = q.reshape(B_, L, SWA_KV_HEADS, G, d)
    s = jnp.einsum('bqkgd,bckd->bkgqc', qg, k).astype(jnp.float32) * (d ** -0.5)
    p = softmax_with_sink(s, sink.reshape(SWA_KV_HEADS, G)).astype(v.dtype)
    o = jnp.einsum('bkgqc,bckd->bqkgd', p, v)
    return o.reshape(B_, L, H * d)


def mla_queries(cq, q_norm, w_uq):
    B_, S_, _ = cq.shape
    q = (rms_norm(cq, q_norm) @ w_uq).reshape(B_, S_, MLA_HEADS, MLA_NOPE_DIM + MLA_ROPE_DIM)
    return q[..., :MLA_NOPE_DIM], q[..., MLA_NOPE_DIM:]


def mla_keys_values(ckv, kv_norm, w_ukv):
    B_, S_, _ = ckv.shape
    kv = (rms_norm(ckv, kv_norm) @ w_ukv).reshape(B_, S_, MLA_HEADS, MLA_NOPE_DIM + MLA_V_DIM)
    return kv[..., :MLA_NOPE_DIM], kv[..., MLA_NOPE_DIM:]


def mla_latent(qn, qr, kn, kr, v, kn_c, kr_c, v_c):
    B_, S_, H, _ = qn.shape
    nb = S_ // BLOCK

    def blocks(t):
        return t.reshape(B_, nb, BLOCK, *t.shape[2:]).swapaxes(0, 1)

    def one_block(qs):
        qn_i, qr_i = qs
        s_lat = jnp.einsum('bqhd,bkhd->bhqk', qn_i, kn) + jnp.einsum('bqhr,bkr->bhqk', qr_i, kr)
        s_ctx = jnp.einsum('bqhd,bchd->bhqc', qn_i, kn_c) + jnp.einsum('bqhr,bcr->bhqc', qr_i, kr_c)
        logits = jnp.concatenate([s_lat, s_ctx], axis=-1).astype(jnp.float32) * MLA_SCALE
        p = jax.nn.softmax(logits, axis=-1).astype(v.dtype)
        return (jnp.einsum('bhqk,bkhd->bqhd', p[..., :S_], v)
                + jnp.einsum('bhqc,bchd->bqhd', p[..., S_:], v_c))

    o = lax.map(one_block, (blocks(qn), blocks(qr)))
    return o.swapaxes(0, 1).reshape(B_, S_, H * MLA_V_DIM)


def mla_context(qn, qr, kn, kr, v):
    B_, L, H, _ = qn.shape
    s = jnp.einsum('bqhd,bkhd->bhqk', qn, kn) + jnp.einsum('bqhr,bkr->bhqk', qr, kr)
    p = jax.nn.softmax(s.astype(jnp.float32) * MLA_SCALE, axis=-1).astype(v.dtype)
    return jnp.einsum('bhqk,bkhd->bqhd', p, v).reshape(B_, L, H * MLA_V_DIM)


def squared_relu_mlp(h, w1, w2):
    return jnp.square(jax.nn.relu(h @ w1)) @ w2


def setup_inputs(seed: int = 0) -> dict:
    key = jax.random.key(seed)
    ks = jax.random.split(key, 20)

    def nrm(k, shape, scale):
        return jax.random.normal(k, shape, jnp.float32) * scale

    return {
        'x': nrm(ks[0], (BATCH, SEQ, D_MODEL), 1.0),
        'c': nrm(ks[1], (BATCH, D_MODEL), 1.0),
        'ctx': nrm(ks[2], (BATCH, CTX_LEN, D_MODEL), 1.0),
        'c_ctx': nrm(ks[3], (D_MODEL,), 1.0),
        'w_ada': nrm(ks[4], (DEPTH, D_MODEL, 6 * D_MODEL), 0.5 * D_MODEL ** -0.5),
        'b_ada': nrm(ks[5], (DEPTH, 6 * D_MODEL), 0.02),
        'norm1_g': 1.0 + nrm(ks[6], (DEPTH, D_MODEL), 0.05),
        'norm2_g': 1.0 + nrm(ks[7], (DEPTH, D_MODEL), 0.05),
        'w_in': nrm(ks[8], (DEPTH, D_MODEL, D_IN), D_MODEL ** -0.5),
        'w_fourier': nrm(ks[9], (DEPTH, FOURIER_GROUPS, FOURIER_GROUP_DIM, FOURIER_GROUP_DIM), FOURIER_GROUP_DIM ** -0.5),
        'swa_sink': nrm(ks[10], (DEPTH, SWA_HEADS), 0.5),
        'mla_q_norm': 1.0 + nrm(ks[11], (DEPTH, MLA_Q_RANK), 0.05),
        'w_uq': nrm(ks[12], (DEPTH, MLA_Q_RANK, MLA_HEADS * (MLA_NOPE_DIM + MLA_ROPE_DIM)), MLA_Q_RANK ** -0.5),
        'mla_kv_norm': 1.0 + nrm(ks[13], (DEPTH, MLA_KV_RANK), 0.05),
        'w_ukv': nrm(ks[14], (DEPTH, MLA_KV_RANK, MLA_HEADS * (MLA_NOPE_DIM + MLA_V_DIM)), MLA_KV_RANK ** -0.5),
        'w_out': nrm(ks[15], (DEPTH, D_MIX, D_MODEL), D_MIX ** -0.5),
        'w_mlp1': nrm(ks[16], (DEPTH, D_MODEL, D_FF), D_MODEL ** -0.5),
        'w_mlp2': nrm(ks[17], (DEPTH, D_FF, D_MODEL), D_FF ** -0.5),
        'final_norm_g': 1.0 + nrm(ks[18], (D_MODEL,), 0.05),
    }


def reference(x, c, ctx, c_ctx, w_ada, b_ada, norm1_g, norm2_g, w_in, w_fourier, swa_sink,
              mla_q_norm, w_uq, mla_kv_norm, w_ukv, w_out, w_mlp1, w_mlp2, final_norm_g):
    B_, S_, _ = x.shape
    L = ctx.shape[1]
    rows = S_ // GRID_W
    cos_h, sin_h = axial_rope_tables(rows, HEAD_DIM)
    cos_r, sin_r = axial_rope_tables(rows, MLA_ROPE_DIM)
    silu_c = jax.nn.silu(c)
    silu_cc = jax.nn.silu(c_ctx)[None, :]
    h, hc = x, ctx
    for l in range(DEPTH):
        last = l == DEPTH - 1
        mod = (silu_c @ w_ada[l] + b_ada[l])[:, None, :]
        mod_c = (silu_cc @ w_ada[l] + b_ada[l])[:, None, :]
        sh1, sc1, g1, sh2, sc2, g2 = jnp.split(mod, 6, axis=-1)
        csh1, csc1, cg1, csh2, csc2, cg2 = jnp.split(mod_c, 6, axis=-1)

        u = modulate(rms_norm(h, norm1_g[l]), sh1, sc1) @ w_in[l]
        uc = modulate(rms_norm(hc, norm1_g[l]), csh1, csc1) @ w_in[l]
        f, q, k, v, cq, ckv, kr = jnp.split(u, IN_SPLITS, axis=-1)
        fc, qc, kc, vc, cqc, ckvc, krc = jnp.split(uc, IN_SPLITS, axis=-1)

        q = apply_rope(q.reshape(B_, S_, SWA_HEADS, HEAD_DIM), cos_h, sin_h)
        k = apply_rope(k.reshape(B_, S_, SWA_KV_HEADS, HEAD_DIM), cos_h, sin_h)
        v = v.reshape(B_, S_, SWA_KV_HEADS, HEAD_DIM)
        kc = kc.reshape(B_, L, SWA_KV_HEADS, HEAD_DIM)
        vc = vc.reshape(B_, L, SWA_KV_HEADS, HEAD_DIM)
        swa_out = swa_latent(q, k, v, kc, vc, swa_sink[l])

        qn, qr = mla_queries(cq, mla_q_norm[l], w_uq[l])
        qr = apply_rope(qr, cos_r, sin_r)
        kn, mv = mla_keys_values(ckv, mla_kv_norm[l], w_ukv[l])
        kr = apply_rope(kr[:, :, None, :], cos_r, sin_r)[:, :, 0, :]
        knc, mvc = mla_keys_values(ckvc, mla_kv_norm[l], w_ukv[l])
        mla_out = mla_latent(qn, qr, kn, kr, mv, knc, krc, mvc)

        mix = jnp.concatenate([fourier_mix(f, w_fourier[l]), swa_out, mla_out], axis=-1) @ w_out[l]
        h = h + g1 * mix
        h = h + g2 * squared_relu_mlp(modulate(rms_norm(h, norm2_g[l]), sh2, sc2), w_mlp1[l], w_mlp2[l])

        if not last:
            qc = qc.reshape(B_, L, SWA_HEADS, HEAD_DIM)
            qnc, qrc = mla_queries(cqc, mla_q_norm[l], w_uq[l])
            mix_c = jnp.concatenate([fourier_mix(fc, w_fourier[l]),
                                     swa_context(qc, kc, vc, swa_sink[l]),
                                     mla_context(qnc, qrc, knc, krc, mvc)], axis=-1) @ w_out[l]
            hc = hc + cg1 * mix_c
            hc = hc + cg2 * squared_relu_mlp(modulate(rms_norm(hc, norm2_g[l]), csh2, csc2), w_mlp1[l], w_mlp2[l])
    return rms_norm(h, final_norm_g)
```

```cpp
#include <hip/hip_runtime.h>
#include <hip/hip_cooperative_groups.h>
#include <stdint.h>
#include <stdio.h>
namespace cg = cooperative_groups;

#ifndef MEGA
#define MEGA 0
#endif

typedef unsigned short bf16_t;
constexpr int D = 1024, NB = 8, S = 4096, L = 256, DEPTH = 2;
constexpr int ML = NB * S, MC = NB * L, MT = ML + MC;
constexpr int DIN = 1312, DFF = 4096;
constexpr int OFF_Q = 256, OFF_K = 640, OFF_V = 768, OFF_CQ = 896, OFF_CKV = 1152, OFF_KR = 1280;
constexpr int QMW = 576, KVW = 768;
constexpr float EPS = 1e-6f;
constexpr float MLA_SCALE = 0.10206207261596577f;

constexpr size_t MiB = 1u << 20;
constexpr size_t O_MOD = 0, O_TAB = 1 * MiB, O_WF = 3 * MiB, O_RSTD = 4 * MiB, O_HC = 5 * MiB;
constexpr size_t O_U = 16 * MiB, O_QM = 104 * MiB, O_KVM = 143 * MiB, O_MIX = 194 * MiB, O_FC = 262 * MiB, O_FS = 296 * MiB, O_HID = 16 * MiB;
constexpr size_t WS_NEED = 330 * MiB;

struct P {
    const float *x, *c, *ctx, *c_ctx, *w_ada, *b_ada, *n1g, *n2g, *w_in, *w_f, *sink, *qn_g, *w_uq, *kvn_g, *w_ukv, *w_out, *w_mlp1, *w_mlp2, *fin_g;
    float* out;
    unsigned char* ws;
};

__device__ __forceinline__ float bf2f(bf16_t v) { return __uint_as_float(((unsigned)v) << 16); }
__device__ __forceinline__ bf16_t f2bf(float f) { unsigned u = __float_as_uint(f); u += 0x7fffu + ((u >> 16) & 1u); return (bf16_t)(u >> 16); }

__device__ __forceinline__ float* ws_mod(const P& p) { return (float*)(p.ws + O_MOD); }
__device__ __forceinline__ float* ws_cosT(const P& p) { return (float*)(p.ws + O_TAB); }
__device__ __forceinline__ float* ws_sinT(const P& p) { return (float*)(p.ws + O_TAB) + 4096; }
__device__ __forceinline__ float* ws_cosh(const P& p) { return (float*)(p.ws + O_TAB) + 8192; }
__device__ __forceinline__ float* ws_sinh(const P& p) { return ws_cosh(p) + 4096 * 32; }
__device__ __forceinline__ float* ws_cosr(const P& p) { return ws_sinh(p) + 4096 * 32; }
__device__ __forceinline__ float* ws_sinr(const P& p) { return ws_cosr(p) + 4096 * 16; }
__device__ __forceinline__ float* ws_wc(const P& p) { return (float*)(p.ws + O_WF); }
__device__ __forceinline__ float* ws_wsn(const P& p) { return (float*)(p.ws + O_WF) + 2 * 4 * 64 * 64; }
__device__ __forceinline__ float* ws_rstd(const P& p) { return (float*)(p.ws + O_RSTD); }
__device__ __forceinline__ float* ws_rcq(const P& p) { return ws_rstd(p) + MT; }
__device__ __forceinline__ float* ws_rckv(const P& p) { return ws_rstd(p) + 2 * MT; }
__device__ __forceinline__ float* ws_hc(const P& p) { return (float*)(p.ws + O_HC); }
__device__ __forceinline__ bf16_t* ws_u(const P& p) { return (bf16_t*)(p.ws + O_U); }
__device__ __forceinline__ bf16_t* ws_qm(const P& p) { return (bf16_t*)(p.ws + O_QM); }
__device__ __forceinline__ bf16_t* ws_kvm(const P& p) { return (bf16_t*)(p.ws + O_KVM); }
__device__ __forceinline__ bf16_t* ws_mix(const P& p) { return (bf16_t*)(p.ws + O_MIX); }
__device__ __forceinline__ float* ws_fc(const P& p) { return (float*)(p.ws + O_FC); }
__device__ __forceinline__ float* ws_fs(const P& p) { return (float*)(p.ws + O_FS); }
__device__ __forceinline__ bf16_t* ws_hid(const P& p) { return (bf16_t*)(p.ws + O_HID); }

__device__ __forceinline__ int modrow(int row) { return row < ML ? (row >> 12) : 8; }
__device__ __forceinline__ const float* hrow_in(const P& p, int l, int row) {
    if (row < ML) return (l == 0 ? p.x : p.out) + (size_t)row * D;
    return (l == 0 ? p.ctx : ws_hc(p)) + (size_t)(row - ML) * D;
}
__device__ __forceinline__ float* hrow_mid(const P& p, int row) {
    if (row < ML) return p.out + (size_t)row * D;
    return ws_hc(p) + (size_t)(row - ML) * D;
}
__device__ __forceinline__ float wave_sum(float v) {
#pragma unroll
    for (int o = 1; o < 64; o <<= 1) v += __shfl_xor(v, o);
    return v;
}

template <class AF, class BF, class EF>
__device__ __forceinline__ void gemm_naive(int M0, int M1, int N, int K, AF af, BF bf, EF ef, int bid, int nb, float* sm) {
    float* As = sm;
    float* Bs = sm + 16 * 68;
    const int tid = threadIdx.x, tx = tid & 15, ty = tid >> 4;
    const int ntn = (N + 63) / 64, ntm = (M1 - M0) / 64;
    for (int t = bid; t < ntm * ntn; t += nb) {
        const int tm = t / ntn, tn = t % ntn;
        const int row0 = M0 + tm * 64, col0 = tn * 64;
        float acc[4][4];
#pragma unroll
        for (int i = 0; i < 4; ++i)
#pragma unroll
            for (int j = 0; j < 4; ++j) acc[i][j] = 0.f;
        for (int k0 = 0; k0 < K; k0 += 16) {
#pragma unroll
            for (int i = 0; i < 4; ++i) {
                const int e = tid + i * 256, r = e >> 4, kk = e & 15;
                As[kk * 68 + r] = af(row0 + r, k0 + kk);
            }
#pragma unroll
            for (int i = 0; i < 4; ++i) {
                const int e = tid + i * 256, kk = e >> 6, n = e & 63;
                Bs[kk * 68 + n] = (col0 + n < N) ? bf(k0 + kk, col0 + n) : 0.f;
            }
            __syncthreads();
#pragma unroll
            for (int kk = 0; kk < 16; ++kk) {
                float a[4], b[4];
#pragma unroll
                for (int i = 0; i < 4; ++i) a[i] = As[kk * 68 + ty * 4 + i];
#pragma unroll
                for (int j = 0; j < 4; ++j) b[j] = Bs[kk * 68 + tx * 4 + j];
#pragma unroll
                for (int i = 0; i < 4; ++i)
#pragma unroll
                    for (int j = 0; j < 4; ++j) acc[i][j] += a[i] * b[j];
            }
            __syncthreads();
        }
#pragma unroll
        for (int i = 0; i < 4; ++i)
#pragma unroll
            for (int j = 0; j < 4; ++j)
                if (col0 + tx * 4 + j < N) ef(row0 + ty * 4 + i, col0 + tx * 4 + j, acc[i][j]);
    }
}

__device__ void ph_prep(const P& p, int bid, int nb, float* sm) {
    const int tid = threadIdx.x, gtid = bid * 256 + tid, gn = nb * 256;
    for (int i = gtid; i < 4096; i += gn) {
        float sn, cs; sincospif((float)i * (1.0f / 2048.0f), &sn, &cs);
        ws_cosT(p)[i] = cs; ws_sinT(p)[i] = sn;
    }
    for (int idx = gtid; idx < 4096 * 32; idx += gn) {
        const int s = idx >> 5, j = idx & 31;
        const int pos = (j < 16) ? (s >> 6) : (s & 63), f = j & 15;
        const float inv = powf(10000.0f, -(float)f / 16.0f), ang = (float)pos * inv;
        ws_cosh(p)[idx] = cosf(ang); ws_sinh(p)[idx] = sinf(ang);
    }
    for (int idx = gtid; idx < 4096 * 16; idx += gn) {
        const int s = idx >> 4, j = idx & 15;
        const int pos = (j < 8) ? (s >> 6) : (s & 63), f = j & 7;
        const float inv = powf(10000.0f, -(float)f / 8.0f), ang = (float)pos * inv;
        ws_cosr(p)[idx] = cosf(ang); ws_sinr(p)[idx] = sinf(ang);
    }
    for (int idx = gtid; idx < 2 * 4 * 64 * 64; idx += gn) {
        const int d = idx & 63, c = (idx >> 6) & 63, lg = idx >> 12;
        float ac = 0.f, as = 0.f;
        for (int c2 = 0; c2 < 64; ++c2) {
            float sn, cs; sincospif((float)((c * c2) & 63) * (1.0f / 32.0f), &sn, &cs);
            const float w = p.w_f[(size_t)(lg * 64 + c2) * 64 + d];
            ac += cs * w; as += sn * w;
        }
        ws_wc(p)[idx] = ac; ws_wsn(p)[idx] = as;
    }
    for (int vb = bid; vb < 48; vb += nb) {
        __syncthreads();
        for (int i = tid; i < 9 * 1024; i += 256) {
            const int r = i >> 10, k = i & 1023;
            const float v = (r < 8) ? p.c[r * 1024 + k] : p.c_ctx[k];
            sm[i] = v / (1.0f + expf(-v));
        }
        __syncthreads();
        const int n = vb * 256 + tid, l = n / 6144, nn = n % 6144;
        float acc[9];
#pragma unroll
        for (int r = 0; r < 9; ++r) acc[r] = 0.f;
        for (int k = 0; k < 1024; ++k) {
            const float w = p.w_ada[((size_t)l * 1024 + k) * 6144 + nn];
#pragma unroll
            for (int r = 0; r < 9; ++r) acc[r] += sm[r * 1024 + k] * w;
        }
        const float bb = p.b_ada[l * 6144 + nn];
#pragma unroll
        for (int r = 0; r < 9; ++r) ws_mod(p)[(size_t)(l * 9 + r) * 6144 + nn] = acc[r] + bb;
    }
}

__device__ void ph_rowstat(const P& p, int l, int which, int nrows, int bid, int nb) {
    const int lane = threadIdx.x & 63, gw = bid * 4 + (threadIdx.x >> 6), nw = nb * 4;
    for (int row = gw; row < nrows; row += nw) {
        const float* h = which == 0 ? hrow_in(p, l, row) : hrow_mid(p, row);
        float ss = 0.f;
#pragma unroll
        for (int j = 0; j < 4; ++j) { const float4 v = ((const float4*)h)[lane + 64 * j]; ss += v.x * v.x + v.y * v.y + v.z * v.z + v.w * v.w; }
        ss = wave_sum(ss);
        if (lane == 0) ws_rstd(p)[row] = 1.0f / sqrtf(ss * (1.0f / 1024.0f) + EPS);
    }
}

__device__ void ph_inproj(const P& p, int l, int bid, int nb, float* sm) {
    const float* rstd = ws_rstd(p); const float* g = p.n1g + l * 1024; bf16_t* U = ws_u(p);
    auto af = [&](int row, int k) -> float {
        const float* mod = ws_mod(p) + (size_t)(l * 9 + modrow(row)) * 6144;
        const float v = hrow_in(p, l, row)[k] * rstd[row] * g[k];
        return v * (1.0f + mod[1024 + k]) + mod[k];
    };
    auto bf = [&](int k, int n) -> float { return p.w_in[((size_t)l * 1024 + k) * DIN + n]; };
    auto ef = [&](int row, int col, float a) { U[(size_t)row * DIN + col] = f2bf(a); };
    gemm_naive(0, MT, DIN, 1024, af, bf, ef, bid, nb, sm);
}

__device__ void ph_post_u(const P& p, int bid, int nb) {
    const int lane = threadIdx.x & 63, gw = bid * 4 + (threadIdx.x >> 6), nw = nb * 4;
    bf16_t* U = ws_u(p);
    for (int row = gw; row < MT; row += nw) {
        bf16_t* u = U + (size_t)row * DIN;
        if (row < ML) {
            const int s = row & 4095;
            const float* ch = ws_cosh(p) + s * 32; const float* sh = ws_sinh(p) + s * 32;
#pragma unroll
            for (int j = 0; j < 4; ++j) {
                const int pi = lane + 64 * j, hh = pi >> 5, i = pi & 31;
                bf16_t* q = u + OFF_Q + hh * 64;
                const float x1 = bf2f(q[i]), x2 = bf2f(q[i + 32]), c = ch[i], sn = sh[i];
                q[i] = f2bf(x1 * c - x2 * sn); q[i + 32] = f2bf(x1 * sn + x2 * c);
            }
            if (lane < 16) {
                bf16_t* q = u + OFF_KR;
                const float x1 = bf2f(q[lane]), x2 = bf2f(q[lane + 16]), c = ws_cosr(p)[s * 16 + lane], sn = ws_sinr(p)[s * 16 + lane];
                q[lane] = f2bf(x1 * c - x2 * sn); q[lane + 16] = f2bf(x1 * sn + x2 * c);
            }
        }
        float s1 = 0.f, s2 = 0.f;
#pragma unroll
        for (int j = 0; j < 4; ++j) { const float v = bf2f(u[OFF_CQ + lane + 64 * j]); s1 += v * v; }
#pragma unroll
        for (int j = 0; j < 2; ++j) { const float v = bf2f(u[OFF_CKV + lane + 64 * j]); s2 += v * v; }
        s1 = wave_sum(s1); s2 = wave_sum(s2);
        if (lane == 0) { ws_rcq(p)[row] = 1.0f / sqrtf(s1 * (1.0f / 256.0f) + EPS); ws_rckv(p)[row] = 1.0f / sqrtf(s2 * (1.0f / 128.0f) + EPS); }
    }
}

__device__ void ph_fourier_local(const P& p, int l, int nrows, int bid, int nb) {
    const int tid = threadIdx.x, g = tid >> 6, d = tid & 63;
    const float* wc = ws_wc(p) + (size_t)(l * 4 + g) * 4096; const float* wsn = ws_wsn(p) + (size_t)(l * 4 + g) * 4096;
    for (int row = bid; row < nrows; row += nb) {
        const bf16_t* u = ws_u(p) + (size_t)row * DIN + g * 64;
        float ac = 0.f, as = 0.f;
        for (int c = 0; c < 64; ++c) { const float f = bf2f(u[c]); ac += f * wc[c * 64 + d]; as += f * wsn[c * 64 + d]; }
        ws_fc(p)[(size_t)row * 256 + tid] = ac; ws_fs(p)[(size_t)row * 256 + tid] = as;
    }
}

__device__ void ph_fourier_dft(const P& p, bool with_ctx, int bid, int nb) {
    const int tid = threadIdx.x;
    const float* cT = ws_cosT(p); const float* sT = ws_sinT(p);
    const int nvb = 8 * 512 + (with_ctx ? 8 * 32 : 0);
    for (int vb = bid; vb < nvb; vb += nb) {
        int rowbase, n, sp0, tstep; float scale;
        if (vb < 8 * 512) { const int b = vb >> 9; rowbase = b * 4096; n = 4096; sp0 = (vb & 511) * 8; tstep = 1; scale = 1.0f / 512.0f; }
        else { const int v2 = vb - 8 * 512, b = v2 >> 5; rowbase = ML + b * 256; n = 256; sp0 = (v2 & 31) * 8; tstep = 16; scale = 1.0f / 128.0f; }
        float acc[8];
#pragma unroll
        for (int j = 0; j < 8; ++j) acc[j] = 0.f;
        const float* fc = ws_fc(p) + (size_t)rowbase * 256 + tid; const float* fs = ws_fs(p) + (size_t)rowbase * 256 + tid;
        for (int s = 0; s < n; ++s) {
            const float a = fc[(size_t)s * 256], b = fs[(size_t)s * 256];
#pragma unroll
            for (int j = 0; j < 8; ++j) { const int k = ((s * (sp0 + j)) & (n - 1)) * tstep; acc[j] += cT[k] * a - sT[k] * b; }
        }
#pragma unroll
        for (int j = 0; j < 8; ++j) ws_mix(p)[(size_t)(rowbase + sp0 + j) * 1024 + tid] = f2bf(acc[j] * scale);
    }
}

__device__ void ph_mla_up(const P& p, int l, int qrows, int bid, int nb, float* sm) {
    const bf16_t* U = ws_u(p);
    {
        const float* rs = ws_rcq(p); const float* g = p.qn_g + l * 256; bf16_t* QM = ws_qm(p);
        auto af = [&](int row, int k) -> float { return bf2f(U[(size_t)row * DIN + OFF_CQ + k]) * rs[row] * g[k]; };
        auto bf = [&](int k, int n) -> float { return p.w_uq[((size_t)l * 256 + k) * QMW + n]; };
        auto ef = [&](int row, int col, float a) { QM[(size_t)row * QMW + col] = f2bf(a); };
        gemm_naive(0, qrows, QMW, 256, af, bf, ef, bid, nb, sm);
    }
    {
        const float* rs = ws_rckv(p); const float* g = p.kvn_g + l * 128; bf16_t* KV = ws_kvm(p);
        auto af = [&](int row, int k) -> float { return bf2f(U[(size_t)row * DIN + OFF_CKV + k]) * rs[row] * g[k]; };
        auto bf = [&](int k, int n) -> float { return p.w_ukv[((size_t)l * 128 + k) * KVW + n]; };
        auto ef = [&](int row, int col, float a) { KV[(size_t)row * KVW + col] = f2bf(a); };
        gemm_naive(0, MT, KVW, 128, af, bf, ef, bid, nb, sm);
    }
}

__device__ void ph_swa(const P& p, int l, bool with_ctx, int bid, int nb) {
    const int tid = threadIdx.x;
    const bf16_t* U = ws_u(p); bf16_t* MIX = ws_mix(p);
    const int nvb = 8 * 6 * 16 + (with_ctx ? 8 * 6 : 0);
    for (int vb = bid; vb < nvb; vb += nb) {
        int b, h, s, row; bool isctx;
        if (vb < 768) { isctx = false; b = vb / 96; const int r = vb % 96; h = r / 16; s = (r % 16) * 256 + tid; row = b * 4096 + s; }
        else { isctx = true; const int v2 = vb - 768; b = v2 / 6; h = v2 % 6; s = tid; row = ML + b * 256 + s; }
        const int kvh = h / 3;
        float q[64], o[64];
        { const bf16_t* qp = U + (size_t)row * DIN + OFF_Q + h * 64;
#pragma unroll
          for (int d = 0; d < 64; ++d) { q[d] = bf2f(qp[d]) * 0.125f; o[d] = 0.f; } }
        float m = p.sink[l * 6 + h], lsum = 1.0f;
        const int j0 = isctx ? 0 : max(0, s - 128), j1 = isctx ? -1 : min(S - 1, s + 128);
        const int nloc = j1 - j0 + 1;
        for (int it = 0; it < nloc + 256; ++it) {
            const int krow = it < nloc ? (b * 4096 + j0 + it) : (ML + b * 256 + (it - nloc));
            const uint4* kp = (const uint4*)(U + (size_t)krow * DIN + OFF_K + kvh * 64);
            const uint4* vp = (const uint4*)(U + (size_t)krow * DIN + OFF_V + kvh * 64);
            float sc = 0.f;
#pragma unroll
            for (int c8 = 0; c8 < 8; ++c8) {
                const uint4 w = kp[c8]; const unsigned ww[4] = {w.x, w.y, w.z, w.w};
#pragma unroll
                for (int e = 0; e < 4; ++e) { sc += q[c8 * 8 + 2 * e] * __uint_as_float(ww[e] << 16); sc += q[c8 * 8 + 2 * e + 1] * __uint_as_float(ww[e] & 0xffff0000u); }
            }
            const float mn = fmaxf(m, sc), alpha = __expf(m - mn), pp = __expf(sc - mn);
            lsum = lsum * alpha + pp;
#pragma unroll
            for (int c8 = 0; c8 < 8; ++c8) {
                const uint4 w = vp[c8]; const unsigned ww[4] = {w.x, w.y, w.z, w.w};
#pragma unroll
                for (int e = 0; e < 4; ++e) {
                    o[c8 * 8 + 2 * e] = o[c8 * 8 + 2 * e] * alpha + pp * __uint_as_float(ww[e] << 16);
                    o[c8 * 8 + 2 * e + 1] = o[c8 * 8 + 2 * e + 1] * alpha + pp * __uint_as_float(ww[e] & 0xffff0000u);
                }
            }
            m = mn;
        }
        const float inv = 1.0f / lsum;
        bf16_t* op = MIX + (size_t)row * 1024 + 256 + h * 64;
#pragma unroll
        for (int d = 0; d < 64; ++d) op[d] = f2bf(o[d] * inv);
    }
}

__device__ void ph_mla(const P& p, bool with_ctx, int bid, int nb, float* sm) {
    const int tid = threadIdx.x;
    const bf16_t* U = ws_u(p); const bf16_t* QM = ws_qm(p); const bf16_t* KV = ws_kvm(p); bf16_t* MIX = ws_mix(p);
    const int nvb = 8 * 6 * 16 + (with_ctx ? 8 * 6 : 0);
    for (int vb = bid; vb < nvb; vb += nb) {
        int b, h, s, row; bool isctx;
        if (vb < 768) { isctx = false; b = vb / 96; const int r = vb % 96; h = r / 16; s = (r % 16) * 256 + tid; row = b * 4096 + s; }
        else { isctx = true; const int v2 = vb - 768; b = v2 / 6; h = v2 % 6; s = tid; row = ML + b * 256 + s; }
        float q[96], o[64];
        { const bf16_t* qp = QM + (size_t)row * QMW + h * 96;
#pragma unroll
          for (int d = 0; d < 96; ++d) q[d] = bf2f(qp[d]);
          if (!isctx) {
#pragma unroll
              for (int i = 0; i < 16; ++i) {
                  const float c = ws_cosr(p)[s * 16 + i], sn = ws_sinr(p)[s * 16 + i], x1 = q[64 + i], x2 = q[80 + i];
                  q[64 + i] = x1 * c - x2 * sn; q[80 + i] = x1 * sn + x2 * c;
              }
          }
#pragma unroll
          for (int d = 0; d < 96; ++d) q[d] *= MLA_SCALE;
#pragma unroll
          for (int d = 0; d < 64; ++d) o[d] = 0.f; }
        float m = -1e30f, lsum = 0.f;
        const int nkeys = isctx ? 256 : 4096 + 256;
        for (int k0 = 0; k0 < nkeys; k0 += 32) {
            __syncthreads();
            for (int e = tid; e < 32 * 160; e += 256) {
                const int j = e / 160, d = e % 160;
                const int kk = k0 + j;
                const int krow = isctx ? (ML + b * 256 + kk) : (kk < 4096 ? b * 4096 + kk : ML + b * 256 + (kk - 4096));
                float v;
                if (d < 64) v = bf2f(KV[(size_t)krow * KVW + h * 128 + d]);
                else if (d < 96) v = bf2f(U[(size_t)krow * DIN + OFF_KR + (d - 64)]);
                else v = bf2f(KV[(size_t)krow * KVW + h * 128 + 64 + (d - 96)]);
                sm[e] = v;
            }
            __syncthreads();
            for (int j = 0; j < 32; ++j) {
                const float* kt = sm + j * 160;
                float sc = 0.f;
#pragma unroll
                for (int d = 0; d < 96; ++d) sc += q[d] * kt[d];
                const float mn = fmaxf(m, sc), alpha = __expf(m - mn), pp = __expf(sc - mn);
                lsum = lsum * alpha + pp;
#pragma unroll
                for (int d = 0; d < 64; ++d) o[d] = o[d] * alpha + pp * kt[96 + d];
                m = mn;
            }
        }
        const float inv = 1.0f / lsum;
        bf16_t* op = MIX + (size_t)row * 1024 + 640 + h * 64;
#pragma unroll
        for (int d = 0; d < 64; ++d) op[d] = f2bf(o[d] * inv);
    }
}

__device__ void ph_outproj(const P& p, int l, int nrows, int bid, int nb, float* sm) {
    const bf16_t* MIX = ws_mix(p);
    auto af = [&](int row, int k) -> float { return bf2f(MIX[(size_t)row * 1024 + k]); };
    auto bf = [&](int k, int n) -> float { return p.w_out[((size_t)l * 1024 + k) * 1024 + n]; };
    auto ef = [&](int row, int col, float a) {
        const float g1 = ws_mod(p)[(size_t)(l * 9 + modrow(row)) * 6144 + 2048 + col];
        hrow_mid(p, row)[col] = hrow_in(p, l, row)[col] + g1 * a;
    };
    gemm_naive(0, nrows, 1024, 1024, af, bf, ef, bid, nb, sm);
}

__device__ void ph_mlp1(const P& p, int l, int nrows, int bid, int nb, float* sm) {
    const float* rstd = ws_rstd(p); const float* g = p.n2g + l * 1024; bf16_t* H = ws_hid(p);
    auto af = [&](int row, int k) -> float {
        const float* mod = ws_mod(p) + (size_t)(l * 9 + modrow(row)) * 6144;
        const float v = hrow_mid(p, row)[k] * rstd[row] * g[k];
        return v * (1.0f + mod[4096 + k]) + mod[3072 + k];
    };
    auto bf = [&](int k, int n) -> float { return p.w_mlp1[((size_t)l * 1024 + k) * DFF + n]; };
    auto ef = [&](int row, int col, float a) { const float t = fmaxf(a, 0.f); H[(size_t)row * DFF + col] = f2bf(t * t); };
    gemm_naive(0, nrows, DFF, 1024, af, bf, ef, bid, nb, sm);
}

__device__ void ph_mlp2(const P& p, int l, int nrows, int bid, int nb, float* sm) {
    const bf16_t* H = ws_hid(p);
    auto af = [&](int row, int k) -> float { return bf2f(H[(size_t)row * DFF + k]); };
    auto bf = [&](int k, int n) -> float { return p.w_mlp2[((size_t)l * DFF + k) * 1024 + n]; };
    auto ef = [&](int row, int col, float a) {
        const float g2 = ws_mod(p)[(size_t)(l * 9 + modrow(row)) * 6144 + 5120 + col];
        float* h = hrow_mid(p, row); h[col] = h[col] + g2 * a;
    };
    gemm_naive(0, nrows, 1024, DFF, af, bf, ef, bid, nb, sm);
}

__device__ void ph_final(const P& p, int bid, int nb) {
    const int lane = threadIdx.x & 63, gw = bid * 4 + (threadIdx.x >> 6), nw = nb * 4;
    for (int row = gw; row < ML; row += nw) {
        float4* h = (float4*)(p.out + (size_t)row * D);
        float4 v[4]; float ss = 0.f;
#pragma unroll
        for (int j = 0; j < 4; ++j) { v[j] = h[lane + 64 * j]; ss += v[j].x * v[j].x + v[j].y * v[j].y + v[j].z * v[j].z + v[j].w * v[j].w; }
        ss = wave_sum(ss);
        const float r = 1.0f / sqrtf(ss * (1.0f / 1024.0f) + EPS);
#pragma unroll
        for (int j = 0; j < 4; ++j) {
            const float4 g = ((const float4*)p.fin_g)[lane + 64 * j];
            h[lane + 64 * j] = make_float4(v[j].x * r * g.x, v[j].y * r * g.y, v[j].z * r * g.z, v[j].w * r * g.w);
        }
    }
}

constexpr int NPH = 9;
__device__ __forceinline__ void run_phase(const P& p, int l, int ph, int bid, int nb, float* sm) {
    const bool last = (l == DEPTH - 1);
    const int nrows = last ? ML : MT;
    switch (ph) {
        case 0: ph_rowstat(p, l, 0, MT, bid, nb); break;
        case 1: ph_inproj(p, l, bid, nb, sm); break;
        case 2: ph_post_u(p, bid, nb); ph_fourier_local(p, l, nrows, bid, nb); break;
        case 3: ph_mla_up(p, l, nrows, bid, nb, sm); ph_fourier_dft(p, !last, bid, nb); break;
        case 4: ph_swa(p, l, !last, bid, nb); ph_mla(p, !last, bid, nb, sm); break;
        case 5: ph_outproj(p, l, nrows, bid, nb, sm); break;
        case 6: ph_rowstat(p, l, 1, nrows, bid, nb); break;
        case 7: ph_mlp1(p, l, nrows, bid, nb, sm); break;
        case 8: ph_mlp2(p, l, nrows, bid, nb, sm); break;
    }
}

constexpr int SM_FLOATS = 9 * 1024;

#if MEGA
__global__ void __launch_bounds__(256) mega_kernel(P p) {
    __shared__ float sm[SM_FLOATS];
    cg::grid_group grid = cg::this_grid();
    const int bid = blockIdx.x, nb = gridDim.x;
    ph_prep(p, bid, nb, sm);
    grid.sync();
    for (int l = 0; l < DEPTH; ++l)
        for (int ph = 0; ph < NPH; ++ph) { run_phase(p, l, ph, bid, nb, sm); grid.sync(); }
    ph_final(p, bid, nb);
}
#else
__global__ void __launch_bounds__(256) k_prep(P p) { __shared__ float sm[SM_FLOATS]; ph_prep(p, blockIdx.x, gridDim.x, sm); }
__global__ void __launch_bounds__(256) k_phase(P p, int l, int ph) { __shared__ float sm[SM_FLOATS]; run_phase(p, l, ph, blockIdx.x, gridDim.x, sm); }
__global__ void __launch_bounds__(256) k_final(P p) { ph_final(p, blockIdx.x, gridDim.x); }
#endif

extern "C" void kernel_launch(void* const* d_in, const int* in_sizes, int n_in, void* d_out, int out_size, void* d_ws, size_t ws_size, hipStream_t stream) {
    if (n_in != 19 || ws_size < WS_NEED) { fprintf(stderr, "kernel_launch: unexpected n_in %d / ws_size %zu\n", n_in, ws_size); return; }
    P p{};
    p.x = (const float*)d_in[0]; p.c = (const float*)d_in[1]; p.ctx = (const float*)d_in[2]; p.c_ctx = (const float*)d_in[3];
    p.w_ada = (const float*)d_in[4]; p.b_ada = (const float*)d_in[5]; p.n1g = (const float*)d_in[6]; p.n2g = (const float*)d_in[7];
    p.w_in = (const float*)d_in[8]; p.w_f = (const float*)d_in[9]; p.sink = (const float*)d_in[10]; p.qn_g = (const float*)d_in[11];
    p.w_uq = (const float*)d_in[12]; p.kvn_g = (const float*)d_in[13]; p.w_ukv = (const float*)d_in[14]; p.w_out = (const float*)d_in[15];
    p.w_mlp1 = (const float*)d_in[16]; p.w_mlp2 = (const float*)d_in[17]; p.fin_g = (const float*)d_in[18];
    p.out = (float*)d_out; p.ws = (unsigned char*)d_ws;
#if MEGA
    static int grid_blocks = 0;
    if (!grid_blocks) {
        int dev = 0, cus = 0, per_cu = 0;
        hipGetDevice(&dev);
        hipDeviceGetAttribute(&cus, hipDeviceAttributeMultiprocessorCount, dev);
        hipOccupancyMaxActiveBlocksPerMultiprocessor(&per_cu, mega_kernel, 256, 0);
        if (per_cu > 4) per_cu = 4;
        grid_blocks = cus * per_cu;
    }
    void* args[] = {&p};
    hipError_t e = hipLaunchCooperativeKernel((void*)mega_kernel, dim3(grid_blocks), dim3(256), args, 0, stream);
    if (e != hipSuccess) fprintf(stderr, "cooperative launch failed: %s (grid %d)\n", hipGetErrorString(e), grid_blocks);
#else
    const int G = 2048;
    k_prep<<<G, 256, 0, stream>>>(p);
    for (int l = 0; l < DEPTH; ++l)
        for (int ph = 0; ph < NPH; ++ph) k_phase<<<G, 256, 0, stream>>>(p, l, ph);
    k_final<<<G, 256, 0, stream>>>(p);
#endif
}
```

```cpp
#include <hip/hip_runtime.h>
#include <hip/hip_cooperative_groups.h>
#include <stdint.h>
#include <stdio.h>
namespace cg = cooperative_groups;
#ifndef MEGA
#define MEGA 1
#endif
#ifndef PROBE_PH
#define PROBE_PH 0
#endif

typedef unsigned short bf16_t;
constexpr int D = 1024, NB = 8, S = 4096, L = 256, DEPTH = 2;
constexpr int ML = NB * S, MC = NB * L, MT = ML + MC;
constexpr int DIN = 1312, DFF = 4096;
constexpr int OFF_Q = 256, OFF_K = 640, OFF_V = 768, OFF_CQ = 896, OFF_CKV = 1152, OFF_KR = 1280;
constexpr int QMW = 576;
constexpr float EPS = 1e-6f;

constexpr size_t MiB = 1u << 20;
constexpr size_t O_MOD = 0, O_TAB = 1 * MiB, O_WF = 3 * MiB, O_HC = 5 * MiB, O_RSSQ = 13 * MiB, O_RSSKV = 14 * MiB + 512 * 1024, O_TW = 15 * MiB + 256 * 1024;
constexpr size_t O_ZF = 16 * MiB, O_YB = 50 * MiB, O_QS = 82 * MiB, O_KS = 108 * MiB, O_VS = 117 * MiB, O_CQ = 126 * MiB, O_CKV = 143 * MiB, O_KR = 152 * MiB,
                 O_QM = 155 * MiB, O_KN = 194 * MiB, O_VM = 220 * MiB, O_HID = 16 * MiB;
constexpr size_t O_WIN_T = 290 * MiB, O_WOUT_T = 297 * MiB, O_W1_T = 301 * MiB, O_W2_T = 317 * MiB, O_WUQ_T = 333 * MiB, O_WUKV_T = 334 * MiB, O_FFTW = 335 * MiB,
                 O_XN = 336 * MiB, O_MIX = 404 * MiB, O_RSSH = 472 * MiB;
constexpr size_t WS_NEED = 477 * MiB;

struct P {
    const float *x, *c, *ctx, *c_ctx, *w_ada, *b_ada, *n1g, *n2g, *w_in, *w_f, *sink, *qn_g, *w_uq, *kvn_g, *w_ukv, *w_out, *w_mlp1, *w_mlp2, *fin_g;
    float* out;
    unsigned char* ws;
};

__device__ __forceinline__ int tidx() { int t = threadIdx.x; asm volatile("" : "+v"(t)); return t; }
__device__ __forceinline__ float shfl_xor_f(float v, int mask) {
    const int lane = tidx() & 63; return __int_as_float(__builtin_amdgcn_ds_bpermute((lane ^ mask) << 2, __float_as_int(v)));
}
__device__ __forceinline__ float bf2f(bf16_t v) { return __uint_as_float(((unsigned)v) << 16); }
__device__ __forceinline__ bf16_t f2bf(float f) { unsigned u = __float_as_uint(f); u += 0x7fffu + ((u >> 16) & 1u); return (bf16_t)(u >> 16); }

__device__ __forceinline__ float* ws_mod(const P& p) { return (float*)(p.ws + O_MOD); }
__device__ __forceinline__ float* ws_cosT(const P& p) { return (float*)(p.ws + O_TAB); }
__device__ __forceinline__ float* ws_sinT(const P& p) { return (float*)(p.ws + O_TAB) + 4096; }
__device__ __forceinline__ float* ws_cosh(const P& p) { return (float*)(p.ws + O_TAB) + 8192; }
__device__ __forceinline__ float* ws_sinh(const P& p) { return ws_cosh(p) + 4096 * 32; }
__device__ __forceinline__ float* ws_cosr(const P& p) { return ws_sinh(p) + 4096 * 32; }
__device__ __forceinline__ float* ws_sinr(const P& p) { return ws_cosr(p) + 4096 * 16; }
__device__ __forceinline__ float* ws_wc(const P& p) { return (float*)(p.ws + O_WF); }
__device__ __forceinline__ float* ws_wsn(const P& p) { return (float*)(p.ws + O_WF) + 2 * 4 * 64 * 64; }
__device__ __forceinline__ float* ws_hc(const P& p) { return (float*)(p.ws + O_HC); }
__device__ __forceinline__ float* ws_rssq(const P& p) { return (float*)(p.ws + O_RSSQ); }
__device__ __forceinline__ float* ws_rsskv(const P& p) { return (float*)(p.ws + O_RSSKV); }
__device__ __forceinline__ float* ws_rssh(const P& p) { return (float*)(p.ws + O_RSSH); }
__device__ __forceinline__ float* ws_gm(const P& p, int l, int which) { return (float*)(p.ws + 475 * MiB) + (size_t)(l * 2 + which) * 9 * 1024; }
__device__ __forceinline__ float* ws_bias2(const P& p, int l) { return (float*)(p.ws + 475 * MiB + 256 * 1024) + (size_t)l * 9 * 4096; }
__device__ __forceinline__ float* ws_bias1(const P& p) { return (float*)(p.ws + 475 * MiB + 768 * 1024); }
__device__ __forceinline__ float* ws_gfin(const P& p) { return (float*)(p.ws + 475 * MiB + 896 * 1024); }
__device__ __forceinline__ bf16_t* ws_zf(const P& p) { return (bf16_t*)(p.ws + O_ZF); }
__device__ __forceinline__ bf16_t* ws_yb(const P& p) { return (bf16_t*)(p.ws + O_YB); }
__device__ __forceinline__ bf16_t* ws_qs(const P& p) { return (bf16_t*)(p.ws + O_QS); }
__device__ __forceinline__ bf16_t* ws_ks(const P& p) { return (bf16_t*)(p.ws + O_KS); }
__device__ __forceinline__ bf16_t* ws_vs(const P& p) { return (bf16_t*)(p.ws + O_VS); }
__device__ __forceinline__ bf16_t* ws_cq(const P& p) { return (bf16_t*)(p.ws + O_CQ); }
__device__ __forceinline__ bf16_t* ws_ckv(const P& p) { return (bf16_t*)(p.ws + O_CKV); }
__device__ __forceinline__ bf16_t* ws_kr(const P& p) { return (bf16_t*)(p.ws + O_KR); }
__device__ __forceinline__ bf16_t* ws_qm(const P& p) { return (bf16_t*)(p.ws + O_QM); }
__device__ __forceinline__ bf16_t* ws_kn(const P& p) { return (bf16_t*)(p.ws + O_KN); }
__device__ __forceinline__ bf16_t* ws_vm(const P& p) { return (bf16_t*)(p.ws + O_VM); }
__device__ __forceinline__ bf16_t* ws_mix(const P& p) { return (bf16_t*)(p.ws + O_MIX); }
__device__ __forceinline__ bf16_t* ws_hid(const P& p) { return (bf16_t*)(p.ws + O_HID); }

__device__ __forceinline__ int modrow(int row) { return row < ML ? (row >> 12) : 8; }
__device__ __forceinline__ const float* hrow_in(const P& p, int l, int row) {
    if (row < ML) return (l == 0 ? p.x : p.out) + (size_t)row * D;
    return (l == 0 ? p.ctx : ws_hc(p)) + (size_t)(row - ML) * D;
}
__device__ __forceinline__ float* hrow_mid(const P& p, int row) {
    if (row < ML) return p.out + (size_t)row * D;
    return ws_hc(p) + (size_t)(row - ML) * D;
}
__device__ __forceinline__ float wave_sum(float v) {
#pragma unroll
    for (int o = 1; o < 64; o <<= 1) v += shfl_xor_f(v, o);
    return v;
}

#define GAS __attribute__((address_space(1)))
#define LAS __attribute__((address_space(3)))
typedef unsigned v4u __attribute__((ext_vector_type(4)));
typedef unsigned v2u __attribute__((ext_vector_type(2)));
typedef float f32x4 __attribute__((ext_vector_type(4)));
typedef float v2u_f __attribute__((ext_vector_type(2)));
#define LDS_WAIT() asm volatile("s_waitcnt lgkmcnt(0)" ::: "memory")
__device__ __forceinline__ unsigned pk2(float lo, float hi) { return (unsigned)f2bf(lo) | ((unsigned)f2bf(hi) << 16); }

constexpr int FAST_THREADS = 512, FAST_LDS = 147456;
constexpr int NIN_PAD = 1792, NUQ_PAD = 768, NUKV = 768;
__device__ __forceinline__ bf16_t* ws_win_t(const P& p, int l) { return (bf16_t*)(p.ws + O_WIN_T) + (size_t)l * NIN_PAD * 1024; }
__device__ __forceinline__ bf16_t* ws_wout_t(const P& p, int l) { return (bf16_t*)(p.ws + O_WOUT_T) + (size_t)l * 1024 * 1024; }
__device__ __forceinline__ bf16_t* ws_w1_t(const P& p, int l) { return (bf16_t*)(p.ws + O_W1_T) + (size_t)l * 4096 * 1024; }
__device__ __forceinline__ bf16_t* ws_w2_t(const P& p, int l) { return (bf16_t*)(p.ws + O_W2_T) + (size_t)l * 1024 * 4096; }
__device__ __forceinline__ bf16_t* ws_wuq_t(const P& p, int l) { return (bf16_t*)(p.ws + O_WUQ_T) + (size_t)l * NUQ_PAD * 256; }
__device__ __forceinline__ bf16_t* ws_wukv_t(const P& p, int l) { return (bf16_t*)(p.ws + O_WUKV_T) + (size_t)l * NUKV * 128; }
__device__ __forceinline__ bf16_t* ws_xn(const P& p) { return (bf16_t*)(p.ws + O_XN); }

namespace pg8 {
#define PG8_LAS __attribute__((address_space(3)))
typedef unsigned short bf16_t;
typedef short bf16x8 __attribute__((ext_vector_type(8)));
typedef float f32x4 __attribute__((ext_vector_type(4)));
typedef unsigned u32x4 __attribute__((ext_vector_type(4)));
constexpr int BM = 256, BK = 64, HALF = 128, HTB = HALF * BK * 2  , STAGE_BYTES = 8 * HTB, NXCD = 8, WGM = 8;

__host__ __device__ __forceinline__ int lds_byte(int r, int c) { const int st = (r >> 4) * 2 + (c >> 5), rr = r & 15, cc = c & 31, ob = rr * 64 + cc * 2; return st * 1024 + (ob ^ (((ob >> 9) & 1) << 5)); }
__host__ __device__ __forceinline__ void stage_rc(int b, int& R, int& C) { const int st = b / 1024, sb = b % 1024, swz = sb ^ (((sb >> 9) & 1) << 5); R = (st >> 1) * 16 + swz / 64; C = (st & 1) * 32 + (swz % 64) / 2; }
__host__ __device__ __forceinline__ int perm32(int rho) { const int n = rho >> 4, i = rho & 15; return 8 * (i >> 2) + 4 * n + (i & 3); }

struct Unit { int pm, pn, ko; };
struct Gemm { const bf16_t* A; const bf16_t* Bt; int M, N, K, ld; int ablk = 0; };

struct StaticOrder {
    int nM, nN, nwg, G, c;
    __host__ __device__ void init(int M, int N, int G_, int c_) { nM = M / BM; nN = N / BM; nwg = nM * nN; G = G_; c = c_; }
    __host__ __device__ bool next(int i, Unit& u) const {
        const long L = (long)i * G + c; if (L >= nwg) return false;
        int wgid = (int)L; { const int q = nwg / NXCD, r = nwg % NXCD, xcd = wgid % NXCD, off = wgid / NXCD; wgid = (xcd < r ? xcd * (q + 1) : r * (q + 1) + (xcd - r) * q) + off; }
        const int nig = WGM * nN, gid = wgid / nig, fm = gid * WGM, gsz = (nM - fm) < WGM ? (nM - fm) : WGM;
        u.pm = fm + ((wgid % nig) % gsz); u.pn = (wgid % nig) / gsz; u.ko = 0; return true;
    }
    __device__ __forceinline__ void a_ready(const Unit&) const {}
    __device__ __forceinline__ void done(const Unit&) const {}
};

__device__ __forceinline__ unsigned cvt_pk_bf16(float lo, float hi) { unsigned r; asm volatile("v_cvt_pk_bf16_f32 %0, %1, %2" : "=v"(r) : "v"(lo), "v"(hi)); return r; }
typedef float f32x2 __attribute__((ext_vector_type(2)));
template <class Epi, class Sched, bool ALIGN_EPI = false, bool SP2 = false>
__device__ __forceinline__ void gemm_phase(PG8_LAS unsigned char* lds, const Gemm g, const Sched& S, const Epi& E) {
    const int tid = tidx(), wid = __builtin_amdgcn_readfirstlane(tid >> 6), lane = tid & 63, wr = wid >> 2, wc = wid & 3, fr = lane & 15, fq = lane >> 4;
    const int K = g.K, nt = K / BK;
    unsigned voffA[2], voffB[2];
#pragma unroll
    for (int i = 0; i < 2; ++i) { int R, C; stage_rc(tid * 16 + i * 8192, R, C); const int Rb = Epi::PERM ? ((R & ~31) + perm32(R & 31)) : R;
        voffA[i] = g.ablk ? (unsigned)(((R >> 4) * (g.ld >> 5) + (C >> 5)) * 512 + (R & 15) * 32 + (C & 31)) * 2u : (unsigned)(R * g.ld + C) * 2u; voffB[i] = (unsigned)(Rb * g.ld + C) * 2u; }
    const size_t kstep = (size_t)(BK * 2);
    const size_t kstepA = g.ablk ? (size_t)2048 : kstep;
    const size_t hstep = (size_t)HALF * g.ld * 2;
    const size_t tstep = 2 * hstep;
    const unsigned ldsw = (unsigned)wid * 1024u;
    const int aoff = lds_byte(wr * 64 + fr, fq * 8), boff = lds_byte(wc * 32 + fr, fq * 8);
#define PG8_SA(b, h) (((b) * 2 + (h)) * HTB)
#define PG8_SB(b, h) ((4 + (b) * 2 + (h)) * HTB)
#define PG8_STAGE(bufoff, gbase, voff) do { _Pragma("unroll") for (int _i = 0; _i < 2; ++_i) \
        __builtin_amdgcn_global_load_lds((const unsigned*)((const char*)(gbase) + (voff)[_i]), (PG8_LAS unsigned*)(lds + (bufoff) + ldsw + _i * 8192), 16, 0, 0); } while (0)
#define PG8_LDA(dst, b, h) do { _Pragma("unroll") for (int m = 0; m < 4; ++m) _Pragma("unroll") for (int k = 0; k < 2; ++k) dst[m][k] = *(const PG8_LAS bf16x8*)(lds + PG8_SA(b, h) + aoff + m * 2048 + k * 1024); } while (0)
#define PG8_LDB(dst, b, h) do { _Pragma("unroll") for (int n = 0; n < 2; ++n) _Pragma("unroll") for (int k = 0; k < 2; ++k) dst[n][k] = *(const PG8_LAS bf16x8*)(lds + PG8_SB(b, h) + boff + n * 2048 + k * 1024); } while (0)
#define PG8_MMA(ai, bj, At, Bt) do { __builtin_amdgcn_s_setprio(1); _Pragma("unroll") for (int m = 0; m < 4; ++m) _Pragma("unroll") for (int n = 0; n < 2; ++n) _Pragma("unroll") for (int k = 0; k < 2; ++k) \
        acc[ai][bj][m][n] = __builtin_amdgcn_mfma_f32_16x16x32_bf16(Bt[n][k], At[m][k], acc[ai][bj][m][n], 0, 0, 0); __builtin_amdgcn_s_setprio(0); } while (0)
#define PG8_WAIT_V(n) asm volatile("s_waitcnt vmcnt(" #n ")" ::: "memory")
#define PG8_WAIT_L(n) asm volatile("s_waitcnt lgkmcnt(" #n ")" ::: "memory")
#define PG8_BAR __builtin_amdgcn_s_barrier()
#define PG8_SCHED __builtin_amdgcn_sched_barrier(0)
    Unit cur, nxt; int ui = 0;
    if (!S.next(0, cur)) return;
    f32x4 acc[2][2][4][2];
#pragma unroll
    for (int a = 0; a < 2; ++a)
#pragma unroll
        for (int b = 0; b < 2; ++b)
#pragma unroll
            for (int m = 0; m < 4; ++m)
#pragma unroll
                for (int n = 0; n < 2; ++n) acc[a][b][m][n] = (f32x4){0.f, 0.f, 0.f, 0.f};
    bf16x8 At[4][2], B0[2][2], B1[2][2];
    const char* cA = (const char*)g.A + (size_t)cur.pm * tstep + (size_t)cur.ko * (g.ablk ? 32 : 2); const char* cB = (const char*)g.Bt + (size_t)cur.pn * tstep + (size_t)cur.ko * 2;
    S.a_ready(cur);
    if constexpr (SP2) {
        PG8_STAGE(PG8_SB(0, 0), cB, voffB); PG8_STAGE(PG8_SB(0, 1), cB + hstep, voffB); PG8_STAGE(PG8_SA(0, 0), cA, voffA); PG8_STAGE(PG8_SA(0, 1), cA + hstep, voffA);
        if (wr == 1) PG8_BAR;
        PG8_WAIT_V(2); PG8_BAR;
        PG8_STAGE(PG8_SB(1, 0), cB + kstep, voffB); PG8_STAGE(PG8_SA(1, 0), cA + kstepA, voffA); PG8_STAGE(PG8_SB(1, 1), cB + hstep + kstep, voffB);
        PG8_WAIT_V(6); PG8_BAR;
    } else {
        PG8_STAGE(PG8_SB(0, 0), cB, voffB); PG8_STAGE(PG8_SA(0, 0), cA, voffA); PG8_STAGE(PG8_SB(0, 1), cB + hstep, voffB); PG8_STAGE(PG8_SA(0, 1), cA + hstep, voffA);
        if (wr == 1) PG8_BAR;
        PG8_WAIT_V(4); PG8_BAR;
        PG8_STAGE(PG8_SB(1, 0), cB + kstep, voffB); PG8_STAGE(PG8_SA(1, 0), cA + kstepA, voffA); PG8_STAGE(PG8_SB(1, 1), cB + hstep + kstep, voffB);
        PG8_WAIT_V(6); PG8_BAR;
    }
    for (;;) {
        const bool has_next = S.next(ui + 1, nxt);
        const char* nA = has_next ? (const char*)g.A + (size_t)nxt.pm * tstep + (size_t)nxt.ko * (g.ablk ? 32 : 2) : cA; const char* nB = has_next ? (const char*)g.Bt + (size_t)nxt.pn * tstep + (size_t)nxt.ko * 2 : cB;
        for (int t = 0; t < nt; t += 2) {
            const bool last = (t == nt - 2);
            const char* a1 = cA + (size_t)(t + 1) * kstepA;
            const char* a2 = last ? nA : cA + (size_t)(t + 2) * kstepA; const char* b2 = last ? nB : cB + (size_t)(t + 2) * kstep;
            const char* a3 = a2 + kstepA; const char* b3 = b2 + kstep;
            if (last && has_next) S.a_ready(nxt);
            if constexpr (SP2) {
            PG8_LDB(B0, 0, 0); PG8_LDB(B1, 0, 1); PG8_SCHED; PG8_LDA(At, 0, 0); PG8_STAGE(PG8_SA(1, 1), a1 + hstep, voffA);
            PG8_WAIT_V(8); PG8_WAIT_L(0); PG8_BAR; PG8_MMA(0, 0, At, B0); PG8_MMA(0, 1, At, B1); PG8_BAR; PG8_SCHED;
            PG8_LDA(At, 0, 1); PG8_STAGE(PG8_SB(0, 0), b2, voffB); PG8_STAGE(PG8_SB(0, 1), b2 + hstep, voffB); PG8_STAGE(PG8_SA(0, 0), a2, voffA);
            PG8_WAIT_V(8); PG8_WAIT_L(0); PG8_BAR; PG8_MMA(1, 0, At, B0); PG8_MMA(1, 1, At, B1); PG8_BAR; PG8_SCHED;
            PG8_LDB(B0, 1, 0); PG8_LDB(B1, 1, 1); PG8_SCHED; PG8_LDA(At, 1, 0); PG8_STAGE(PG8_SA(0, 1), a2 + hstep, voffA);
            PG8_WAIT_V(8); PG8_WAIT_L(0); PG8_BAR; PG8_MMA(0, 0, At, B0); PG8_MMA(0, 1, At, B1); PG8_BAR; PG8_SCHED;
            PG8_LDA(At, 1, 1); PG8_STAGE(PG8_SB(1, 0), b3, voffB); PG8_STAGE(PG8_SB(1, 1), b3 + hstep, voffB); PG8_STAGE(PG8_SA(1, 0), a3, voffA);
            PG8_WAIT_V(8); PG8_WAIT_L(0); PG8_BAR; PG8_MMA(1, 0, At, B0); PG8_MMA(1, 1, At, B1); PG8_BAR; PG8_SCHED;
            } else {
            PG8_LDB(B0, 0, 0); PG8_SCHED; PG8_LDA(At, 0, 0); PG8_STAGE(PG8_SA(1, 1), a1 + hstep, voffA);
            PG8_WAIT_L(8); PG8_BAR; PG8_WAIT_L(0); PG8_MMA(0, 0, At, B0); PG8_BAR; PG8_SCHED;
            PG8_LDB(B1, 0, 1); PG8_STAGE(PG8_SB(0, 0), b2, voffB);
            PG8_BAR; PG8_WAIT_L(0); PG8_MMA(0, 1, At, B1); PG8_BAR;
            PG8_LDA(At, 0, 1); PG8_STAGE(PG8_SA(0, 0), a2, voffA);
            PG8_BAR; PG8_WAIT_L(0); PG8_MMA(1, 0, At, B0); PG8_BAR; PG8_SCHED;
            PG8_STAGE(PG8_SB(0, 1), b2 + hstep, voffB);
            PG8_WAIT_V(6); PG8_BAR; PG8_MMA(1, 1, At, B1); PG8_BAR;
            PG8_LDB(B0, 1, 0); PG8_SCHED; PG8_LDA(At, 1, 0); PG8_STAGE(PG8_SA(0, 1), a2 + hstep, voffA);
            PG8_WAIT_L(8); PG8_BAR; PG8_WAIT_L(0); PG8_MMA(0, 0, At, B0); PG8_BAR; PG8_SCHED;
            PG8_LDB(B1, 1, 1); PG8_STAGE(PG8_SB(1, 0), b3, voffB);
            PG8_BAR; PG8_WAIT_L(0); PG8_MMA(0, 1, At, B1); PG8_BAR;
            PG8_LDA(At, 1, 1); PG8_STAGE(PG8_SA(1, 0), a3, voffA);
            PG8_BAR; PG8_WAIT_L(0); PG8_MMA(1, 0, At, B0); PG8_BAR; PG8_SCHED;
            PG8_STAGE(PG8_SB(1, 1), b3 + hstep, voffB);
            PG8_WAIT_V(6); PG8_BAR; PG8_MMA(1, 1, At, B1); PG8_BAR;
            }
        }
        if constexpr (ALIGN_EPI) { if (wr == 0) PG8_BAR; }
        if constexpr (!Epi::AFTER_DRAIN) { const int t2_ = tidx(); const int fr_ = t2_ & 15, fq_ = (t2_ & 63) >> 4;
                                           E(acc, cur, wr, wc, fr_, fq_); S.done(cur); }
        if (!has_next) break;
#pragma unroll
        for (int a = 0; a < 2; ++a)
#pragma unroll
            for (int b = 0; b < 2; ++b)
#pragma unroll
                for (int m = 0; m < 4; ++m)
#pragma unroll
                    for (int n = 0; n < 2; ++n) acc[a][b][m][n] = (f32x4){0.f, 0.f, 0.f, 0.f};
        cur = nxt; cA = nA; cB = nB; ++ui;
        if constexpr (ALIGN_EPI) { if (wr == 1) PG8_BAR; }
    }
    PG8_WAIT_V(0);
    if constexpr (!ALIGN_EPI) { if (wr == 0) PG8_BAR; }
    PG8_BAR;
    if constexpr (Epi::AFTER_DRAIN) { E.fused(acc, cur, wr, wc, fr, fq, lds, wid, lane); S.done(cur); }
#undef PG8_SA
#undef PG8_SB
#undef PG8_STAGE
#undef PG8_LDA
#undef PG8_LDB
#undef PG8_MMA
#undef PG8_WAIT_V
#undef PG8_WAIT_L
#undef PG8_BAR
#undef PG8_SCHED
}
}

template <class F>
__device__ __forceinline__ void tr_item(F fn, int K, bf16_t* WT, LAS float* scr, int kb, int nbk, int lane) {
    asm volatile("" : "+v"(lane));
    const int k0 = 64 * kb, n0 = 32 * nbk;
#pragma unroll 4
    for (int i = 0; i < 32; ++i) { const int kk = 2 * i + (lane >> 5); scr[kk * 33 + (lane & 31)] = fn(k0 + kk, n0 + (lane & 31)); }
    LDS_WAIT(); asm volatile("" ::: "memory");
    const int c = lane & 7;
#pragma unroll
    for (int j = 0; j < 4; ++j) { const int n = (lane >> 3) + 8 * j; const LAS float* s = scr + (8 * c) * 33 + n;
        v4u o; o.x = pk2(s[0 * 33], s[1 * 33]); o.y = pk2(s[2 * 33], s[3 * 33]); o.z = pk2(s[4 * 33], s[5 * 33]); o.w = pk2(s[6 * 33], s[7 * 33]);
        *(GAS v4u*)(WT + (size_t)(n0 + n) * K + k0 + 8 * c) = o; }
    LDS_WAIT(); asm volatile("" ::: "memory");
}
__device__ __forceinline__ float win_src(const P& p, int l, int k, int n) {
    const float* w = p.w_in + ((size_t)l * 1024 + k) * DIN;
    if (n < 512) { const int part = n >> 8, g = (n >> 6) & 3, d = n & 63;
        const float* wf = (part ? ws_wsn(p) : ws_wc(p)) + (size_t)(l * 4 + g) * 4096 + d; float a = 0.f;
        for (int c = 0; c < 64; ++c) a += w[g * 64 + c] * wf[c * 64];
        return a; }
    if (n < 1024) { const int pp = n - 512, H = pp >> 6, pos = pp & 63, d = 32 * ((pos >> 2) & 1) + 16 * (pos >> 5) + 4 * ((pos >> 3) & 3) + (pos & 3); return w[OFF_Q + H * 64 + d]; }
    if (n < 1280) { const int pp = n - 1024; return pp < 128 ? w[OFF_V + pp] : w[OFF_CKV + pp - 128]; }
    if (n < 1536) return w[OFF_CQ + n - 1280];
    const int pp = n - 1536; return pp < 32 ? w[OFF_KR + 16 * ((pp >> 2) & 1) + 4 * (pp >> 3) + (pp & 3)] : 0.f;
}
__device__ __forceinline__ float wuq_src(const P& p, int l, int k, int n) {
    int col; if (n < 384) col = (n >> 6) * 96 + (n & 63); else if (n < 576) { const int pp = n - 384, ps = pp & 31; col = (pp >> 5) * 96 + 64 + 16 * ((ps >> 2) & 1) + 4 * (ps >> 3) + (ps & 3); } else return 0.f;
    return p.w_uq[((size_t)l * 256 + k) * QMW + col] * p.qn_g[l * 256 + k];
}
__device__ __forceinline__ float wukv_src(const P& p, int l, int k, int n) {
    int col; if (n < 384) col = (n >> 6) * 128 + (n & 63); else { const int pp = n - 384; col = (pp >> 6) * 128 + 64 + (pp & 63); }
    return p.w_ukv[((size_t)l * 128 + k) * 768 + col] * p.kvn_g[l * 128 + k];
}
__device__ __forceinline__ void fp_weights_in(const P& p, LAS unsigned char* lds, int bid, int nb) {
    const int tid = tidx(), lane = tid & 63, wave = tid >> 6;
    LAS float* scr = (LAS float*)(lds + wave * 16384);
    const int gw = bid * 8 + wave, NGW = nb * 8;
    constexpr int NBL = NIN_PAD / 32, I_IN = 16 * NBL;
#pragma unroll 1
    for (int it = gw; it < 2 * I_IN; it += NGW) {
        const int l = it / I_IN, r = it % I_IN, kb = r / NBL, nbk = r % NBL;
        if (nbk >= 16) { tr_item([&](int k, int n) { return win_src(p, l, k, n); }, 1024, ws_win_t(p, l), scr, kb, nbk, lane); }
        else {
            int ln = lane; asm volatile("" : "+v"(ln));
            const int part = nbk >> 3, g = (nbk >> 1) & 3, k0 = 64 * kb + 32 * (nbk & 1);
            const float* wx = (part ? ws_wsn(p) : ws_wc(p)) + (size_t)(l * 4 + g) * 4096 + ln;
            const float* wsrc = p.w_in + ((size_t)l * 1024 + k0) * DIN + g * 64;
#pragma unroll 4
            for (int i = 0; i < 8; ++i) { const int e = i * 64 + ln, kk = e >> 4, c4 = e & 15; ((LAS f32x4*)scr)[e] = *(const f32x4*)(wsrc + (size_t)kk * DIN + 4 * c4); }
            float wxr[64];
#pragma unroll
            for (int c = 0; c < 64; ++c) wxr[c] = wx[c * 64];
            LDS_WAIT(); asm volatile("" ::: "memory");
            bf16_t* dst = ws_win_t(p, l) + (size_t)(part * 256 + g * 64 + ln) * 1024 + k0;
#pragma unroll 1
            for (int k8 = 0; k8 < 4; ++k8) {
                float a[8];
#pragma unroll
                for (int j = 0; j < 8; ++j) a[j] = 0.f;
#pragma unroll
                for (int j = 0; j < 8; ++j) {
                    float s0 = 0.f, s1 = 0.f, s2 = 0.f, s3 = 0.f;
#pragma unroll
                    for (int c4 = 0; c4 < 16; ++c4) { const f32x4 w4 = ((LAS f32x4*)scr)[(8 * k8 + j) * 16 + c4];
                        asm("v_fmac_f32 %0, %1, %2" : "+v"(s0) : "v"(wxr[4 * c4]), "v"(w4.x)); asm("v_fmac_f32 %0, %1, %2" : "+v"(s1) : "v"(wxr[4 * c4 + 1]), "v"(w4.y));
                        asm("v_fmac_f32 %0, %1, %2" : "+v"(s2) : "v"(wxr[4 * c4 + 2]), "v"(w4.z)); asm("v_fmac_f32 %0, %1, %2" : "+v"(s3) : "v"(wxr[4 * c4 + 3]), "v"(w4.w)); }
                    a[j] = (s0 + s1) + (s2 + s3);
                    __builtin_amdgcn_sched_barrier(0);
                }
                v4u o; o.x = pk2(a[0], a[1]); o.y = pk2(a[2], a[3]); o.z = pk2(a[4], a[5]); o.w = pk2(a[6], a[7]);
                *(v4u*)(dst + 8 * k8) = o;
            }
            LDS_WAIT(); asm volatile("" ::: "memory");
        }
    }
}
__device__ __forceinline__ void fp_weights(const P& p, LAS unsigned char* lds, int bid, int nb) {
    const int tid = tidx(), lane = tid & 63, wave = tid >> 6;
    LAS float* scr = (LAS float*)(lds + wave * 16384);
    const int gw = bid * 8 + wave, NGW = nb * 8;
    constexpr int I_OUT = 16 * 32, I_1 = 16 * 128, I_2 = 64 * 32, I_UQ = 4 * (NUQ_PAD / 32), I_UKV = 2 * (NUKV / 32);
    constexpr int PER_L = I_OUT + I_1 + I_2 + I_UQ + I_UKV;
#pragma unroll 1
    for (int it = gw; it < 2 * PER_L; it += NGW) {
        const int l = it / PER_L; int r = it % PER_L;
        if (r < I_OUT) { const float* W = p.w_out + (size_t)l * 1024 * 1024; tr_item([&](int k, int n) { return W[(size_t)k * 1024 + n]; }, 1024, ws_wout_t(p, l), scr, r / 32, r % 32, lane); continue; } r -= I_OUT;
        if (r < I_1) { const float* W = p.w_mlp1 + (size_t)l * 1024 * DFF; tr_item([&](int k, int n) { return W[(size_t)k * DFF + n]; }, 1024, ws_w1_t(p, l), scr, r / 128, r % 128, lane); continue; } r -= I_1;
        if (r < I_2) { const float* W = p.w_mlp2 + (size_t)l * DFF * 1024; tr_item([&](int k, int n) { return W[(size_t)k * 1024 + n]; }, DFF, ws_w2_t(p, l), scr, r / 32, r % 32, lane); continue; } r -= I_2;
        if (r < I_UQ) { const int nbl = NUQ_PAD / 32; tr_item([&](int k, int n) { return wuq_src(p, l, k, n); }, 256, ws_wuq_t(p, l), scr, r / nbl, r % nbl, lane); continue; } r -= I_UQ;
        { const int nbl = NUKV / 32; tr_item([&](int k, int n) { return wukv_src(p, l, k, n); }, 128, ws_wukv_t(p, l), scr, r / nbl, r % nbl, lane); }
    }
}

__device__ __forceinline__ void fp_tables(const P& p, int bid, int nb) {
    const int gt = bid * FAST_THREADS + tidx(), GT = nb * FAST_THREADS;
    for (int idx = gt; idx < 4096 * 32; idx += GT) {
        const int s = idx >> 5, j = idx & 31;
        const int pos = (j < 16) ? (s >> 6) : (s & 63), f = j & 15;
        const float inv = powf(10000.0f, -(float)f / 16.0f), ang = (float)pos * inv;
        ws_cosh(p)[idx] = cosf(ang); ws_sinh(p)[idx] = sinf(ang);
    }
    for (int idx = gt; idx < 4096 * 16; idx += GT) {
        const int s = idx >> 4, j = idx & 15;
        const int pos = (j < 8) ? (s >> 6) : (s & 63), f = j & 7;
        const float inv = powf(10000.0f, -(float)f / 8.0f), ang = (float)pos * inv;
        ws_cosr(p)[idx] = cosf(ang); ws_sinr(p)[idx] = sinf(ang);
    }
    for (int idx = gt; idx < 2 * 4 * 64 * 64; idx += GT) {
        const int d = idx & 63, c = (idx >> 6) & 63, lg = idx >> 12;
        float ac = 0.f, as = 0.f;
        for (int c2 = 0; c2 < 64; ++c2) {
            float sn, cs; sincospif((float)((c * c2) & 63) * (1.0f / 32.0f), &sn, &cs);
            const float w = p.w_f[(size_t)(lg * 64 + c2) * 64 + d];
            ac += cs * w; as += sn * w;
        }
        ws_wc(p)[idx] = ac; ws_wsn(p)[idx] = as;
    }
}
__device__ __forceinline__ void fp_mods(const P& p, LAS unsigned char* lds, int bid, int nb) {
    const int tid = tidx(), lane = tid & 63, w = tid >> 6;
    LAS float* sc = (LAS float*)lds;
    LAS float* part = (LAS float*)(lds + 36864);
    if (bid >= 192) return;
    for (int i = tid; i < 9 * 1024; i += FAST_THREADS) {
        const int r = i >> 10, k = i & 1023;
        const float v = (r < 8) ? p.c[r * 1024 + k] : p.c_ctx[k];
        sc[i] = v / (1.0f + expf(-v));
    }
    __syncthreads();
    for (int it = bid; it < 192; it += nb) {
        const int l = it / 96, n = (it % 96) * 64 + lane;
        float acc[9];
#pragma unroll
        for (int r = 0; r < 9; ++r) acc[r] = 0.f;
        const float* wp = p.w_ada + ((size_t)l * 1024 + w * 128) * 6144 + n;
#pragma unroll 16
        for (int k = 0; k < 128; ++k) {
            const float wv = wp[(size_t)k * 6144];
#pragma unroll
            for (int r = 0; r < 9; ++r) acc[r] += sc[r * 1024 + w * 128 + k] * wv;
        }
#pragma unroll
        for (int r = 0; r < 9; ++r) part[(w * 9 + r) * 64 + lane] = acc[r];
        __syncthreads();
        for (int i = tid; i < 9 * 64; i += FAST_THREADS) {
            const int r = i >> 6, c = i & 63; float s = 0.f;
#pragma unroll
            for (int ww = 0; ww < 8; ++ww) s += part[(ww * 9 + r) * 64 + c];
            const int nn = (it % 96) * 64 + c;
            ws_mod(p)[(size_t)(l * 9 + r) * 6144 + nn] = s + p.b_ada[l * 6144 + nn];
        }
        __syncthreads();
    }
}


__device__ __forceinline__ void fp_gm(const P& p, int bid, int nb) {
    const int gt = bid * FAST_THREADS + tidx(), GT = nb * FAST_THREADS;
    for (int i = gt; i < 9 * 1024; i += GT) ws_gfin(p)[i] = p.fin_g[i & 1023];
    for (int i = gt; i < 2 * 2 * 9 * 1024; i += GT) {
        const int k = i & 1023, r = (i >> 10) % 9, lw = i / (9 * 1024), l = lw >> 1, which = lw & 1;
        const float g = (which == 0 ? p.n1g : p.n2g)[l * 1024 + k];
        ws_gm(p, l, which)[r * 1024 + k] = g * (1.0f + ws_mod(p)[(size_t)(l * 9 + r) * 6144 + (which == 0 ? 1024 : 4096) + k]);
    }
}
__device__ __forceinline__ void fp_bias(const P& p, int bid, int nb) {
    const int tid = tidx(), lane = tid & 63, gw = bid * 8 + (tid >> 6), NGW = nb * 8;
#pragma unroll 1
    for (int g = 0; g < 3; ++g) {
        const int nit = g < 2 ? 4096 : NIN_PAD, ldd = nit;
        if (gw >= nit) continue;
        const float* sh = g < 2 ? ws_mod(p) + (size_t)(g * 9) * 6144 + 3072 : ws_mod(p) + (size_t)9 * 6144;
        const bf16_t* wbase = g < 2 ? ws_w1_t(p, g) : ws_win_t(p, 1); float* dst = g < 2 ? ws_bias2(p, g) : ws_bias1(p);
        f32x4 s[9][4];
#pragma unroll
        for (int r = 0; r < 9; ++r) { const float* q = sh + (size_t)r * 6144 + 8 * lane; s[r][0] = *(const f32x4*)q; s[r][1] = *(const f32x4*)(q + 4); s[r][2] = *(const f32x4*)(q + 512); s[r][3] = *(const f32x4*)(q + 516); }
#pragma unroll 1
        for (int n = gw; n < nit; n += NGW) {
            const bf16_t* wrow = wbase + (size_t)n * 1024;
            float w[16];
            { const v4u a = ((const v4u*)wrow)[lane], b = ((const v4u*)wrow)[64 + lane];
              const unsigned u[8] = {a.x, a.y, a.z, a.w, b.x, b.y, b.z, b.w};
#pragma unroll
              for (int j = 0; j < 8; ++j) { w[2 * j] = __uint_as_float(u[j] << 16); w[2 * j + 1] = __uint_as_float(u[j] & 0xffff0000u); } }
            float d[9];
#pragma unroll
            for (int r = 0; r < 9; ++r)
                d[r] = (w[0] * s[r][0].x + w[1] * s[r][0].y) + (w[2] * s[r][0].z + w[3] * s[r][0].w) + (w[4] * s[r][1].x + w[5] * s[r][1].y) + (w[6] * s[r][1].z + w[7] * s[r][1].w)
                     + (w[8] * s[r][2].x + w[9] * s[r][2].y) + (w[10] * s[r][2].z + w[11] * s[r][2].w) + (w[12] * s[r][3].x + w[13] * s[r][3].y) + (w[14] * s[r][3].z + w[15] * s[r][3].w);
#pragma unroll
            for (int o = 1; o < 64; o <<= 1) {
                float t[9];
#pragma unroll
                for (int r = 0; r < 9; ++r) t[r] = shfl_xor_f(d[r], o);
#pragma unroll
                for (int r = 0; r < 9; ++r) d[r] += t[r];
            }
            if (lane < 9) { float v = d[0];
#pragma unroll
                for (int r = 1; r < 9; ++r) v = lane == r ? d[r] : v;
                dst[(size_t)lane * ldd + n] = v; }
        }
    }
}

__device__ __forceinline__ void fp_xn(const P& p, int l, int which, int nrows, int bid, int nb) {
    const int tid = tidx(), lane = tid & 63, gw = bid * 8 + (tid >> 6), NGW = nb * 8;
    const float* g = (which == 0 ? p.n1g : p.n2g) + l * 1024;
    for (int row = gw; row < nrows; row += NGW) {
        const float* h = which == 0 ? hrow_in(p, l, row) : hrow_mid(p, row);
        const float* mod = ws_mod(p) + (size_t)(l * 9 + modrow(row)) * 6144 + (which == 0 ? 0 : 3072);
        f32x4 v[4]; float ss = 0.f;
#pragma unroll
        for (int j = 0; j < 4; ++j) { v[j] = ((const f32x4*)h)[lane + 64 * j]; ss += (v[j].x * v[j].x + v[j].y * v[j].y) + (v[j].z * v[j].z + v[j].w * v[j].w); }
        ss = wave_sum(ss);
        const float rstd = 1.0f / sqrtf(ss * (1.0f / 1024.0f) + EPS);
        bf16_t* o = ws_xn(p) + (size_t)row * 1024;
#pragma unroll
        for (int j = 0; j < 4; ++j) {
            const int c = 4 * lane + 256 * j;
            const f32x4 gg = *(const f32x4*)(g + c), sh = *(const f32x4*)(mod + c), sc = *(const f32x4*)(mod + 1024 + c);
            const f32x4 y = (v[j] * rstd * gg) * (sc + 1.0f) + sh;
            v2u w; w.x = pk2(y.x, y.y); w.y = pk2(y.z, y.w);
            *(v2u*)(o + c) = w;
        }
    }
}

__device__ __forceinline__ void st8(bf16_t* dst, const pg8::f32x4 a, const pg8::f32x4 b) {
    v4u w; w.x = pg8::cvt_pk_bf16(a.x, a.y); w.y = pg8::cvt_pk_bf16(a.z, a.w); w.z = pg8::cvt_pk_bf16(b.x, b.y); w.w = pg8::cvt_pk_bf16(b.z, b.w); *(v4u*)dst = w;
}
__device__ __forceinline__ void st8_nt(bf16_t* dst, const pg8::f32x4 a, const pg8::f32x4 b) {
    v4u w; w.x = pg8::cvt_pk_bf16(a.x, a.y); w.y = pg8::cvt_pk_bf16(a.z, a.w); w.z = pg8::cvt_pk_bf16(b.x, b.y); w.w = pg8::cvt_pk_bf16(b.z, b.w); __builtin_nontemporal_store(w, (v4u*)dst);
}
__device__ __forceinline__ float sq4(const pg8::f32x4 v) { return (v.x * v.x + v.y * v.y) + (v.z * v.z + v.w * v.w); }
struct EpiResidA {
    static constexpr bool PERM = true, AFTER_DRAIN = false;
    const float* hin_lat; const float* hin_ctx;
    const float* gm_in; float* hout; const float* gate; const float* gm; bf16_t* XN; float* RSSH;
    __device__ __forceinline__ void operator()(const pg8::f32x4 (&acc)[2][2][4][2], const pg8::Unit& u, int wr, int wc, int fr, int fq) const {
        const int mr = modrow(u.pm * 256), cb = u.pn * 256 + wc * 32 + 8 * fq;
        pg8::f32x4 gg[2][2], gmv[2][2], rgi[2][2];
#pragma unroll
        for (int bj = 0; bj < 2; ++bj)
#pragma unroll
            for (int n = 0; n < 2; ++n) { gg[bj][n] = *(const pg8::f32x4*)(gate + (size_t)mr * 6144 + cb + bj * 128 + n * 4);
                                          gmv[bj][n] = gm ? *(const pg8::f32x4*)(gm + (size_t)mr * 1024 + cb + bj * 128 + n * 4) : (pg8::f32x4){0.f, 0.f, 0.f, 0.f};
                                          if (!hin_lat) { const pg8::f32x4 g_ = *(const pg8::f32x4*)(gm_in + (size_t)mr * 1024 + cb + bj * 128 + n * 4);
                                                          rgi[bj][n] = (pg8::f32x4){1.0f / g_.x, 1.0f / g_.y, 1.0f / g_.z, 1.0f / g_.w}; } }
#pragma unroll
        for (int ai = 0; ai < 2; ++ai)
#pragma unroll
            for (int m = 0; m < 4; ++m) {
                const int row = u.pm * 256 + ai * 128 + wr * 64 + m * 16 + fr;
                float ss = 0.f;
#pragma unroll
                for (int bj = 0; bj < 2; ++bj) {
                    pg8::f32x4 b0, b1;
                    if (hin_lat) { const float* hi = (row < ML ? hin_lat + (size_t)row * 1024 : hin_ctx + (size_t)(row - ML) * 1024) + cb + bj * 128; b0 = *(const pg8::f32x4*)hi; b1 = *(const pg8::f32x4*)(hi + 4); }
                    else { const v4u w = *(const v4u*)(XN + (size_t)row * 1024 + cb + bj * 128);
                           b0 = (pg8::f32x4){__uint_as_float(w.x << 16), __uint_as_float(w.x & 0xffff0000u), __uint_as_float(w.y << 16), __uint_as_float(w.y & 0xffff0000u)} * rgi[bj][0];
                           b1 = (pg8::f32x4){__uint_as_float(w.z << 16), __uint_as_float(w.z & 0xffff0000u), __uint_as_float(w.w << 16), __uint_as_float(w.w & 0xffff0000u)} * rgi[bj][1]; }
                    const pg8::f32x4 h0 = b0 + gg[bj][0] * acc[ai][bj][m][0], h1 = b1 + gg[bj][1] * acc[ai][bj][m][1];
                    ss += sq4(h0) + sq4(h1);
                    if (hout) { float* ho = hout + (size_t)row * 1024 + cb + bj * 128; *(pg8::f32x4*)ho = h0; *(pg8::f32x4*)(ho + 4) = h1; }
                    if (gm) st8(XN + (size_t)row * 1024 + cb + bj * 128, h0 * gmv[bj][0], h1 * gmv[bj][1]);
                }
                ss += shfl_xor_f(ss, 16); ss += shfl_xor_f(ss, 32);
                if (fq == 0) RSSH[(size_t)row * 16 + u.pn * 4 + wc] = ss;
            }
    }
};
__device__ __forceinline__ float rstd16(const float* rssh, int row, int fq) {
    const pg8::f32x4 a = *(const pg8::f32x4*)(rssh + (size_t)row * 16 + 4 * fq);
    float s = (a.x + a.y) + (a.z + a.w);
    s += shfl_xor_f(s, 16); s += shfl_xor_f(s, 32);
    return 1.0f / sqrtf(s * (1.0f / 1024.0f) + EPS);
}
struct EpiMlp1 {
    static constexpr bool PERM = true, AFTER_DRAIN = false;
    bf16_t* O; const float* RSSH; const float* bias;
    __device__ __forceinline__ void operator()(const pg8::f32x4 (&acc)[2][2][4][2], const pg8::Unit& u, int wr, int wc, int fr, int fq) const {
        const int mr = modrow(u.pm * 256), cb = u.pn * 256 + wc * 32 + 8 * fq;
        pg8::f32x4 bv[2][2];
#pragma unroll
        for (int bj = 0; bj < 2; ++bj)
#pragma unroll
            for (int n = 0; n < 2; ++n) bv[bj][n] = *(const pg8::f32x4*)(bias + (size_t)mr * 4096 + cb + bj * 128 + n * 4);
#pragma unroll
        for (int ai = 0; ai < 2; ++ai)
#pragma unroll
            for (int m = 0; m < 4; ++m) {
                const int row = u.pm * 256 + ai * 128 + wr * 64 + m * 16 + fr;
                const float r = rstd16(RSSH, row, fq);
#pragma unroll
                for (int bj = 0; bj < 2; ++bj) {
                    pg8::f32x4 v[2];
#pragma unroll
                    for (int n = 0; n < 2; ++n) { v[n] = acc[ai][bj][m][n] * r + bv[bj][n];
                        v[n].x = fmaxf(v[n].x, 0.f); v[n].y = fmaxf(v[n].y, 0.f); v[n].z = fmaxf(v[n].z, 0.f); v[n].w = fmaxf(v[n].w, 0.f); v[n] = v[n] * v[n]; }
                    st8_nt(O + ((size_t)((row >> 4) * (DFF >> 5) + ((cb + bj * 128) >> 5)) * 512 + (row & 15) * 32 + 8 * fq), v[0], v[1]);
                }
            }
    }
};
struct EpiInproj {
    static constexpr bool PERM = true, AFTER_DRAIN = false;
    bf16_t *ZF, *QS, *KS, *VS, *CQ, *CKV, *KR; float *RSSQ, *RSSKV; const float *cosh, *sinh, *cosr, *sinr; const float* RSSH; const float* bias;
    __device__ __forceinline__ void operator()(const pg8::f32x4 (&acc_in)[2][2][4][2], const pg8::Unit& u, int wr, int wc, int fr, int fq) const {
        const int pn = u.pn, c8 = wc * 32 + 8 * fq;
        pg8::f32x4 bv[2][2];
#pragma unroll
        for (int bj = 0; bj < 2; ++bj)
#pragma unroll
            for (int n = 0; n < 2; ++n) bv[bj][n] = RSSH ? *(const pg8::f32x4*)(bias + (size_t)modrow(u.pm * 256) * NIN_PAD + pn * 256 + c8 + bj * 128 + n * 4) : (pg8::f32x4){0.f, 0.f, 0.f, 0.f};
#pragma unroll
        for (int ai = 0; ai < 2; ++ai)
#pragma unroll
            for (int m = 0; m < 4; ++m) {
                const int row = u.pm * 256 + ai * 128 + wr * 64 + m * 16 + fr;
                const bool lat = row < ML; const int s = row & 4095;
                pg8::f32x4 a[2][2];
#pragma unroll
                for (int bj = 0; bj < 2; ++bj)
#pragma unroll
                    for (int n = 0; n < 2; ++n) a[bj][n] = acc_in[ai][bj][m][n];
                if (RSSH) { const float r = rstd16(RSSH, row, fq);
#pragma unroll
                    for (int bj = 0; bj < 2; ++bj)
#pragma unroll
                        for (int n = 0; n < 2; ++n) a[bj][n] = a[bj][n] * r + bv[bj][n]; }
                if (pn < 2) {
#pragma unroll
                    for (int bj = 0; bj < 2; ++bj) st8(ZF + (size_t)row * 512 + pn * 256 + bj * 128 + c8, a[bj][0], a[bj][1]);
                } else if (pn < 4) {
                    const int e = wc & 1, i0 = 16 * e + 4 * fq;
#pragma unroll
                    for (int bj = 0; bj < 2; ++bj) {
                        const int H = (pn - 2) * 4 + bj * 2 + (wc >> 1);
                        pg8::f32x4 y1 = a[bj][0], y2 = a[bj][1];
                        if (lat) { const pg8::f32x4 c4 = *(const pg8::f32x4*)(cosh + s * 32 + i0), s4 = *(const pg8::f32x4*)(sinh + s * 32 + i0);
                                   const pg8::f32x4 x1 = y1, x2 = y2; y1 = x1 * c4 - x2 * s4; y2 = x1 * s4 + x2 * c4; }
                        if (H < 6) { y1 = y1 * (0.125f * 1.4426950408889634f); y2 = y2 * (0.125f * 1.4426950408889634f);
                                     st8(QS + (size_t)row * 384 + H * 64 + 32 * e + 8 * fq, y1, y2); }
                        else st8(KS + ((size_t)(((row >> 6) * 2 + (H - 6)) * 8 + 4 * e + fq) * 64 + (row & 63)) * 8, y1, y2);
                    }
                } else if (pn == 4) {
                    st8(VS + ((size_t)((((row >> 6) * 2 + (wc >> 1)) * 2 + (wc & 1)) * 64 + (row & 63)) * 4 + fq) * 8, a[0][0], a[0][1]);
                    st8(CKV + (size_t)row * 128 + c8, a[1][0], a[1][1]);
                    float ss = sq4(a[1][0]) + sq4(a[1][1]);
                    ss += shfl_xor_f(ss, 16); ss += shfl_xor_f(ss, 32);
                    if (fq == 0) RSSKV[(size_t)row * 4 + wc] = ss;
                } else if (pn == 5) {
#pragma unroll
                    for (int bj = 0; bj < 2; ++bj) {
                        st8(CQ + (size_t)row * 256 + bj * 128 + c8, a[bj][0], a[bj][1]);
                        float ss = sq4(a[bj][0]) + sq4(a[bj][1]);
                        ss += shfl_xor_f(ss, 16); ss += shfl_xor_f(ss, 32);
                        if (fq == 0) RSSQ[(size_t)row * 8 + bj * 4 + wc] = ss;
                    }
                } else if (wc == 0) {
                    pg8::f32x4 y1 = a[0][0], y2 = a[0][1];
                    if (lat) { const pg8::f32x4 c4 = *(const pg8::f32x4*)(cosr + s * 16 + 4 * fq), s4 = *(const pg8::f32x4*)(sinr + s * 16 + 4 * fq);
                               const pg8::f32x4 x1 = y1, x2 = y2; y1 = x1 * c4 - x2 * s4; y2 = x1 * s4 + x2 * c4; }
                    st8(KR + ((size_t)((row >> 6) * 4 + fq) * 64 + (row & 63)) * 8, y1, y2);
                }
            }
    }
};
struct EpiUpQ {
    static constexpr bool PERM = true, AFTER_DRAIN = false;
    bf16_t* QM; const float* RSSQ; const float *cosr, *sinr;
    __device__ __forceinline__ void operator()(const pg8::f32x4 (&acc)[2][2][4][2], const pg8::Unit& u, int wr, int wc, int fr, int fq) const {
#pragma unroll
        for (int ai = 0; ai < 2; ++ai)
#pragma unroll
            for (int m = 0; m < 4; ++m) {
                const int row = u.pm * 256 + ai * 128 + wr * 64 + m * 16 + fr;
                const bool lat = row < ML; const int s = row & 4095;
                float r; { const v2u_f pa = *(const v2u_f*)(RSSQ + (size_t)row * 8 + 2 * fq); float s_ = pa.x + pa.y; s_ += shfl_xor_f(s_, 16); s_ += shfl_xor_f(s_, 32);
                           r = (0.10206207261596577f * 1.4426950408889634f) / sqrtf(s_ * (1.0f / 256.0f) + EPS); }
#pragma unroll
                for (int bj = 0; bj < 2; ++bj) {
                    const int grp = u.pn * 8 + bj * 4 + wc;
                    if (grp < 18) {
                        pg8::f32x4 y1 = acc[ai][bj][m][0] * r, y2 = acc[ai][bj][m][1] * r;
                        if (grp >= 12 && lat) { const pg8::f32x4 c4 = *(const pg8::f32x4*)(cosr + s * 16 + 4 * fq), s4 = *(const pg8::f32x4*)(sinr + s * 16 + 4 * fq);
                                                const pg8::f32x4 x1 = y1, x2 = y2; y1 = x1 * c4 - x2 * s4; y2 = x1 * s4 + x2 * c4; }
                        st8(QM + (size_t)row * QMW + grp * 32 + 8 * fq, y1, y2);
                    }
                }
            }
    }
};
struct EpiUpKV {
    static constexpr bool PERM = true, AFTER_DRAIN = false;
    bf16_t *KN, *VM; const float* RSSKV;
    __device__ __forceinline__ void operator()(const pg8::f32x4 (&acc)[2][2][4][2], const pg8::Unit& u, int wr, int wc, int fr, int fq) const {
#pragma unroll
        for (int ai = 0; ai < 2; ++ai)
#pragma unroll
            for (int m = 0; m < 4; ++m) {
                const int row = u.pm * 256 + ai * 128 + wr * 64 + m * 16 + fr;
                float r; { float s_ = RSSKV[(size_t)row * 4 + fq]; s_ += shfl_xor_f(s_, 16); s_ += shfl_xor_f(s_, 32); r = 1.0f / sqrtf(s_ * (1.0f / 128.0f) + EPS); }
#pragma unroll
                for (int bj = 0; bj < 2; ++bj) {
                    const int cb = u.pn * 2 + bj, tile = row >> 6, rit = row & 63;
                    bf16_t* dst;
                    if (cb < 3) { const int head = cb * 2 + (wc >> 1), chunk = (wc & 1) * 4 + fq; dst = KN + ((size_t)((tile * 6 + head) * 8 + chunk) * 64 + rit) * 8; }
                    else { const int head = (cb - 3) * 2 + (wc >> 1); dst = VM + ((size_t)(((tile * 6 + head) * 2 + (wc & 1)) * 64 + rit) * 4 + fq) * 8; }
                    st8(dst, acc[ai][bj][m][0] * r, acc[ai][bj][m][1] * r);
                }
            }
    }
};
namespace attn {
using bf16x8 = __attribute__((ext_vector_type(8))) short;
using s16x4  = __attribute__((ext_vector_type(4))) short;
using f32x16 = __attribute__((ext_vector_type(16))) float;
using u32x4  = __attribute__((ext_vector_type(4))) unsigned;
constexpr int NW = 8, QBLK = 32, KVBLK = 64;
constexpr int SHM_V = 16384, SHM_K = 16384, SHM_ATTN = 2 * SHM_V + 2 * SHM_K + NW * 64 * 4;
constexpr float LOG2E = 1.4426950408889634f;
constexpr float THRN = 8.f;
#define KSWZ(row, colB) ((row) * 256 + ((colB) ^ (((row) & 7) << 4)))
#define SBAR() __builtin_amdgcn_sched_barrier(0)
__device__ __forceinline__ int crow(int r, int hi) { return (r & 3) + 8 * (r >> 2) + 4 * hi; }
__device__ __forceinline__ unsigned cvtpk(float lo, float hi) { unsigned r; asm volatile("v_cvt_pk_bf16_f32 %0, %1, %2" : "=v"(r) : "v"(lo), "v"(hi)); return r; }

template <int MODE> struct Cfg;
template <> struct Cfg<0> { static constexpr int KD = 96; static constexpr float SCALE = 0.10206207261596577f; static constexpr int NLOAD = 3; };
template <> struct Cfg<1> { static constexpr int KD = 64; static constexpr float SCALE = 0.125f; static constexpr int NLOAD = 2; };

template <int MODE>
__device__ __forceinline__ void partialSM(f32x16& p0, f32x16& p1, float& m_reg, float& mn, float& alpha) {
  constexpr float SC = Cfg<MODE>::SCALE, C = SC * LOG2E;
  float pmax = p0[0];
#pragma unroll
  for (int r = 1; r < 16; ++r) pmax = fmaxf(pmax, p0[r]);
#pragma unroll
  for (int r = 0; r < 16; ++r) pmax = fmaxf(pmax, p1[r]);
  { auto rr = __builtin_amdgcn_permlane32_swap(__float_as_uint(pmax), __float_as_uint(pmax), false, false);
    pmax = fmaxf(__uint_as_float(rr[0]), __uint_as_float(rr[1])); }
  if (__builtin_expect(__all(pmax - m_reg <= THRN / SC), 1)) { mn = m_reg; alpha = 1.f; }
  else { mn = fmaxf(m_reg, pmax); alpha = __builtin_amdgcn_exp2f((m_reg - mn) * C); m_reg = mn; }
  const float mnC = -mn * C;
#pragma unroll
  for (int r = 0; r < 16; ++r) p0[r] = fmaf(p0[r], C, mnC);
#pragma unroll
  for (int r = 0; r < 16; ++r) p1[r] = fmaf(p1[r], C, mnC);
#pragma unroll
  for (int r = 0; r < 16; ++r) p0[r] = __builtin_amdgcn_exp2f(p0[r]);
}
__device__ __forceinline__ void finishSM(f32x16& p0, f32x16& p1, float alpha, float& l_reg, bf16x8& pa0, bf16x8& pa1, bf16x8& pa2, bf16x8& pa3) {
#pragma unroll
  for (int r = 0; r < 16; ++r) p1[r] = __builtin_amdgcn_exp2f(p1[r]);
  float ps = 0;
#pragma unroll
  for (int r = 0; r < 16; ++r) ps += p0[r];
#pragma unroll
  for (int r = 0; r < 16; ++r) ps += p1[r];
  { auto rr = __builtin_amdgcn_permlane32_swap(__float_as_uint(ps), __float_as_uint(ps), false, false);
    ps = __uint_as_float(rr[0]) + __uint_as_float(rr[1]); }
  l_reg = l_reg * alpha + ps;
#define PK4(P, BASE, OUT) do { unsigned a0 = cvtpk(P[BASE + 0], P[BASE + 1]), a1 = cvtpk(P[BASE + 2], P[BASE + 3]);   \
    unsigned b0 = cvtpk(P[BASE + 4], P[BASE + 5]), b1 = cvtpk(P[BASE + 6], P[BASE + 7]);                              \
    auto r0 = __builtin_amdgcn_permlane32_swap(a0, b0, false, false); auto r1 = __builtin_amdgcn_permlane32_swap(a1, b1, false, false); \
    u32x4 w = {r0[0], r1[0], r0[1], r1[1]}; OUT = *reinterpret_cast<bf16x8*>(&w); } while (0)
  PK4(p0, 0, pa0); PK4(p0, 8, pa1); PK4(p1, 0, pa2); PK4(p1, 8, pa3);
#undef PK4
}
template <int KD>
__device__ __forceinline__ void qkt(f32x16& p0, f32x16& p1, const char* Ks, const bf16x8* qr, int r32, int hi) {
  p0 = f32x16{}; p1 = f32x16{};
#pragma unroll
  for (int d0 = 0; d0 < KD / 16; ++d0) { const int cb = (d0 * 16 + hi * 8) * 2;
    const bf16x8 b0 = *reinterpret_cast<const bf16x8*>(Ks + KSWZ(r32, cb));
    const bf16x8 b1 = *reinterpret_cast<const bf16x8*>(Ks + KSWZ(32 + r32, cb));
    p0 = __builtin_amdgcn_mfma_f32_32x32x16_bf16(b0, qr[d0], p0, 0, 0, 0);
    p1 = __builtin_amdgcn_mfma_f32_32x32x16_bf16(b1, qr[d0], p1, 0, 0, 0); }
}
__device__ __forceinline__ int v_st(int k, int c) { const int kk = (k & ~0xC) | ((k & 4) << 1) | ((k & 8) >> 1); return ((kk >> 3) * 4 + (c >> 5)) * 512 + ((kk & 7) * 32 + (c & 31)) * 2; }
__device__ __forceinline__ int v_rd_base(int lane) { return ((lane & 3) << 3) | (((lane >> 2) & 3) << 6) | (((lane >> 4) & 1) << 5) | (((lane >> 5) & 1) << 8); }
constexpr int v_rd_off(int d0, int ks, int half) { return d0 * 512 + ks * 4096 + half * 2048; }
template <int OFF> __device__ __forceinline__ s16x4 tr_read(int vb) {
  s16x4 r; asm volatile("ds_read_b64_tr_b16 %0, %1 offset:%2" : "=&v"(r) : "v"(vb), "i"(OFF) : "memory"); return r;
}
template <int D0> __device__ __forceinline__ void pv_one(f32x16& od, int vb, bf16x8 pa0, bf16x8 pa1, bf16x8 pa2, bf16x8 pa3) {
  const s16x4 l0 = tr_read<v_rd_off(D0, 0, 0)>(vb), h0 = tr_read<v_rd_off(D0, 0, 1)>(vb), l1 = tr_read<v_rd_off(D0, 1, 0)>(vb), h1 = tr_read<v_rd_off(D0, 1, 1)>(vb);
  const s16x4 l2 = tr_read<v_rd_off(D0, 2, 0)>(vb), h2 = tr_read<v_rd_off(D0, 2, 1)>(vb), l3 = tr_read<v_rd_off(D0, 3, 0)>(vb), h3 = tr_read<v_rd_off(D0, 3, 1)>(vb);
  asm volatile("s_waitcnt lgkmcnt(0)" ::: "memory"); SBAR();
#define PK(L, H) (bf16x8){L[0], L[1], L[2], L[3], H[0], H[1], H[2], H[3]}
  od = __builtin_amdgcn_mfma_f32_32x32x16_bf16(pa0, PK(l0, h0), od, 0, 0, 0);
  od = __builtin_amdgcn_mfma_f32_32x32x16_bf16(pa1, PK(l1, h1), od, 0, 0, 0);
  od = __builtin_amdgcn_mfma_f32_32x32x16_bf16(pa2, PK(l2, h2), od, 0, 0, 0);
  od = __builtin_amdgcn_mfma_f32_32x32x16_bf16(pa3, PK(l3, h3), od, 0, 0, 0);
#undef PK
}
__device__ __forceinline__ void pv_d0(f32x16* o, int vb, bf16x8 pa0, bf16x8 pa1, bf16x8 pa2, bf16x8 pa3) {
  pv_one<0>(o[0], vb, pa0, pa1, pa2, pa3); pv_one<1>(o[1], vb, pa0, pa1, pa2, pa3);
}
__device__ __forceinline__ void swa_mask(f32x16& p0, f32x16& p1, int kbase, int qpos, int hi) {
#pragma unroll
  for (int r = 0; r < 16; ++r) {
    const int k0 = kbase + crow(r, hi) - qpos, k1 = k0 + 32;
    if (k0 > 128 || k0 < -128) p0[r] = -1e30f;
    if (k1 > 128 || k1 < -128) p1[r] = -1e30f;
  }
}

template <int MODE>
__device__ __forceinline__ void attn_unit(const P& p, int l, bool isctx, int b, int h, int q0, char* lds) {
  constexpr int KD = Cfg<MODE>::KD; constexpr float SC = Cfg<MODE>::SCALE, C = SC * LOG2E;
  const int tid = tidx(), wid = tid >> 6, lane = tid & 63, r32 = lane & 31, hi = lane >> 5;
  char* V_lds = lds; char* K_lds = lds + 2 * SHM_V;
  float* wsf = (float*)(lds + 2 * SHM_V + 2 * SHM_K) + wid * 64; float* li_l = wsf; float* al_l = wsf + 32;
  const bf16_t* QM = ws_qm(p); const bf16_t* KN = ws_kn(p); const bf16_t* VM = ws_vm(p); const bf16_t* KR = ws_kr(p);
  const bf16_t* QS = ws_qs(p); const bf16_t* KS = ws_ks(p); const bf16_t* VS = ws_vs(p);
  const int qrow0 = isctx ? ML + b * 256 : b * 4096 + q0;
  const int qrow = qrow0 + wid * QBLK + r32, qpos = q0 + wid * QBLK + r32;
  const int kvh = h / 3;
  int kstart = 0, NT;
  if (MODE == 0) NT = isctx ? 4 : 68;
  else { if (isctx) NT = 4; else { kstart = max(0, q0 - 128); const int kend = min(S, q0 + 384); NT = 4 + (kend - kstart) / 64; } }
  auto tile_row = [&](int t) -> int {
    if (isctx) return ML + b * 256 + t * 64;
    if (MODE == 0) return t < 64 ? b * 4096 + t * 64 : ML + b * 256 + (t - 64) * 64;
    return t < 4 ? ML + b * 256 + t * 64 : b * 4096 + kstart + (t - 4) * 64;
  };
  float m_reg = -1e30f, l_reg = 0; f32x16 o[2] = {}; bf16x8 qr[KD / 16];
  if (MODE == 0) {
    const bf16_t* Qw = QM + (size_t)qrow * QMW + hi * 8;
#pragma unroll
    for (int d0 = 0; d0 < 4; ++d0) qr[d0] = *reinterpret_cast<const bf16x8*>(Qw + h * 64 + d0 * 16);
#pragma unroll
    for (int d0 = 4; d0 < 6; ++d0) qr[d0] = *reinterpret_cast<const bf16x8*>(Qw + 384 + h * 32 + (d0 - 4) * 16);
  } else {
    const bf16_t* Qw = QS + (size_t)qrow * 384 + h * 64 + hi * 8;
#pragma unroll
    for (int d0 = 0; d0 < 4; ++d0) qr[d0] = *reinterpret_cast<const bf16x8*>(Qw + d0 * 16);
  }
  const int srow = tid >> 3, sch = tid & 7, srow2 = (tid & 255) >> 2, sch2 = tid & 3;
  const int kst = KSWZ(srow, sch * 16), kst2 = KSWZ(srow2, (8 + sch2) * 16), vst = v_st(srow, sch * 8);
  const int vb0 = (int)(uintptr_t)V_lds + v_rd_base(lane);
  struct Slot { bf16x8 k, v, k2; } sl_[2];
#define SLOAD(i, t) do { const int rb_ = tile_row(t); \
    if (MODE == 0) { sl_[i].k = *reinterpret_cast<const bf16x8*>(KN + (size_t)(rb_ + srow) * 384 + h * 64 + sch * 8); \
      sl_[i].v = *reinterpret_cast<const bf16x8*>(VM + (size_t)(rb_ + srow) * 384 + h * 64 + sch * 8); \
      sl_[i].k2 = *reinterpret_cast<const bf16x8*>(KR + (size_t)(rb_ + srow2) * 32 + sch2 * 8); } \
    else { sl_[i].k = *reinterpret_cast<const bf16x8*>(KS + (size_t)(rb_ + srow) * 128 + kvh * 64 + sch * 8); \
      sl_[i].v = *reinterpret_cast<const bf16x8*>(VS + (size_t)(rb_ + srow) * 128 + kvh * 64 + sch * 8); } } while (0)
#define SWRITE(bf, i) do { *(bf16x8*)(V_lds + (bf) * SHM_V + vst) = sl_[i].v; *(bf16x8*)(K_lds + (bf) * SHM_K + kst) = sl_[i].k; \
    if (MODE == 0) *(bf16x8*)(K_lds + (bf) * SHM_K + kst2) = sl_[i].k2; } while (0)
#define SWAIT() do { if (MODE == 0) asm volatile("s_waitcnt vmcnt(3)" ::: "memory"); else asm volatile("s_waitcnt vmcnt(2)" ::: "memory"); } while (0)
#define RESC(a) do { if (__any((a) < 1.f)) { if (hi == 0) al_l[r32] = (a); asm volatile("s_waitcnt lgkmcnt(0)" ::: "memory"); \
    _Pragma("unroll") for (int d = 0; d < 2; ++d) _Pragma("unroll") for (int r = 0; r < 16; ++r) o[d][r] *= al_l[crow(r, hi)]; } } while (0)
#define MASK(P0, P1, t) do { if (MODE == 1 && !isctx && (t) >= 4) swa_mask(P0, P1, kstart + ((t) - 4) * 64, qpos, hi); } while (0)
  f32x16 pA0, pA1, pB0, pB1; float mnA, mnB, alA, alB; bf16x8 pa0, pa1, pa2, pa3;
  constexpr int SE = 0, SO = 1;
  SLOAD(SE, 0); asm volatile("s_waitcnt vmcnt(0)" ::: "memory"); SWRITE(0, SE); __syncthreads();
  qkt<KD>(pA0, pA1, K_lds, qr, r32, hi); MASK(pA0, pA1, 0); partialSM<MODE>(pA0, pA1, m_reg, mnA, alA);
  SLOAD(SO, 1); if (2 < NT) SLOAD(SE, 2);
  SWAIT(); SWRITE(1, SO); __syncthreads();
  for (int j = 1; j + 1 < NT; j += 2) {
    SBAR(); qkt<KD>(pB0, pB1, K_lds + SHM_K, qr, r32, hi);
    finishSM(pA0, pA1, alA, l_reg, pa0, pa1, pa2, pa3); SBAR();
    SLOAD(SO, j + 2); SBAR();
    pv_d0(o, vb0, pa0, pa1, pa2, pa3); MASK(pB0, pB1, j); partialSM<MODE>(pB0, pB1, m_reg, mnB, alB);
    __syncthreads(); SWAIT(); SWRITE(0, SE);
    RESC(alB); __syncthreads();
    SBAR(); qkt<KD>(pA0, pA1, K_lds, qr, r32, hi);
    finishSM(pB0, pB1, alB, l_reg, pa0, pa1, pa2, pa3); SBAR();
    if (j + 3 < NT) SLOAD(SE, j + 3); SBAR();
    pv_d0(o, vb0 + SHM_V, pa0, pa1, pa2, pa3); MASK(pA0, pA1, j + 1); partialSM<MODE>(pA0, pA1, m_reg, mnA, alA);
    __syncthreads(); SWAIT(); SWRITE(1, SO);
    RESC(alA); __syncthreads();
  }
  SBAR(); qkt<KD>(pB0, pB1, K_lds + SHM_K, qr, r32, hi);
  finishSM(pA0, pA1, alA, l_reg, pa0, pa1, pa2, pa3); SBAR();
  pv_d0(o, vb0, pa0, pa1, pa2, pa3); MASK(pB0, pB1, NT - 1); partialSM<MODE>(pB0, pB1, m_reg, mnB, alB);
  __syncthreads(); RESC(alB);
  finishSM(pB0, pB1, alB, l_reg, pa0, pa1, pa2, pa3); SBAR();
  pv_d0(o, vb0 + SHM_V, pa0, pa1, pa2, pa3);
  if (MODE == 1) l_reg += __builtin_amdgcn_exp2f(p.sink[l * 6 + h] * LOG2E - m_reg * C);
  if (hi == 0) li_l[r32] = l_reg; asm volatile("s_waitcnt lgkmcnt(0)" ::: "memory");
  float rli[16];
#pragma unroll
  for (int r = 0; r < 16; ++r) rli[r] = __builtin_amdgcn_rcpf(li_l[crow(r, hi)]);
  bf16_t* Ow = ws_mix(p) + (size_t)(qrow0 + wid * QBLK) * 1024 + (MODE == 0 ? 640 : 256) + h * 64;
  { bf16_t* stg = (bf16_t*)(lds + SHM_ATTN) + wid * 2048;
#pragma unroll
    for (int r = 0; r < 16; ++r) { const int orow = crow(r, hi);
#pragma unroll
      for (int d0 = 0; d0 < 2; ++d0) stg[orow * 64 + d0 * 32 + r32] = f2bf(o[d0][r] * rli[r]); }
    asm volatile("s_waitcnt lgkmcnt(0)" ::: "memory");
#pragma unroll
    for (int i = 0; i < 4; ++i) { const int row = i * 8 + (lane >> 3), ch = lane & 7; const u32x4 v = *(const u32x4*)(stg + row * 64 + ch * 8); *(u32x4*)(Ow + (size_t)row * 1024 + ch * 8) = v; }
    asm volatile("s_waitcnt lgkmcnt(0)" ::: "memory"); }
  __syncthreads();
#undef SLOAD
#undef SWRITE
#undef SWAIT
#undef RESC
#undef MASK
}
#undef KSWZ
#undef SBAR
}

__device__ __forceinline__ bf16_t* ws_fwa(const P& p) { return (bf16_t*)(p.ws + O_FFTW); }
__device__ __forceinline__ bf16_t* ws_fwb(const P& p) { return (bf16_t*)(p.ws + O_FFTW + 32768); }
__device__ __forceinline__ bf16_t* ws_fwc(const P& p) { return (bf16_t*)(p.ws + O_FFTW + 65536); }
__device__ __forceinline__ float2* ws_tw(const P& p) { return (float2*)(p.ws + O_TW); }
__device__ __forceinline__ void fp_fftw(const P& p, int bid, int nb) {
    const int gt = bid * FAST_THREADS + tidx(), GT = nb * FAST_THREADS;
    for (int i = gt; i < 4096; i += GT) { float sn, cs; sincospif((float)i * (1.0f / 2048.0f), &sn, &cs); ws_tw(p)[i] = make_float2(cs, sn); }
    for (int i = gt; i < 128 * 128; i += GT) {
        const int m = i >> 7, k = i & 127, pp = m >> 6, s1p = m & 63, part = k >> 6, s1 = k & 63;
        float sn, cs; sincospif((float)((s1 * s1p) & 63) * (1.0f / 32.0f), &sn, &cs);
        const float v = pp == 0 ? (part == 0 ? cs : -sn) : (part == 0 ? -sn : -cs);
        ws_fwa(p)[i] = f2bf(v);
    }
    for (int i = gt; i < 64 * 128; i += GT) {
        const int m = i >> 7, k = i & 127, part = k >> 6, s2 = k & 63;
        float sn, cs; sincospif((float)((s2 * m) & 63) * (1.0f / 32.0f), &sn, &cs);
        ws_fwb(p)[i] = f2bf((part == 0 ? cs : sn) * (1.0f / 512.0f));
    }
    for (int i = gt; i < 256 * 512; i += GT) {
        const int m = i >> 9, k = i & 511, part = k >> 8, s = k & 255;
        float sn, cs; sincospif((float)((s * m) & 255) * (1.0f / 128.0f), &sn, &cs);
        ws_fwc(p)[i] = f2bf((part == 0 ? cs : -sn) * (1.0f / 128.0f));
    }
}
namespace fft {
using attn::bf16x8; using attn::s16x4; using attn::f32x16;
template <class RowFn> __device__ __forceinline__ void ld_rows(bf16x8 (&v)[8], RowFn rowptr, int c) {
    const int tid = tidx();
#pragma unroll
    for (int i = 0; i < 8; ++i) { const int q = tid + 512 * i, k = q >> 5, cc = q & 31; v[i] = *reinterpret_cast<const bf16x8*>(rowptr(c * 128 + k) + cc * 8); }
}
__device__ __forceinline__ void st_tile(char* lds, const bf16x8 (&v)[8]) {
    const int tid = tidx();
#pragma unroll
    for (int i = 0; i < 8; ++i) { const int q = tid + 512 * i, k = q >> 5, cc = q & 31;
        *(bf16x8*)(lds + ((k >> 6) * 2 + (cc >> 4)) * 16384 + attn::v_st(k & 63, (cc & 15) * 8)) = v[i]; }
}
template <int LDW> __device__ __forceinline__ void ld_w(bf16x8 (&wf)[2][8], const bf16_t* W, int t0, int c) {
    const int lane = tidx() & 63, r32 = lane & 31, hi = lane >> 5;
#pragma unroll
    for (int t = 0; t < 2; ++t) { const bf16_t* wp = W + (size_t)(32 * (t0 + t) + r32) * LDW + c * 128 + 8 * hi;
#pragma unroll
        for (int ks = 0; ks < 8; ++ks) wf[t][ks] = *reinterpret_cast<const bf16x8*>(wp + 16 * ks); }
}
__device__ __forceinline__ void rd_tile(bf16x8 (&bfr)[8], char* lds) {
    const int tid = tidx(), w = tid >> 6, lane = tid & 63;
    const int vb = (int)(uintptr_t)lds + attn::v_rd_base(lane) + (w >> 2) * 16384 + (w & 3) * 512;
#define FFT_RD(ks) { const s16x4 lo_ = attn::tr_read<((ks) >> 2) * 32768 + ((ks) & 3) * 4096>(vb), hi_ = attn::tr_read<((ks) >> 2) * 32768 + ((ks) & 3) * 4096 + 2048>(vb); \
                     bfr[ks] = (bf16x8){lo_[0], lo_[1], lo_[2], lo_[3], hi_[0], hi_[1], hi_[2], hi_[3]}; }
    FFT_RD(0) FFT_RD(1) FFT_RD(2) FFT_RD(3) FFT_RD(4) FFT_RD(5) FFT_RD(6) FFT_RD(7)
#undef FFT_RD
    asm volatile("s_waitcnt lgkmcnt(0)" ::: "memory"); __builtin_amdgcn_sched_barrier(0);
}
__device__ __forceinline__ void mac2(f32x16& a0, f32x16& a1, const bf16x8 (&wf)[2][8], const bf16x8 (&bfr)[8]) {
#pragma unroll
    for (int ks = 0; ks < 8; ++ks) a0 = __builtin_amdgcn_mfma_f32_32x32x16_bf16(wf[0][ks], bfr[ks], a0, 0, 0, 0);
#pragma unroll
    for (int ks = 0; ks < 8; ++ks) a1 = __builtin_amdgcn_mfma_f32_32x32x16_bf16(wf[1][ks], bfr[ks], a1, 0, 0, 0);
}
constexpr int TWL = 131072 + 4096;
}
__device__ __forceinline__ void fp_fft_a(const P& p, bool with_ctx, LAS unsigned char* ldsl, int bid, int nb) {
    char* lds = (char*)ldsl;
    const int tid = tidx(), w = tid >> 6, lane = tid & 63, r32 = lane & 31, hi = lane >> 5;
    const bf16_t* ZF = ws_zf(p); bf16_t* YB = ws_yb(p); bf16_t* MIX = ws_mix(p); const float2* TW = ws_tw(p);
    const int nu = 512 + (with_ctx ? 32 : 0);
    constexpr int WL = 65536, STG = 98304;
#pragma unroll
    for (int i = 0; i < 4; ++i) { const int q = tid + 512 * i, row = q >> 4, c = q & 15; *(v4u*)(lds + WL + row * 256 + ((c ^ (row & 15)) << 4)) = *(const v4u*)(ws_fwa(p) + row * 128 + c * 8); }
    auto rowp = [&](int u, int k) -> const bf16_t* {
        if (u < 512) { const int b = u >> 6, s2 = u & 63; return ZF + (size_t)(b * 4096 + 64 * (k & 63) + s2) * 512 + (k >> 6) * 256; }
        const int b = (u - 512) >> 2; return ZF + (size_t)(ML + b * 256 + (k & 255)) * 512 + (k >> 8) * 256; };
    attn::bf16x8 v[8];
    int u = nb - 1 - bid;
    if (u < nu) fft::ld_rows(v, [&](int k) { return rowp(u, k); }, 0);
    for (; u < nu; u += nb) {
        const int un = u + nb;
        attn::bf16x8 bfr[8];
        bf16_t* stg = (bf16_t*)(lds + STG) + w * 2048;
        if (u < 512) {
            const int b = u >> 6, s2 = u & 63;
            float2 twv = make_float2(0.f, 0.f); if (w == 0) twv = TW[s2 * lane];
            attn::f32x16 acc[4];
#pragma unroll
            for (int t = 0; t < 4; ++t) acc[t] = attn::f32x16{};
            __syncthreads();
            fft::st_tile(lds, v); if (w == 0) *(float2*)(lds + fft::TWL + lane * 8) = twv;
            __syncthreads();
            if (un < nu) fft::ld_rows(v, [&](int k) { return rowp(un, k); }, 0);
            fft::rd_tile(bfr, lds);
            const char* wrow = lds + WL + r32 * 256; const int x = r32 & 15;
#pragma unroll
            for (int t = 0; t < 4; ++t)
#pragma unroll
                for (int ks = 0; ks < 8; ++ks) {
                    const attn::bf16x8 wfr = *(const attn::bf16x8*)(wrow + t * 8192 + (((2 * ks + hi) ^ x) << 4));
                    acc[t] = __builtin_amdgcn_mfma_f32_32x32x16_bf16(wfr, bfr[ks], acc[t], 0, 0, 0);
                }
            const char* twb = lds + fft::TWL + hi * 32;
#pragma unroll
            for (int tt = 0; tt < 2; ++tt) {
#pragma unroll
                for (int r = 0; r < 16; ++r) {
                    const float2 cs = *(const float2*)(twb + (32 * tt + attn::crow(r, 0)) * 8);
                    const float yr = acc[tt][r], yi = acc[tt + 2][r];
                    const unsigned pk = pg8::cvt_pk_bf16(yr * cs.x + yi * cs.y, yi * cs.x - yr * cs.y);
                    stg[attn::crow(r, hi) * 64 + r32] = (bf16_t)(pk & 0xffffu); stg[attn::crow(r, hi) * 64 + 32 + r32] = (bf16_t)(pk >> 16);
                }
                asm volatile("s_waitcnt lgkmcnt(0)" ::: "memory");
#pragma unroll
                for (int i = 0; i < 4; ++i) { const int s1p = 32 * tt + i * 8 + (lane >> 3), c8 = lane & 7;
                    const v4u vv = *(const v4u*)(stg + (i * 8 + (lane >> 3)) * 64 + c8 * 8);
                    *(v4u*)(YB + ((size_t)((b * 64 + s1p) * 64 + s2)) * 512 + (c8 >> 2) * 256 + 32 * w + (c8 & 3) * 8) = vv; }
                asm volatile("s_waitcnt lgkmcnt(0)" ::: "memory");
            }
        } else {
            const int b = (u - 512) >> 2, tq = (u - 512) & 3;
            attn::f32x16 acc[2]; acc[0] = attn::f32x16{}; acc[1] = attn::f32x16{};
            attn::bf16x8 wf[2][8];
#pragma unroll 1
            for (int c = 0; c < 4; ++c) {
                __syncthreads(); fft::st_tile(lds, v); __syncthreads();
                fft::ld_w<512>(wf, ws_fwc(p) + (size_t)(64 * tq) * 512, 0, c);
                __builtin_amdgcn_sched_barrier(0);
                if (c < 3) fft::ld_rows(v, [&](int k) { return rowp(u, k); }, c + 1);
                __builtin_amdgcn_sched_barrier(0);
                fft::rd_tile(bfr, lds);
                fft::mac2(acc[0], acc[1], wf, bfr);
            }
#pragma unroll
            for (int t = 0; t < 2; ++t)
#pragma unroll
                for (int r = 0; r < 16; ++r) stg[(32 * t + attn::crow(r, hi)) * 32 + r32] = f2bf(acc[t][r]);
            asm volatile("s_waitcnt lgkmcnt(0)" ::: "memory");
#pragma unroll
            for (int i = 0; i < 4; ++i) { const int rr = i * 16 + (lane >> 2), c4 = lane & 3; const v4u vv = *(const v4u*)(stg + rr * 32 + c4 * 8);
                *(v4u*)(MIX + (size_t)(ML + b * 256 + 64 * tq + rr) * 1024 + 32 * w + c4 * 8) = vv; }
            asm volatile("s_waitcnt lgkmcnt(0)" ::: "memory");
        }
    }
    __syncthreads();
}
__device__ __forceinline__ void fp_fft_b(const P& p, LAS unsigned char* ldsl, int bid, int nb) {
    char* lds = (char*)ldsl;
    const int tid = tidx(), w = tid >> 6, lane = tid & 63, r32 = lane & 31, hi = lane >> 5;
    const bf16_t* YB = ws_yb(p); bf16_t* MIX = ws_mix(p);
    constexpr int WL = 65536, STG = 98304;
#pragma unroll
    for (int i = 0; i < 2; ++i) { const int q = tid + 512 * i, row = q >> 4, c = q & 15; *(v4u*)(lds + WL + row * 256 + ((c ^ (row & 15)) << 4)) = *(const v4u*)(ws_fwb(p) + row * 128 + c * 8); }
    auto rowp = [&](int u, int k) -> const bf16_t* { const int b = u >> 6, s1p = u & 63; return YB + ((size_t)((b * 64 + s1p) * 64 + (k & 63))) * 512 + (k >> 6) * 256; };
    attn::bf16x8 v[8];
    int u = bid;
    if (u < 512) fft::ld_rows(v, [&](int k) { return rowp(u, k); }, 0);
    for (; u < 512; u += nb) {
        const int b = u >> 6, s1p = u & 63, un = u + nb;
        attn::bf16x8 bfr[8];
        attn::f32x16 acc[2]; acc[0] = attn::f32x16{}; acc[1] = attn::f32x16{};
        __syncthreads(); fft::st_tile(lds, v); __syncthreads();
        if (un < 512) fft::ld_rows(v, [&](int k) { return rowp(un, k); }, 0);
        fft::rd_tile(bfr, lds);
        const char* wrow = lds + WL + r32 * 256; const int x = r32 & 15;
#pragma unroll
        for (int t = 0; t < 2; ++t)
#pragma unroll
            for (int ks = 0; ks < 8; ++ks) {
                const attn::bf16x8 wfr = *(const attn::bf16x8*)(wrow + t * 8192 + (((2 * ks + hi) ^ x) << 4));
                acc[t] = __builtin_amdgcn_mfma_f32_32x32x16_bf16(wfr, bfr[ks], acc[t], 0, 0, 0);
            }
        bf16_t* stg = (bf16_t*)(lds + STG) + w * 2048;
#pragma unroll
        for (int t = 0; t < 2; ++t)
#pragma unroll
            for (int r = 0; r < 16; ++r) stg[(32 * t + attn::crow(r, hi)) * 32 + r32] = f2bf(acc[t][r]);
        asm volatile("s_waitcnt lgkmcnt(0)" ::: "memory");
#pragma unroll
        for (int i = 0; i < 4; ++i) { const int rr = i * 16 + (lane >> 2), c4 = lane & 3; const v4u vv = *(const v4u*)(stg + rr * 32 + c4 * 8);
            *(v4u*)(MIX + (size_t)(b * 4096 + s1p + 64 * rr) * 1024 + 32 * w + c4 * 8) = vv; }
        asm volatile("s_waitcnt lgkmcnt(0)" ::: "memory");
    }
    __syncthreads();
}

namespace hta {
using bf16x8 = __attribute__((ext_vector_type(8))) short;
using s16x4  = __attribute__((ext_vector_type(4))) short;
using f32x16 = __attribute__((ext_vector_type(16))) float;
using u32x4  = __attribute__((ext_vector_type(4))) unsigned;
constexpr int NW = 8, QBLK = 32, KVBLK = 64, NSLOT = 3, SLOTV = 8192;
constexpr float LOG2E = 1.4426950408889634f;
template <int MODE> struct Cfg;
template <> struct Cfg<0> { static constexpr int KD = 96; };
template <> struct Cfg<1> { static constexpr int KD = 64; };
template <int KD> struct Lds { static constexpr int SLOTK = KD * 128, K = 0, V = NSLOT * SLOTK, WS = V + NSLOT * SLOTV, OST = WS + NW * 64 * 4, BYTES = OST + NW * 4096; };
__device__ __forceinline__ int crow(int r, int hi) { return (r & 3) + 8 * (r >> 2) + 4 * hi; }
#define SBAR() __builtin_amdgcn_sched_barrier(0)
__device__ __forceinline__ void glds16(const void* gsrc, unsigned lds_dst) { unsigned keep;
  asm volatile("s_mov_b32 %0, m0\n\ts_mov_b32 m0, %2\n\ts_nop 0\n\tglobal_load_lds_dwordx4 %1, off\n\ts_mov_b32 m0, %0" : "=&s"(keep) : "v"(gsrc), "s"(lds_dst) : "memory"); }
__device__ __forceinline__ float max3f(float a, float b, float c) { float r; asm("v_max3_f32 %0, %1, %2, %3" : "=v"(r) : "v"(a), "v"(b), "v"(c)); return r; }
__device__ __forceinline__ float max2f(float a, float b) { float r; asm("v_max_f32_e32 %0, %1, %2" : "=v"(r) : "v"(a), "v"(b)); return r; }
__device__ __forceinline__ float fadd_s(float a, float b) { float r; asm("v_add_f32_e32 %0, %1, %2" : "=v"(r) : "v"(a), "v"(b)); return r; }
__device__ __forceinline__ float fsub_s(float a, float b) { float r; asm("v_sub_f32_e32 %0, %1, %2" : "=v"(r) : "v"(a), "v"(b)); return r; }
typedef float f32x2_t __attribute__((ext_vector_type(2))); typedef __bf16 bf16x2_t __attribute__((ext_vector_type(2)));
__device__ __forceinline__ unsigned cvtpk_s(float lo, float hi) { f32x2_t v = {lo, hi}; bf16x2_t b = __builtin_convertvector(v, bf16x2_t); return __builtin_bit_cast(unsigned, b); }
#define WAIT_BAR(N) asm volatile("s_waitcnt vmcnt(" #N ") lgkmcnt(0)\n\ts_barrier" ::: "memory")
typedef __attribute__((address_space(3))) const char* lds_cptr;
typedef short v4i16_t __attribute__((ext_vector_type(4)));
__device__ __forceinline__ void kload2(bf16x8* kf, lds_cptr kp, int j) { kf[2 * j] = *(const __attribute__((address_space(3))) bf16x8*)(kp + j * 2048); kf[2 * j + 1] = *(const __attribute__((address_space(3))) bf16x8*)(kp + j * 2048 + 512); }
__device__ __forceinline__ s16x4 vtr(lds_cptr p) { return __builtin_bit_cast(s16x4, __builtin_amdgcn_ds_read_tr16_b64_v4i16((__attribute__((address_space(3))) v4i16_t*)p)); }
__device__ __forceinline__ float rowmax(const f32x16& p0, const f32x16& p1) {
  float a = max3f(p0[0], p0[1], p1[0]), b = max3f(p0[2], p0[3], p1[1]); a = max3f(a, p1[2], p1[3]);
#pragma unroll
  for (int r = 4; r < 16; r += 4) { a = max3f(a, p0[r], p0[r + 1]); b = max3f(b, p0[r + 2], p0[r + 3]); a = max3f(a, p1[r], p1[r + 1]); b = max3f(b, p1[r + 2], p1[r + 3]); }
  const float m = max2f(a, b);
  auto rr = __builtin_amdgcn_permlane32_swap(__float_as_uint(m), __float_as_uint(m), false, false);
  return max2f(__uint_as_float(rr[0]), __uint_as_float(rr[1]));
}
__device__ __forceinline__ void pv(f32x16* o, int vb, bf16x8 pa0, bf16x8 pa1, bf16x8 pa2, bf16x8 pa3) {
#pragma unroll
  for (int d0 = 0; d0 < 2; ++d0) { s16x4 lo[4], hi[4];
#pragma unroll
    for (int ks = 0; ks < 4; ++ks) {
      asm volatile("ds_read_b64_tr_b16 %0,%1 offset:%c2" : "=&v"(lo[ks]) : "v"(vb), "i"(d0 * 4096 + ks * 1024) : "memory");
      asm volatile("ds_read_b64_tr_b16 %0,%1 offset:%c2" : "=&v"(hi[ks]) : "v"(vb), "i"(d0 * 4096 + ks * 1024 + 512) : "memory"); }
    asm volatile("s_waitcnt lgkmcnt(0)" ::: "memory"); SBAR();
#define PK(k) (bf16x8){lo[k][0], lo[k][1], lo[k][2], lo[k][3], hi[k][0], hi[k][1], hi[k][2], hi[k][3]}
    o[d0] = __builtin_amdgcn_mfma_f32_32x32x16_bf16(pa0, PK(0), o[d0], 0, 0, 0);
    o[d0] = __builtin_amdgcn_mfma_f32_32x32x16_bf16(pa1, PK(1), o[d0], 0, 0, 0);
    o[d0] = __builtin_amdgcn_mfma_f32_32x32x16_bf16(pa2, PK(2), o[d0], 0, 0, 0);
    o[d0] = __builtin_amdgcn_mfma_f32_32x32x16_bf16(pa3, PK(3), o[d0], 0, 0, 0);
#undef PK
  }
}
__device__ __forceinline__ void wmask(f32x16& p0, f32x16& p1, int kbase, int qpos, int hi) {
  const float NEG = -INFINITY;
#pragma unroll
  for (int r = 0; r < 16; ++r) { const int k0 = kbase + crow(r, hi) - qpos, k1 = k0 + 32;
    if (k0 > 128 || k0 < -128) p0[r] = NEG;
    if (k1 > 128 || k1 < -128) p1[r] = NEG; }
}

template <int MODE, int THRL>
__device__ __forceinline__ void unit(const P& p, int l, bool isctx, int b, int h, int q0, char* shm) {
  constexpr int KD = Cfg<MODE>::KD, NS = KD / 16, SLOTK = Lds<KD>::SLOTK, LDS_K = Lds<KD>::K, LDS_V = Lds<KD>::V, LDS_WS = Lds<KD>::WS, LDS_OST = Lds<KD>::OST;
  const int tid = tidx(), lane = tid & 63, r32 = lane & 31, hi = lane >> 5; const int wid = __builtin_amdgcn_readfirstlane(tid >> 6);
  const int qrow0 = isctx ? ML + b * 256 : b * 4096 + q0;
  const int qrow = qrow0 + wid * QBLK + r32, qpos = q0 + wid * QBLK + r32;
  const int kvh = h / 3;
  int kstart = 0, NT;
  if (MODE == 0) NT = isctx ? 4 : 68;
  else { if (isctx) NT = 4; else { kstart = max(0, q0 - 128); const int kend = min(S, q0 + 384); NT = 4 + (kend - kstart) / 64; } }
#define RB(t) (isctx ? ML + b * 256 + (t) * 64 : (MODE == 0 ? ((t) < 64 ? b * 4096 + (t) * 64 : ML + b * 256 + ((t) - 64) * 64) : ((t) < 4 ? ML + b * 256 + (t) * 64 : b * 4096 + kstart + ((t) - 4) * 64)))
  const unsigned lds0 = (unsigned)(uintptr_t)shm;
  float* wsf = (float*)(shm + LDS_WS) + wid * 64;
  const bf16_t* ksrc = (MODE == 0 ? ws_kn(p) + (size_t)(h * 8 + wid) * 512 : ws_ks(p) + (size_t)(kvh * 8 + wid) * 512) + lane * 8;
  const bf16_t* ksrc2 = ws_kr(p) + (size_t)(wid & 3) * 512 + lane * 8;
  const bf16_t* vsrc = (MODE == 0 ? ws_vm(p) + (size_t)(h * 2 + (wid >> 2)) * 2048 : ws_vs(p) + (size_t)(kvh * 2 + (wid >> 2)) * 2048) + (wid & 3) * 512 + lane * 8;
  constexpr int NH = MODE == 0 ? 6 : 2;
  const unsigned kdst = lds0 + LDS_K + wid * 1024, kdst2 = lds0 + LDS_K + (8 + (wid & 3)) * 1024, vdst = lds0 + LDS_V + wid * 1024;
#define KSL(x) (KD == 96 ? (x) + ((x) >> 1) : (x))
#define DMA_K(t, slot) do { const int tl_ = RB(t) >> 6; glds16(ksrc + (size_t)tl_ * (NH * 8 * 512), (unsigned)__builtin_amdgcn_readfirstlane(kdst + KSL(slot))); \
    if (MODE == 0) glds16(ksrc2 + (size_t)tl_ * (4 * 512), (unsigned)__builtin_amdgcn_readfirstlane(kdst2 + KSL(slot))); } while (0)
#define DMA_V(t, slot) glds16(vsrc + (size_t)(RB(t) >> 6) * (NH * 2 * 2048), (unsigned)__builtin_amdgcn_readfirstlane(vdst + (slot)))
  const int vb0 = (int)(lds0 + LDS_V) + ((lane >> 4) & 1) * 32 + (lane & 3) * 8 + (4 * hi + ((lane & 15) >> 2)) * 64;
  bf16x8 kf[2 * NS];
  const lds_cptr shm3 = (lds_cptr)shm; const lds_cptr kp0 = shm3 + LDS_K + hi * 1024 + r32 * 16; const lds_cptr vp0 = shm3 + LDS_V + ((lane >> 4) & 1) * 32 + (lane & 3) * 8 + (4 * hi + ((lane & 15) >> 2)) * 64;
  DMA_K(0, 0); DMA_V(0, 0); DMA_K(1, SLOTV);
  bf16x8 qr[NS];
  if (MODE == 0) {
    const bf16_t* Qw = ws_qm(p) + (size_t)qrow * QMW + hi * 8;
#pragma unroll
    for (int d0 = 0; d0 < 4; ++d0) qr[d0] = *reinterpret_cast<const bf16x8*>(Qw + h * 64 + d0 * 16);
#pragma unroll
    for (int d0 = 4; d0 < NS; ++d0) qr[d0] = *reinterpret_cast<const bf16x8*>(Qw + 384 + h * 32 + (d0 - 4) * 16);
  } else {
    const bf16_t* Qw = ws_qs(p) + (size_t)qrow * 384 + h * 64 + hi * 8;
#pragma unroll
    for (int d0 = 0; d0 < NS; ++d0) qr[d0] = *reinterpret_cast<const bf16x8*>(Qw + d0 * 16);
  }
  float mhat = 0.f, l_reg = 0.f; f32x16 o[2]; o[0] = f32x16{}; o[1] = f32x16{}; f32x16 negm = f32x16{}; asm volatile("" : "+v"(negm));
#define CMASK(P0, P1, t) do { if (MODE == 1 && !isctx && (t) >= 4) wmask(P0, P1, kstart + ((t) - 4) * 64, qpos, hi); } while (0)
  bool resc = false;
#define START(P0, P1) do { const float rm = rowmax(P0, P1); resc = false; \
    { const float dl = rm; mhat = fadd_s(mhat, dl); \
      _Pragma("unroll") for (int r = 0; r < 16; ++r) { P0[r] = fsub_s(P0[r], dl); P1[r] = fsub_s(P1[r], dl); } \
      _Pragma("unroll") for (int r = 0; r < 16; ++r) negm[r] = -mhat; asm volatile("" : "+v"(negm)); } \
    _Pragma("unroll") for (int r = 0; r < 16; ++r) P0[r] = __builtin_amdgcn_exp2f(P0[r]); } while (0)
#define RESC() do { if (resc) { asm volatile("s_waitcnt lgkmcnt(0)" ::: "memory"); \
      _Pragma("unroll") for (int d_ = 0; d_ < 2; ++d_) _Pragma("unroll") for (int r = 0; r < 16; ++r) o[d_][r] *= wsf[crow(r, hi)]; } } while (0)
  f32x16 pA0, pA1, pB0, pB1;
  int sl_prev = 0, sl_cur = 0, sl_next = SLOTV;
#define ROT() do { sl_prev = sl_cur; sl_cur = sl_next; sl_next = (sl_next == (NSLOT - 1) * SLOTV) ? 0 : sl_next + SLOTV; } while (0)
  DMA_K(2, 2 * SLOTV);
  WAIT_BAR(0);
  { const char* kb = shm + LDS_K + hi * 1024 + r32 * 16;
#pragma unroll
    for (int d0 = 0; d0 < NS; ++d0) {
      const bf16x8 b0 = *reinterpret_cast<const bf16x8*>(kb + d0 * 2048);
      const bf16x8 b1 = *reinterpret_cast<const bf16x8*>(kb + d0 * 2048 + 512);
      if (d0 == 0) { pA0 = __builtin_amdgcn_mfma_f32_32x32x16_bf16(b0, qr[0], negm, 0, 0, 0); pA1 = __builtin_amdgcn_mfma_f32_32x32x16_bf16(b1, qr[0], negm, 0, 0, 0); }
      else { pA0 = __builtin_amdgcn_mfma_f32_32x32x16_bf16(b0, qr[d0], pA0, 0, 0, 0); pA1 = __builtin_amdgcn_mfma_f32_32x32x16_bf16(b1, qr[d0], pA1, 0, 0, 0); } } }
  asm volatile("s_nop 15\n\ts_nop 7" : "+v"(pA0), "+v"(pA1)); CMASK(pA0, pA1, 0);
  START(pA0, pA1);
  _Pragma("unroll") for (int r = 0; r < 16; ++r) pA1[r] = __builtin_amdgcn_exp2f(pA1[r]);
  WAIT_BAR(0);
  DMA_K(3, 0); DMA_V(1, SLOTV);
  ROT();
#pragma unroll
  for (int j = 0; j < NS; ++j) kload2(kf, kp0 + KSL(sl_cur), j);
  if (MODE == 0) WAIT_BAR(3); else WAIT_BAR(2);
  s16x4 vlo[8], vhi[8]; u32x4 pw0, pw1, pw2, pw3;
#define PKW(P, B) cvtpk_s(P[B], P[B + 1])
#define PAF(k) __builtin_bit_cast(bf16x8, pw##k)
#define VFR(i) (bf16x8){vlo[i][0], vlo[i][1], vlo[i][2], vlo[i][3], vhi[i][0], vhi[i][1], vhi[i][2], vhi[i][3]}
#define PIN(x) asm volatile("" : "+v"(x))
#define MX3(a, b, c) __builtin_fmaxf(__builtin_fmaxf((a), (b)), (c))
#define PR(P, i) __builtin_shufflevector(P, P, i, (i) + 1)
#define GAPA(MF, PA, PB, W0, W1, PW) do { MF; s2 += PA; s2 += PB; PIN(s2); W0; W1; PIN(PW); SBAR(); } while (0)
#define GAPA1(MF, PA, W0, W1, PW) do { MF; s2 += PA; PIN(s2); W0; W1; PIN(PW); SBAR(); } while (0)
#define GAPA0(MF) do { MF; SBAR(); } while (0)
#define EX(v) __builtin_amdgcn_exp2f(v)
#define GAPB(MF, X, B) do { MF; X[B] = EX(X[B]); X[B + 1] = EX(X[B + 1]); X[B + 2] = EX(X[B + 2]); X[B + 3] = EX(X[B + 3]); PIN(X); SBAR(); } while (0)
#define VRD(i) do { vlo[i] = vtr(vp_ + (((i) >> 2) * 4096 + ((i) & 3) * 1024)); vhi[i] = vtr(vp_ + (((i) >> 2) * 4096 + ((i) & 3) * 1024 + 512)); } while (0)
#define KRD(G, j) do { if (G) { kload2(kf, kp0 + KSL(sl_next), j); SBAR(); } } while (0)
#define STEP(C0, C1, P0, P1, t, GK, GV, GL) do { SBAR(); \
    const lds_cptr vp_ = vp0 + sl_prev; \
    f32x2_t s2 = PR(P0, 0); \
    if constexpr (NS == 4) { VRD(0); SBAR(); \
    GAPA(C0 = __builtin_amdgcn_mfma_f32_32x32x16_bf16(kf[0], qr[0], negm, 0, 0, 0), PR(P0, 2), PR(P0, 4),     pw0[0] = PKW(P0, 0), pw0[1] = PKW(P0, 2), pw0); \
    VRD(4); SBAR(); GAPA(C1 = __builtin_amdgcn_mfma_f32_32x32x16_bf16(kf[1], qr[0], negm, 0, 0, 0), PR(P0, 6), PR(P0, 8),     pw0[2] = PKW(P0, 4), pw0[3] = PKW(P0, 6), pw0); \
    VRD(1); SBAR(); GAPA(C0 = __builtin_amdgcn_mfma_f32_32x32x16_bf16(kf[2], qr[1], C0, 0, 0, 0),   PR(P0, 10), PR(P0, 12), pw1[0] = PKW(P0, 8), pw1[1] = PKW(P0, 10), pw1); \
    VRD(5); SBAR(); GAPA(C1 = __builtin_amdgcn_mfma_f32_32x32x16_bf16(kf[3], qr[1], C1, 0, 0, 0),   PR(P0, 14), PR(P1, 0),   pw1[2] = PKW(P0, 12), pw1[3] = PKW(P0, 14), pw1); \
    VRD(2); SBAR(); GAPA(C0 = __builtin_amdgcn_mfma_f32_32x32x16_bf16(kf[4], qr[2], C0, 0, 0, 0),   PR(P1, 2), PR(P1, 4),     pw2[0] = PKW(P1, 0), pw2[1] = PKW(P1, 2), pw2); \
    VRD(6); SBAR(); GAPA(C1 = __builtin_amdgcn_mfma_f32_32x32x16_bf16(kf[5], qr[2], C1, 0, 0, 0),   PR(P1, 6), PR(P1, 8),     pw2[2] = PKW(P1, 4), pw2[3] = PKW(P1, 6), pw2); \
    VRD(3); SBAR(); GAPA(C0 = __builtin_amdgcn_mfma_f32_32x32x16_bf16(kf[6], qr[3], C0, 0, 0, 0),   PR(P1, 10), PR(P1, 12), pw3[0] = PKW(P1, 8), pw3[1] = PKW(P1, 10), pw3); \
    VRD(7); SBAR(); GAPA1(C1 = __builtin_amdgcn_mfma_f32_32x32x16_bf16(kf[7], qr[3], C1, 0, 0, 0),   PR(P1, 14),       pw3[2] = PKW(P1, 12), pw3[3] = PKW(P1, 14), pw3); \
    } else { \
    VRD(0); SBAR(); C0 = __builtin_amdgcn_mfma_f32_32x32x16_bf16(kf[0], qr[0], negm, 0, 0, 0); s2 += PR(P0, 2); PIN(s2); pw0[0] = PKW(P0, 0); pw0[1] = PKW(P0, 2); PIN(pw0); SBAR(); \
    VRD(4); SBAR(); C1 = __builtin_amdgcn_mfma_f32_32x32x16_bf16(kf[1], qr[0], negm, 0, 0, 0); s2 += PR(P0, 4); PIN(s2); pw0[2] = PKW(P0, 4); PIN(pw0); SBAR(); \
    C0 = __builtin_amdgcn_mfma_f32_32x32x16_bf16(kf[2], qr[1], C0, 0, 0, 0); s2 += PR(P0, 6); s2 += PR(P0, 8); PIN(s2); pw0[3] = PKW(P0, 6); PIN(pw0); SBAR(); \
    VRD(1); SBAR(); C1 = __builtin_amdgcn_mfma_f32_32x32x16_bf16(kf[3], qr[1], C1, 0, 0, 0); s2 += PR(P0, 10); PIN(s2); pw1[0] = PKW(P0, 8); pw1[1] = PKW(P0, 10); PIN(pw1); SBAR(); \
    VRD(5); SBAR(); C0 = __builtin_amdgcn_mfma_f32_32x32x16_bf16(kf[4], qr[2], C0, 0, 0, 0); s2 += PR(P0, 12); PIN(s2); pw1[2] = PKW(P0, 12); PIN(pw1); SBAR(); \
    C1 = __builtin_amdgcn_mfma_f32_32x32x16_bf16(kf[5], qr[2], C1, 0, 0, 0); s2 += PR(P0, 14); s2 += PR(P1, 0); PIN(s2); pw1[3] = PKW(P0, 14); PIN(pw1); SBAR(); \
    VRD(2); SBAR(); C0 = __builtin_amdgcn_mfma_f32_32x32x16_bf16(kf[6], qr[3], C0, 0, 0, 0); s2 += PR(P1, 2); PIN(s2); pw2[0] = PKW(P1, 0); pw2[1] = PKW(P1, 2); PIN(pw2); SBAR(); \
    VRD(6); SBAR(); C1 = __builtin_amdgcn_mfma_f32_32x32x16_bf16(kf[7], qr[3], C1, 0, 0, 0); s2 += PR(P1, 4); PIN(s2); pw2[2] = PKW(P1, 4); PIN(pw2); SBAR(); \
    C0 = __builtin_amdgcn_mfma_f32_32x32x16_bf16(kf[8], qr[4], C0, 0, 0, 0); s2 += PR(P1, 6); s2 += PR(P1, 8); PIN(s2); pw2[3] = PKW(P1, 6); PIN(pw2); SBAR(); \
    VRD(3); SBAR(); C1 = __builtin_amdgcn_mfma_f32_32x32x16_bf16(kf[9], qr[4], C1, 0, 0, 0); s2 += PR(P1, 10); PIN(s2); pw3[0] = PKW(P1, 8); pw3[1] = PKW(P1, 10); PIN(pw3); SBAR(); \
    VRD(7); SBAR(); C0 = __builtin_amdgcn_mfma_f32_32x32x16_bf16(kf[10], qr[5], C0, 0, 0, 0); s2 += PR(P1, 12); PIN(s2); pw3[2] = PKW(P1, 12); PIN(pw3); SBAR(); \
    C1 = __builtin_amdgcn_mfma_f32_32x32x16_bf16(kf[11], qr[5], C1, 0, 0, 0); s2 += PR(P1, 14); PIN(s2); pw3[3] = PKW(P1, 14); PIN(pw3); SBAR(); \
    } \
    l_reg += s2[0] + s2[1]; \
    if (GK) { DMA_K((t) + 3, sl_cur); } if (GV) { DMA_V((t) + 1, sl_next); } \
    CMASK(C0, C1, t); \
    { float a = MX3(C0[0], C0[1], C1[0]), b_ = MX3(C0[2], C0[3], C1[1]); a = MX3(a, C1[2], C1[3]); \
      _Pragma("unroll") for (int r = 4; r < 16; r += 4) { a = MX3(a, C0[r], C0[r + 1]); b_ = MX3(b_, C0[r + 2], C0[r + 3]); a = MX3(a, C1[r], C1[r + 1]); b_ = MX3(b_, C1[r + 2], C1[r + 3]); } \
      float rm = __builtin_fmaxf(a, b_); { auto rr = __builtin_amdgcn_permlane32_swap(__float_as_uint(rm), __float_as_uint(rm), false, false); rm = __builtin_fmaxf(__uint_as_float(rr[0]), __uint_as_float(rr[1])); } \
      resc = false; \
      if (__builtin_expect(__any(rm > (float)THRL), 0)) { const float dl = __builtin_fmaxf(rm, 0.f); mhat += dl; \
        _Pragma("unroll") for (int r = 0; r < 16; ++r) { C0[r] -= dl; C1[r] -= dl; } \
        _Pragma("unroll") for (int r = 0; r < 16; ++r) negm[r] = -mhat; asm volatile("" : "+v"(negm)); \
        const float f = __builtin_amdgcn_exp2f(-dl); l_reg *= f; if (hi == 0) wsf[r32] = f; resc = true; } } \
    SBAR(); \
    GAPB(o[0] = __builtin_amdgcn_mfma_f32_32x32x16_bf16(PAF(0), VFR(0), o[0], 0, 0, 0), C0, 0); \
    GAPB(o[1] = __builtin_amdgcn_mfma_f32_32x32x16_bf16(PAF(0), VFR(4), o[1], 0, 0, 0), C0, 4); \
    KRD(GL, 0); GAPB(o[0] = __builtin_amdgcn_mfma_f32_32x32x16_bf16(PAF(1), VFR(1), o[0], 0, 0, 0), C0, 8); \
    KRD(GL, 1); GAPB(o[1] = __builtin_amdgcn_mfma_f32_32x32x16_bf16(PAF(1), VFR(5), o[1], 0, 0, 0), C0, 12); \
    KRD(GL, 2); GAPB(o[0] = __builtin_amdgcn_mfma_f32_32x32x16_bf16(PAF(2), VFR(2), o[0], 0, 0, 0), C1, 0); \
    KRD(GL, 3); GAPB(o[1] = __builtin_amdgcn_mfma_f32_32x32x16_bf16(PAF(2), VFR(6), o[1], 0, 0, 0), C1, 4); \
    if constexpr (NS == 6) { KRD(GL, 4); } GAPB(o[0] = __builtin_amdgcn_mfma_f32_32x32x16_bf16(PAF(3), VFR(3), o[0], 0, 0, 0), C1, 8); \
    if constexpr (NS == 6) { KRD(GL, 5); } GAPB(o[1] = __builtin_amdgcn_mfma_f32_32x32x16_bf16(PAF(3), VFR(7), o[1], 0, 0, 0), C1, 12); \
    } while (0)
#define WB_FULL() do { if (MODE == 0) WAIT_BAR(3); else WAIT_BAR(2); } while (0)
  int t = 1;
  for (; t + 5 < NT; t += 2) {
    STEP(pB0, pB1, pA0, pA1, t, true, true, true);     WB_FULL(); RESC(); ROT();
    STEP(pA0, pA1, pB0, pB1, t + 1, true, true, true); WB_FULL(); RESC(); ROT();
  }
#define ENDW(tt) do { if ((tt) + 3 < NT) { WB_FULL(); } else if ((tt) + 2 < NT) { WAIT_BAR(1); } else { WAIT_BAR(0); } } while (0)
  for (; t + 1 < NT; t += 2) {
    STEP(pB0, pB1, pA0, pA1, t, (t + 3 < NT), (t + 1 < NT), (t + 1 < NT));       ENDW(t);     RESC(); ROT();
    STEP(pA0, pA1, pB0, pB1, t + 1, (t + 4 < NT), (t + 2 < NT), (t + 2 < NT));   ENDW(t + 1); RESC(); ROT();
  }
  STEP(pB0, pB1, pA0, pA1, NT - 1, false, false, false); RESC();
  { float sacc = pB0[0] + pB0[1]; _Pragma("unroll") for (int r = 2; r < 16; ++r) sacc += pB0[r]; _Pragma("unroll") for (int r = 0; r < 16; ++r) sacc += pB1[r]; l_reg += sacc;
    pw0 = (u32x4){PKW(pB0, 0), PKW(pB0, 2), PKW(pB0, 4), PKW(pB0, 6)}; pw1 = (u32x4){PKW(pB0, 8), PKW(pB0, 10), PKW(pB0, 12), PKW(pB0, 14)}; pw2 = (u32x4){PKW(pB1, 0), PKW(pB1, 2), PKW(pB1, 4), PKW(pB1, 6)}; pw3 = (u32x4){PKW(pB1, 8), PKW(pB1, 10), PKW(pB1, 12), PKW(pB1, 14)};
    SBAR(); pv(o, vb0 + sl_cur, PAF(0), PAF(1), PAF(2), PAF(3)); }
#undef PKW
#undef PAF
#undef VFR
#undef PIN
#undef MX3
#undef GAPA
#undef GAPA1
#undef PR
#undef GAPA0
#undef GAPB
#undef EX
#undef VRD
#undef KRD
#undef STEP
#undef ENDW
#undef WB_FULL
  { auto rr = __builtin_amdgcn_permlane32_swap(__float_as_uint(l_reg), __float_as_uint(l_reg), false, false); l_reg = __uint_as_float(rr[0]) + __uint_as_float(rr[1]); }
  if (MODE == 1) l_reg += __builtin_amdgcn_exp2f(p.sink[l * 6 + h] * LOG2E - mhat);
  if (hi == 0) wsf[32 + r32] = l_reg; asm volatile("s_waitcnt lgkmcnt(0)" ::: "memory");
  float rli[16];
#pragma unroll
  for (int r = 0; r < 16; ++r) rli[r] = __builtin_amdgcn_rcpf(wsf[32 + crow(r, hi)]);
  bf16_t* Ow = ws_mix(p) + (size_t)(qrow0 + wid * QBLK) * 1024 + (MODE == 0 ? 640 : 256) + h * 64;
  { bf16_t* stg = (bf16_t*)(shm + LDS_OST) + wid * 2048;
#pragma unroll
    for (int r = 0; r < 16; ++r) { const int orow = crow(r, hi);
#pragma unroll
      for (int d0 = 0; d0 < 2; ++d0) stg[orow * 64 + d0 * 32 + r32] = f2bf(o[d0][r] * rli[r]); }
    asm volatile("s_waitcnt lgkmcnt(0)" ::: "memory");
#pragma unroll
    for (int i = 0; i < 4; ++i) { const int row = i * 8 + (lane >> 3), ch = lane & 7; const u32x4 v = *(const u32x4*)(stg + row * 64 + ch * 8); *(u32x4*)(Ow + (size_t)row * 1024 + ch * 8) = v; } }
  asm volatile("s_waitcnt lgkmcnt(0)\n\ts_barrier" ::: "memory");
#undef DMA_K
#undef DMA_V
#undef KSL
#undef RB
#undef CMASK
#undef START
#undef RESC
#undef ROT
}
#undef SBAR
#undef WAIT_BAR
}

__device__ __forceinline__ void fp_attn(const P& p, int l, bool with_ctx, LAS unsigned char* lds, int bid, int nb) {
    const int n_lat = 8 * 6 * 16, n_ctx = with_ctx ? 8 * 6 : 0, per = n_lat + n_ctx;
    const int vcu = (nb % 8 == 0) ? (bid % 8) * (nb / 8) + bid / 8 : bid;
    for (int u = vcu; u < 2 * per; u += nb) {
        const int mode = u / per; int r = u % per;
        bool isctx = false; int b, h, q0;
        if (r < n_lat) { b = r / 96; const int r2 = r % 96; h = r2 / 16; q0 = (r2 % 16) * 256; }
        else { isctx = true; r -= n_lat; b = r / 6; h = r % 6; q0 = 0; }
        if (mode == 0) hta::unit<0, 8>(p, l, isctx, b, h, q0, (char*)lds);
        else hta::unit<1, 8>(p, l, isctx, b, h, q0, (char*)lds);
    }
}


__device__ __forceinline__ void fp_final(const P& p, int bid, int nb) {
    const int lane = tidx() & 63, gw = bid * 8 + (tidx() >> 6), nw = nb * 8;
    for (int row = gw; row < ML; row += nw) {
        const float pr = lane < 16 ? ws_rssh(p)[(size_t)row * 16 + lane] : 0.f;
        const float r = 1.0f / sqrtf(wave_sum(pr) * (1.0f / 1024.0f) + EPS);
        const v4u* x = (const v4u*)(ws_xn(p) + (size_t)row * 1024); f32x4* o = (f32x4*)(p.out + (size_t)row * D);
#pragma unroll
        for (int j = 0; j < 2; ++j) { const v4u w = x[lane + 64 * j];
            __builtin_nontemporal_store((f32x4){__uint_as_float(w.x << 16), __uint_as_float(w.x & 0xffff0000u), __uint_as_float(w.y << 16), __uint_as_float(w.y & 0xffff0000u)} * r, o + 2 * (lane + 64 * j));
            __builtin_nontemporal_store((f32x4){__uint_as_float(w.z << 16), __uint_as_float(w.z & 0xffff0000u), __uint_as_float(w.w << 16), __uint_as_float(w.w & 0xffff0000u)} * r, o + 2 * (lane + 64 * j) + 1); }
    }
}


struct CtxSplitOrder {
    int G, c;
    __device__ __forceinline__ bool next(int i, pg8::Unit& u) const { const int v = i * G + c; if (v >= 256) return false; const int t = v & 31, ks = v >> 5; u.pm = ML / 256 + (t >> 2); u.pn = t & 3; u.ko = ks * 512; return true; }
    __device__ __forceinline__ void a_ready(const pg8::Unit&) const {}
    __device__ __forceinline__ void done(const pg8::Unit&) const {}
};
struct EpiSlab {
    static constexpr bool PERM = true, AFTER_DRAIN = false;
    float* slab;
    __device__ __forceinline__ void operator()(const pg8::f32x4 (&acc)[2][2][4][2], const pg8::Unit& u, int wr, int wc, int fr, int fq) const {
        float* base = slab + (size_t)(u.ko >> 9) * MC * 1024 + u.pn * 256 + wc * 32 + 8 * fq;
#pragma unroll
        for (int ai = 0; ai < 2; ++ai)
#pragma unroll
            for (int m = 0; m < 4; ++m) {
                float* o = base + (size_t)(u.pm * 256 - ML + ai * 128 + wr * 64 + m * 16 + fr) * 1024;
#pragma unroll
                for (int bj = 0; bj < 2; ++bj) { *(pg8::f32x4*)(o + bj * 128) = acc[ai][bj][m][0]; *(pg8::f32x4*)(o + bj * 128 + 4) = acc[ai][bj][m][1]; }
            }
    }
};
__device__ __forceinline__ void fp_ctx_finalize(const P& p, int bid, int nb) {
    const int tid = tidx(), lane = tid & 63, gw = bid * 8 + (tid >> 6), NGW = nb * 8;
    const float* slab = (const float*)(p.ws + O_MIX);
    const float* gate = ws_mod(p) + (size_t)8 * 6144 + 5120; const float* gm = ws_gm(p, 1, 0) + 8 * 1024; const float* gmi = ws_gm(p, 0, 1) + 8 * 1024;
    for (int r = gw; r < MC; r += NGW) {
        bf16_t* xr = ws_xn(p) + (size_t)(ML + r) * 1024; float ss = 0.f;
#pragma unroll
        for (int j = 0; j < 4; ++j) {
            const int c = 4 * lane + 256 * j;
            f32x4 s = *(const f32x4*)(slab + (size_t)r * 1024 + c);
#pragma unroll
            for (int ks = 1; ks < 8; ++ks) s += *(const f32x4*)(slab + ((size_t)ks * MC + r) * 1024 + c);
            const v2u w_ = *(const v2u*)(xr + c); const f32x4 gi = *(const f32x4*)(gmi + c);
            const f32x4 ho = (f32x4){__uint_as_float(w_.x << 16) / gi.x, __uint_as_float(w_.x & 0xffff0000u) / gi.y, __uint_as_float(w_.y << 16) / gi.z, __uint_as_float(w_.y & 0xffff0000u) / gi.w};
            const f32x4 hn = ho + *(const f32x4*)(gate + c) * s;
            ss += (hn.x * hn.x + hn.y * hn.y) + (hn.z * hn.z + hn.w * hn.w);
            const f32x4 y = hn * *(const f32x4*)(gm + c);
            v2u w; w.x = pk2(y.x, y.y); w.y = pk2(y.z, y.w); *(v2u*)(xr + c) = w;
        }
        ss = wave_sum(ss);
        if (lane < 16) ws_rssh(p)[(size_t)(ML + r) * 16 + lane] = lane == 0 ? ss : 0.f;
    }
}
__device__ __forceinline__ void run_fast(const P& p_arg, int l, int ph, LAS unsigned char* lds, int bid, int nb) {
#if MEGA && defined(__HIP_DEVICE_COMPILE__)
    const __attribute__((address_space(4))) P* kp = (const __attribute__((address_space(4))) P*)__builtin_amdgcn_kernarg_segment_ptr();
    asm volatile("" : "+s"(kp));
    const P p = *kp;
#else
    const P& p = p_arg;
#endif
    const bool last = (l == DEPTH - 1);
    const int nrows = last ? ML : MT;
    switch (ph) {
        case 100: fp_mods(p, lds, bid, nb); fp_tables(p, bid, nb); fp_fftw(p, bid, nb); fp_weights(p, lds, bid, nb); break;
        case 112: fp_weights_in(p, lds, bid, nb); fp_gm(p, bid, nb); break;
        case 114: fp_bias(p, bid, nb); break;
        case 113: fp_final(p, bid, nb); break;
        case 110: fp_fft_a(p, !last, lds, bid, nb); break;
        case 111: fp_fft_b(p, lds, bid, nb); break;
        case 101: fp_xn(p, l, 0, MT, bid, nb); break;
        case 102: { pg8::Gemm g{ws_xn(p), ws_win_t(p, l), MT, NIN_PAD, 1024, 1024, 0}; pg8::StaticOrder S; S.init(MT, NIN_PAD, nb, bid);
                    EpiInproj E{ws_zf(p), ws_qs(p), ws_ks(p), ws_vs(p), ws_cq(p), ws_ckv(p), ws_kr(p), ws_rssq(p), ws_rsskv(p), ws_cosh(p), ws_sinh(p), ws_cosr(p), ws_sinr(p),
                                l == 0 ? nullptr : ws_rssh(p), ws_bias1(p)};
                    pg8::gemm_phase<EpiInproj, pg8::StaticOrder, true, true>(lds, g, S, E); } break;
        case 108: { pg8::Gemm g{ws_cq(p), ws_wuq_t(p, l), nrows, NUQ_PAD, 256, 256, 0}; pg8::StaticOrder S; S.init(nrows, NUQ_PAD, nb, bid);
                    EpiUpQ E{ws_qm(p), ws_rssq(p), ws_cosr(p), ws_sinr(p)}; pg8::gemm_phase<EpiUpQ, pg8::StaticOrder, true, true>(lds, g, S, E); } break;
        case 109: { pg8::Gemm g{ws_ckv(p), ws_wukv_t(p, l), MT, NUKV, 128, 128, 0}; pg8::StaticOrder S; S.init(MT, NUKV, nb, bid);
                    EpiUpKV E{ws_kn(p), ws_vm(p), ws_rsskv(p)}; pg8::gemm_phase<EpiUpKV, pg8::StaticOrder, true, true>(lds, g, S, E); } break;
        case 107: fp_attn(p, l, !last, lds, bid, nb); break;
        case 103: { pg8::Gemm g{ws_mix(p), ws_wout_t(p, l), nrows, 1024, 1024, 1024, 0}; pg8::StaticOrder S; S.init(nrows, 1024, nb, bid);
                    EpiResidA E{l == 0 ? p.x : nullptr, p.ctx, ws_gm(p, 1, 0), nullptr, ws_mod(p) + (size_t)(l * 9) * 6144 + 2048, ws_gm(p, l, 1), ws_xn(p), ws_rssh(p)};
                    pg8::gemm_phase<EpiResidA, pg8::StaticOrder, true, true>(lds, g, S, E); } break;
        case 104: fp_xn(p, l, 1, nrows, bid, nb); break;
        case 105: { pg8::Gemm g{ws_xn(p), ws_w1_t(p, l), nrows, DFF, 1024, 1024, 0}; pg8::StaticOrder S; S.init(nrows, DFF, nb, bid);
                    EpiMlp1 E{ws_hid(p), ws_rssh(p), ws_bias2(p, l)}; pg8::gemm_phase<EpiMlp1, pg8::StaticOrder, true, true>(lds, g, S, E); } break;
        case 106: { const int mrows = ML;
                    pg8::Gemm g{ws_hid(p), ws_w2_t(p, l), mrows, 1024, DFF, DFF, 1}; pg8::StaticOrder S; S.init(mrows, 1024, nb, bid);
                    EpiResidA E{nullptr, nullptr, ws_gm(p, l, 1), nullptr, ws_mod(p) + (size_t)(l * 9) * 6144 + 5120, last ? ws_gfin(p) : ws_gm(p, 1, 0), ws_xn(p), ws_rssh(p)};
                    pg8::gemm_phase<EpiResidA, pg8::StaticOrder, true, true>(lds, g, S, E); } break;
        case 117: { pg8::Gemm g{ws_hid(p), ws_w2_t(p, 0), MT, 1024, 512, DFF, 1}; CtxSplitOrder S{nb, bid};
                    EpiSlab E{(float*)(p.ws + O_MIX)}; pg8::gemm_phase<EpiSlab, CtxSplitOrder, true, true>(lds, g, S, E); } break;
        case 118: fp_ctx_finalize(p, bid, nb); break;
    }
}
typedef GAS unsigned gu32;
#define RLX_AGENT __ATOMIC_RELAXED, __HIP_MEMORY_SCOPE_AGENT
#define XB_TMO      128
#define XB_XCNT(j)  (256  + 64 * (j))
#define XB_XSUB(j)  (1280 + 64 * (j))
#define XB_XGEN(j)  (2304 + 64 * (j))
#define XB_TOP      3328
#define XB_TOPGEN   3392
#define XCD_BAR_WORDS 3456
#define XB_SPIN_CAP (1u << 18)

__device__ __forceinline__ unsigned xb_ld(unsigned* p)              { return __hip_atomic_load(p, __ATOMIC_RELAXED, __HIP_MEMORY_SCOPE_AGENT); }
__device__ __forceinline__ unsigned xb_add(unsigned* p, unsigned v) { return __hip_atomic_fetch_add(p, v, __ATOMIC_RELAXED, __HIP_MEMORY_SCOPE_AGENT); }
__device__ __forceinline__ unsigned xb_xcc_id() { return (unsigned)__builtin_amdgcn_s_getreg((3 << 11) | 20) & 0xFu; }
#define XB_SPIN(cond, bar) do { unsigned _sp = 0; while (cond) { __builtin_amdgcn_s_sleep(1); \
    if ((++_sp & 255u) == 0u) { if (xb_ld(&(bar)[XB_TMO])) break; if (_sp > XB_SPIN_CAP) { atomicAdd(&(bar)[XB_TMO], 1u); break; } } } } while (0)

struct XcdBarrier {
    unsigned* bar; unsigned x;
    volatile LAS unsigned* st;
};

__device__ __forceinline__ XcdBarrier xcd_barrier_post(unsigned* bar, volatile LAS unsigned* st) {
    XcdBarrier b; b.bar = bar; b.x = xb_xcc_id(); b.st = st;
    if (threadIdx.x == 0) (void)xb_add(&bar[XB_XCNT(b.x)], 1u);
    return b;
}
__device__ __forceinline__ void xcd_barrier_complete(unsigned* bar, unsigned x, unsigned& nloc, unsigned& nx) {
    const unsigned G = gridDim.x * gridDim.y * gridDim.z;
    unsigned sum, cnt, mine, sp = 0u;
    for (;;) {
        sum = 0u; cnt = 0u; mine = 0u;
#pragma unroll
        for (unsigned j = 0; j < 16; ++j) { const unsigned c = xb_ld(&bar[XB_XCNT(j)]); sum += c; cnt += (c > 0u) ? 1u : 0u; mine = (j == x) ? c : mine; }
        if (sum == G) break;
        __builtin_amdgcn_s_sleep(1);
        if ((++sp & 255u) == 0u) { if (xb_ld(&bar[XB_TMO])) break; if (sp > XB_SPIN_CAP) { atomicAdd(&bar[XB_TMO], 1u); break; } }
    }
    nloc = mine > 0u ? mine : 1u; nx = cnt > 0u ? cnt : 1u;
}

__device__ __forceinline__ void xcd_barrier(const XcdBarrier& b) {
    asm volatile("s_waitcnt vmcnt(0)" ::: "memory");
    __syncthreads();
    if (threadIdx.x == 0) {
        unsigned* bar = b.bar;
        __builtin_amdgcn_s_waitcnt(0);
        unsigned nloc = b.st[0], nx = b.st[1];
        if (nloc == 0u) { xcd_barrier_complete(bar, b.x, nloc, nx); b.st[0] = nloc; b.st[1] = nx; }
        const unsigned old = xb_add(&bar[XB_XSUB(b.x)], 1u);
        const unsigned gen = old / nloc;
        if (old + 1u == (gen + 1u) * nloc) {
            __builtin_amdgcn_fence(__ATOMIC_RELEASE, "agent");
            asm volatile("s_waitcnt vmcnt(0)" ::: "memory");
            const unsigned og = xb_add(&bar[XB_TOP], 1u);
            const unsigned tg = og / nx;
            if (og + 1u == (tg + 1u) * nx) xb_add(&bar[XB_TOPGEN], 1u);
            else XB_SPIN(xb_ld(&bar[XB_TOPGEN]) == tg, bar);
            __builtin_amdgcn_fence(__ATOMIC_ACQUIRE, "agent");
            xb_add(&bar[XB_XGEN(b.x)], 1u);
            asm volatile("s_waitcnt vmcnt(0)" ::: "memory");
        } else {
            XB_SPIN(xb_ld(&bar[XB_XGEN(b.x)]) == gen, bar);
            __builtin_amdgcn_fence(__ATOMIC_ACQUIRE, "agent");
            asm volatile("s_waitcnt vmcnt(0)" ::: "memory");
        }
    }
    __syncthreads();
}

#if MEGA
constexpr size_t O_CTL = 476 * MiB; constexpr size_t CTL_BYTES = 65536;
constexpr int LDS_MISC_OFF = 131072 + 320;
__device__ __forceinline__ void gsync(LAS unsigned char* lds) {
#if defined(__HIP_DEVICE_COMPILE__)
    const __attribute__((address_space(4))) P* kp = (const __attribute__((address_space(4))) P*)__builtin_amdgcn_kernarg_segment_ptr();
    asm volatile("" : "+s"(kp));
    XcdBarrier b; b.bar = (unsigned*)(kp->ws + O_CTL); b.x = xb_xcc_id(); b.st = (volatile LAS unsigned*)(lds + LDS_MISC_OFF) + 8;
    xcd_barrier(b);
#endif
}
__global__ void __launch_bounds__(FAST_THREADS, 2) mega_kernel(P p) {
    extern __shared__ __attribute__((aligned(16))) unsigned char lds_raw[];
    LAS unsigned char* lds = (LAS unsigned char*)lds_raw;
    cg::grid_group grid = cg::this_grid();
    const int bid = blockIdx.x, nb = gridDim.x;
    volatile LAS unsigned* MISC = (volatile LAS unsigned*)(lds + LDS_MISC_OFF);
    if (threadIdx.x < 32) MISC[threadIdx.x] = 0u;
    __syncthreads();
    (void)xcd_barrier_post((unsigned*)(p.ws + O_CTL), MISC + 8);
#define PH(l, ph) do { run_fast(p, l, ph, lds, bid, nb); if (PROBE_PH == (ph)) { gsync(lds); run_fast(p, l, ph, lds, bid, nb); } } while (0)
#define GSYNC() gsync(lds)
    if (nb == 0x7fffffff) grid.sync();
    PH(0, 100); GSYNC();
    PH(0, 112); PH(0, 101); GSYNC();
#pragma unroll 1
    for (int l = 0; l < DEPTH; ++l) {
        PH(l, 102); GSYNC();
        PH(l, 108); PH(l, 109); PH(l, 110); if (l == 0) PH(l, 114); GSYNC();
        PH(l, 107); PH(l, 111); GSYNC();
        PH(l, 103); GSYNC();
        PH(l, 105); GSYNC();
        PH(l, 106); if (l == 0) PH(l, 117); GSYNC();
        if (l == 0) { PH(l, 118); GSYNC(); }
    }
    PH(0, 113);
}
#else
template <int PH> __global__ void __launch_bounds__(FAST_THREADS, 2) k_fast(P p, int l) {
    extern __shared__ __attribute__((aligned(16))) unsigned char lds_raw[];
    run_fast(p, l, PH, (LAS unsigned char*)lds_raw, blockIdx.x, gridDim.x);
}
#endif

extern "C" void kernel_launch(void* const* d_in, const int* in_sizes, int n_in, void* d_out, int out_size, void* d_ws, size_t ws_size, hipStream_t stream) {
    if (n_in != 19 || ws_size < WS_NEED) { fprintf(stderr, "kernel_launch: unexpected n_in %d / ws_size %zu\n", n_in, ws_size); return; }
    P p{};
    p.x = (const float*)d_in[0]; p.c = (const float*)d_in[1]; p.ctx = (const float*)d_in[2]; p.c_ctx = (const float*)d_in[3];
    p.w_ada = (const float*)d_in[4]; p.b_ada = (const float*)d_in[5]; p.n1g = (const float*)d_in[6]; p.n2g = (const float*)d_in[7];
    p.w_in = (const float*)d_in[8]; p.w_f = (const float*)d_in[9]; p.sink = (const float*)d_in[10]; p.qn_g = (const float*)d_in[11];
    p.w_uq = (const float*)d_in[12]; p.kvn_g = (const float*)d_in[13]; p.w_ukv = (const float*)d_in[14]; p.w_out = (const float*)d_in[15];
    p.w_mlp1 = (const float*)d_in[16]; p.w_mlp2 = (const float*)d_in[17]; p.fin_g = (const float*)d_in[18];
    p.out = (float*)d_out; p.ws = (unsigned char*)d_ws;
#if MEGA
    static int grid_blocks = 0;
    if (!grid_blocks) {
        if (hipFuncSetAttribute((const void*)mega_kernel, hipFuncAttributeMaxDynamicSharedMemorySize, FAST_LDS) != hipSuccess) { fprintf(stderr, "hipFuncSetAttribute failed\n"); return; }
        int dev = 0, cus = 0, per_cu = 0;
        hipGetDevice(&dev);
        hipDeviceGetAttribute(&cus, hipDeviceAttributeMultiprocessorCount, dev);
        hipOccupancyMaxActiveBlocksPerMultiprocessor(&per_cu, mega_kernel, FAST_THREADS, FAST_LDS);
        if (per_cu < 1) { fprintf(stderr, "occupancy query says %d blocks per CU\n", per_cu); return; }
        grid_blocks = cus;
    }
    if (hipMemsetAsync((char*)d_ws + O_CTL, 0, CTL_BYTES, stream) != hipSuccess) { fprintf(stderr, "hipMemsetAsync failed\n"); return; }
    void* args[] = {&p};
    hipError_t e = hipLaunchCooperativeKernel((void*)mega_kernel, dim3(grid_blocks), dim3(FAST_THREADS), args, FAST_LDS, stream);
    if (e != hipSuccess) fprintf(stderr, "cooperative launch failed: %s (grid %d)\n", hipGetErrorString(e), grid_blocks);
#else
    static int init = 0;
    if (!init) {
#define SETA(PH) if (hipFuncSetAttribute((const void*)k_fast<PH>, hipFuncAttributeMaxDynamicSharedMemorySize, FAST_LDS) != hipSuccess) { fprintf(stderr, "hipFuncSetAttribute failed\n"); return; }
        SETA(100) SETA(101) SETA(102) SETA(103) SETA(104) SETA(105) SETA(106) SETA(107) SETA(108) SETA(109) SETA(110) SETA(111) SETA(112) SETA(113) SETA(114) SETA(117) SETA(118)
        init = 1; }
    const int GF = 256;
#define FAST(l, ph) k_fast<ph><<<GF, FAST_THREADS, FAST_LDS, stream>>>(p, l)
    FAST(0, 100); FAST(0, 112);
    for (int l = 0; l < DEPTH; ++l) {
        if (l == 0) FAST(l, 101); FAST(l, 102); FAST(l, 108); FAST(l, 109); FAST(l, 110); if (l == 0) FAST(l, 114); FAST(l, 107); FAST(l, 111);
        FAST(l, 103); FAST(l, 105); FAST(l, 106); if (l == 0) { FAST(l, 117); FAST(l, 118); }
    }
    FAST(0, 113);
#endif
}
```

```cpp
#include <hip/hip_runtime.h>
#include <hip/hip_cooperative_groups.h>
#include <stdint.h>
#include <stdio.h>
namespace cg = cooperative_groups;
#ifndef MEGA
#define MEGA 1
#endif
#ifndef PROBE_PH
#define PROBE_PH 0
#endif

typedef unsigned short bf16_t;
constexpr int D = 1024, NB = 8, S = 4096, L = 256, DEPTH = 2;
constexpr int ML = NB * S, MC = NB * L, MT = ML + MC;
constexpr int DIN = 1312, DFF = 4096;
constexpr int OFF_Q = 256, OFF_K = 640, OFF_V = 768, OFF_CQ = 896, OFF_CKV = 1152, OFF_KR = 1280;
constexpr int QMW = 576;
constexpr float EPS = 1e-6f;

constexpr size_t MiB = 1u << 20;
constexpr size_t O_MOD = 0, O_TAB = 1 * MiB, O_WF = 3 * MiB, O_HC = 5 * MiB, O_RSSQ = 13 * MiB, O_RSSKV = 14 * MiB + 512 * 1024, O_TW = 15 * MiB + 256 * 1024;
constexpr size_t O_ZF = 16 * MiB, O_YB = 50 * MiB, O_QS = 82 * MiB, O_KS = 108 * MiB, O_VS = 117 * MiB, O_CQ = 126 * MiB, O_CKV = 143 * MiB, O_KR = 152 * MiB,
                 O_QM = 155 * MiB, O_KN = 194 * MiB, O_VM = 220 * MiB, O_HID = 16 * MiB;
constexpr size_t O_WIN_T = 290 * MiB, O_WOUT_T = 297 * MiB, O_W1_T = 301 * MiB, O_W2_T = 317 * MiB, O_WUQ_T = 333 * MiB, O_WUKV_T = 334 * MiB, O_FFTW = 335 * MiB,
                 O_XN = 336 * MiB, O_MIX = 404 * MiB, O_RSSH = 472 * MiB;
constexpr size_t WS_NEED = 477 * MiB;

struct P {
    const float *x, *c, *ctx, *c_ctx, *w_ada, *b_ada, *n1g, *n2g, *w_in, *w_f, *sink, *qn_g, *w_uq, *kvn_g, *w_ukv, *w_out, *w_mlp1, *w_mlp2, *fin_g;
    float* out;
    unsigned char* ws;
};

__device__ __forceinline__ int tidx() { int t = threadIdx.x; asm volatile("" : "+v"(t)); return t; }
__device__ __forceinline__ float shfl_xor_f(float v, int mask) {
    const int lane = tidx() & 63; return __int_as_float(__builtin_amdgcn_ds_bpermute((lane ^ mask) << 2, __float_as_int(v)));
}
__device__ __forceinline__ float bf2f(bf16_t v) { return __uint_as_float(((unsigned)v) << 16); }
__device__ __forceinline__ bf16_t f2bf(float f) { unsigned u = __float_as_uint(f); u += 0x7fffu + ((u >> 16) & 1u); return (bf16_t)(u >> 16); }

__device__ __forceinline__ float* ws_mod(const P& p) { return (float*)(p.ws + O_MOD); }
__device__ __forceinline__ float* ws_cosT(const P& p) { return (float*)(p.ws + O_TAB); }
__device__ __forceinline__ float* ws_sinT(const P& p) { return (float*)(p.ws + O_TAB) + 4096; }
__device__ __forceinline__ float* ws_cosh(const P& p) { return (float*)(p.ws + O_TAB) + 8192; }
__device__ __forceinline__ float* ws_sinh(const P& p) { return ws_cosh(p) + 4096 * 32; }
__device__ __forceinline__ float* ws_cosr(const P& p) { return ws_sinh(p) + 4096 * 32; }
__device__ __forceinline__ float* ws_sinr(const P& p) { return ws_cosr(p) + 4096 * 16; }
__device__ __forceinline__ float* ws_wc(const P& p) { return (float*)(p.ws + O_WF); }
__device__ __forceinline__ float* ws_wsn(const P& p) { return (float*)(p.ws + O_WF) + 2 * 4 * 64 * 64; }
__device__ __forceinline__ float* ws_hc(const P& p) { return (float*)(p.ws + O_HC); }
__device__ __forceinline__ float* ws_rssq(const P& p) { return (float*)(p.ws + O_RSSQ); }
__device__ __forceinline__ float* ws_rsskv(const P& p) { return (float*)(p.ws + O_RSSKV); }
__device__ __forceinline__ float* ws_rssh(const P& p) { return (float*)(p.ws + O_RSSH); }
__device__ __forceinline__ float* ws_gm(const P& p, int l, int which) { return (float*)(p.ws + 475 * MiB) + (size_t)(l * 2 + which) * 9 * 1024; }
__device__ __forceinline__ float* ws_bias2(const P& p, int l) { return (float*)(p.ws + 475 * MiB + 256 * 1024) + (size_t)l * 9 * 4096; }
__device__ __forceinline__ float* ws_bias1(const P& p) { return (float*)(p.ws + 475 * MiB + 768 * 1024); }
__device__ __forceinline__ float* ws_gfin(const P& p) { return (float*)(p.ws + 475 * MiB + 896 * 1024); }
__device__ __forceinline__ bf16_t* ws_zf(const P& p) { return (bf16_t*)(p.ws + O_ZF); }
__device__ __forceinline__ bf16_t* ws_yb(const P& p) { return (bf16_t*)(p.ws + O_YB); }
__device__ __forceinline__ bf16_t* ws_qs(const P& p) { return (bf16_t*)(p.ws + O_QS); }
__device__ __forceinline__ bf16_t* ws_ks(const P& p) { return (bf16_t*)(p.ws + O_KS); }
__device__ __forceinline__ bf16_t* ws_vs(const P& p) { return (bf16_t*)(p.ws + O_VS); }
__device__ __forceinline__ bf16_t* ws_cq(const P& p) { return (bf16_t*)(p.ws + O_CQ); }
__device__ __forceinline__ bf16_t* ws_ckv(const P& p) { return (bf16_t*)(p.ws + O_CKV); }
__device__ __forceinline__ bf16_t* ws_kr(const P& p) { return (bf16_t*)(p.ws + O_KR); }
__device__ __forceinline__ bf16_t* ws_qm(const P& p) { return (bf16_t*)(p.ws + O_QM); }
__device__ __forceinline__ bf16_t* ws_kn(const P& p) { return (bf16_t*)(p.ws + O_KN); }
__device__ __forceinline__ bf16_t* ws_vm(const P& p) { return (bf16_t*)(p.ws + O_VM); }
__device__ __forceinline__ bf16_t* ws_mix(const P& p) { return (bf16_t*)(p.ws + O_MIX); }
__device__ __forceinline__ bf16_t* ws_hid(const P& p) { return (bf16_t*)(p.ws + O_HID); }

__device__ __forceinline__ int modrow(int row) { return row < ML ? (row >> 12) : 8; }
__device__ __forceinline__ const float* hrow_in(const P& p, int l, int row) {
    if (row < ML) return (l == 0 ? p.x : p.out) + (size_t)row * D;
    return (l == 0 ? p.ctx : ws_hc(p)) + (size_t)(row - ML) * D;
}
__device__ __forceinline__ float* hrow_mid(const P& p, int row) {
    if (row < ML) return p.out + (size_t)row * D;
    return ws_hc(p) + (size_t)(row - ML) * D;
}
__device__ __forceinline__ float wave_sum(float v) {
#pragma unroll
    for (int o = 1; o < 64; o <<= 1) v += shfl_xor_f(v, o);
    return v;
}

#define GAS __attribute__((address_space(1)))
#define LAS __attribute__((address_space(3)))
typedef unsigned v4u __attribute__((ext_vector_type(4)));
typedef unsigned v2u __attribute__((ext_vector_type(2)));
typedef float f32x4 __attribute__((ext_vector_type(4)));
typedef float v2u_f __attribute__((ext_vector_type(2)));
#define LDS_WAIT() asm volatile("s_waitcnt lgkmcnt(0)" ::: "memory")
__device__ __forceinline__ unsigned pk2(float lo, float hi) { return (unsigned)f2bf(lo) | ((unsigned)f2bf(hi) << 16); }

constexpr int FAST_THREADS = 512, FAST_LDS = 147456;
constexpr int NIN_PAD = 1792, NUQ_PAD = 768, NUKV = 768;
__device__ __forceinline__ bf16_t* ws_win_t(const P& p, int l) { return (bf16_t*)(p.ws + O_WIN_T) + (size_t)l * NIN_PAD * 1024; }
__device__ __forceinline__ bf16_t* ws_wout_t(const P& p, int l) { return (bf16_t*)(p.ws + O_WOUT_T) + (size_t)l * 1024 * 1024; }
__device__ __forceinline__ bf16_t* ws_w1_t(const P& p, int l) { return (bf16_t*)(p.ws + O_W1_T) + (size_t)l * 4096 * 1024; }
__device__ __forceinline__ bf16_t* ws_w2_t(const P& p, int l) { return (bf16_t*)(p.ws + O_W2_T) + (size_t)l * 1024 * 4096; }
__device__ __forceinline__ bf16_t* ws_wuq_t(const P& p, int l) { return (bf16_t*)(p.ws + O_WUQ_T) + (size_t)l * NUQ_PAD * 256; }
__device__ __forceinline__ bf16_t* ws_wukv_t(const P& p, int l) { return (bf16_t*)(p.ws + O_WUKV_T) + (size_t)l * NUKV * 128; }
__device__ __forceinline__ bf16_t* ws_xn(const P& p) { return (bf16_t*)(p.ws + O_XN); }

namespace pg8 {
#define PG8_LAS __attribute__((address_space(3)))
typedef unsigned short bf16_t;
typedef short bf16x8 __attribute__((ext_vector_type(8)));
typedef float f32x4 __attribute__((ext_vector_type(4)));
typedef unsigned u32x4 __attribute__((ext_vector_type(4)));
constexpr int BM = 256, BK = 64, HALF = 128, HTB = HALF * BK * 2  , STAGE_BYTES = 8 * HTB, NXCD = 8, WGM = 8;

__host__ __device__ __forceinline__ int lds_byte(int r, int c) { const int st = (r >> 4) * 2 + (c >> 5), rr = r & 15, cc = c & 31, ob = rr * 64 + cc * 2; return st * 1024 + (ob ^ (((ob >> 9) & 1) << 5)); }
__host__ __device__ __forceinline__ void stage_rc(int b, int& R, int& C) { const int st = b / 1024, sb = b % 1024, swz = sb ^ (((sb >> 9) & 1) << 5); R = (st >> 1) * 16 + swz / 64; C = (st & 1) * 32 + (swz % 64) / 2; }
__host__ __device__ __forceinline__ int perm32(int rho) { const int n = rho >> 4, i = rho & 15; return 8 * (i >> 2) + 4 * n + (i & 3); }

struct Unit { int pm, pn, ko; };
struct Gemm { const bf16_t* A; const bf16_t* Bt; int M, N, K, ld; int ablk = 0; };

struct StaticOrder {
    int nM, nN, nwg, G, c;
    __host__ __device__ void init(int M, int N, int G_, int c_) { nM = M / BM; nN = N / BM; nwg = nM * nN; G = G_; c = c_; }
    __host__ __device__ bool next(int i, Unit& u) const {
        const long L = (long)i * G + c; if (L >= nwg) return false;
        int wgid = (int)L; { const int q = nwg / NXCD, r = nwg % NXCD, xcd = wgid % NXCD, off = wgid / NXCD; wgid = (xcd < r ? xcd * (q + 1) : r * (q + 1) + (xcd - r) * q) + off; }
        const int nig = WGM * nN, gid = wgid / nig, fm = gid * WGM, gsz = (nM - fm) < WGM ? (nM - fm) : WGM;
        u.pm = fm + ((wgid % nig) % gsz); u.pn = (wgid % nig) / gsz; u.ko = 0; return true;
    }
    __device__ __forceinline__ void a_ready(const Unit&) const {}
    __device__ __forceinline__ void done(const Unit&) const {}
};

__device__ __forceinline__ unsigned cvt_pk_bf16(float lo, float hi) { unsigned r; asm volatile("v_cvt_pk_bf16_f32 %0, %1, %2" : "=v"(r) : "v"(lo), "v"(hi)); return r; }
typedef float f32x2 __attribute__((ext_vector_type(2)));
template <class Epi, class Sched, bool ALIGN_EPI = false, bool SP2 = false>
__device__ __forceinline__ void gemm_phase(PG8_LAS unsigned char* lds, const Gemm g, const Sched& S, const Epi& E) {
    const int tid = tidx(), wid = __builtin_amdgcn_readfirstlane(tid >> 6), lane = tid & 63, wr = wid >> 2, wc = wid & 3, fr = lane & 15, fq = lane >> 4;
    const int K = g.K, nt = K / BK;
    unsigned voffA[2], voffB[2];
#pragma unroll
    for (int i = 0; i < 2; ++i) { int R, C; stage_rc(tid * 16 + i * 8192, R, C); const int Rb = Epi::PERM ? ((R & ~31) + perm32(R & 31)) : R;
        voffA[i] = g.ablk ? (unsigned)(((R >> 4) * (g.ld >> 5) + (C >> 5)) * 512 + (R & 15) * 32 + (C & 31)) * 2u : (unsigned)(R * g.ld + C) * 2u; voffB[i] = (unsigned)(Rb * g.ld + C) * 2u; }
    const size_t kstep = (size_t)(BK * 2);
    const size_t kstepA = g.ablk ? (size_t)2048 : kstep;
    const size_t hstep = (size_t)HALF * g.ld * 2;
    const size_t tstep = 2 * hstep;
    const unsigned ldsw = (unsigned)wid * 1024u;
    const int aoff = lds_byte(wr * 64 + fr, fq * 8), boff = lds_byte(wc * 32 + fr, fq * 8);
#define PG8_SA(b, h) (((b) * 2 + (h)) * HTB)
#define PG8_SB(b, h) ((4 + (b) * 2 + (h)) * HTB)
#define PG8_STAGE(bufoff, gbase, voff) do { _Pragma("unroll") for (int _i = 0; _i < 2; ++_i) \
        __builtin_amdgcn_global_load_lds((const unsigned*)((const char*)(gbase) + (voff)[_i]), (PG8_LAS unsigned*)(lds + (bufoff) + ldsw + _i * 8192), 16, 0, 0); } while (0)
#define PG8_LDA(dst, b, h) do { _Pragma("unroll") for (int m = 0; m < 4; ++m) _Pragma("unroll") for (int k = 0; k < 2; ++k) dst[m][k] = *(const PG8_LAS bf16x8*)(lds + PG8_SA(b, h) + aoff + m * 2048 + k * 1024); } while (0)
#define PG8_LDB(dst, b, h) do { _Pragma("unroll") for (int n = 0; n < 2; ++n) _Pragma("unroll") for (int k = 0; k < 2; ++k) dst[n][k] = *(const PG8_LAS bf16x8*)(lds + PG8_SB(b, h) + boff + n * 2048 + k * 1024); } while (0)
#define PG8_MMA(ai, bj, At, Bt) do { __builtin_amdgcn_s_setprio(1); _Pragma("unroll") for (int k = 0; k < 2; ++k) _Pragma("unroll") for (int m = 0; m < 4; ++m) _Pragma("unroll") for (int n = 0; n < 2; ++n)   \
        acc[ai][bj][m][n] = __builtin_amdgcn_mfma_f32_16x16x32_bf16(Bt[n][k], At[m][k], acc[ai][bj][m][n], 0, 0, 0); __builtin_amdgcn_s_setprio(0); } while (0)
#define PG8_WAIT_V(n) asm volatile("s_waitcnt vmcnt(" #n ")" ::: "memory")
#define PG8_WAIT_L(n) asm volatile("s_waitcnt lgkmcnt(" #n ")" ::: "memory")
#define PG8_BAR __builtin_amdgcn_s_barrier()
#define PG8_SCHED __builtin_amdgcn_sched_barrier(0)
    Unit cur, nxt; int ui = 0;
    if (!S.next(0, cur)) return;
    f32x4 acc[2][2][4][2];
#pragma unroll
    for (int a = 0; a < 2; ++a)
#pragma unroll
        for (int b = 0; b < 2; ++b)
#pragma unroll
            for (int m = 0; m < 4; ++m)
#pragma unroll
                for (int n = 0; n < 2; ++n) acc[a][b][m][n] = (f32x4){0.f, 0.f, 0.f, 0.f};
    bf16x8 At[4][2], B0[2][2], B1[2][2];
    const char* cA = (const char*)g.A + (size_t)cur.pm * tstep + (size_t)cur.ko * (g.ablk ? 32 : 2); const char* cB = (const char*)g.Bt + (size_t)cur.pn * tstep + (size_t)cur.ko * 2;
    S.a_ready(cur);
    if constexpr (SP2) {
        PG8_STAGE(PG8_SB(0, 0), cB, voffB); PG8_STAGE(PG8_SB(0, 1), cB + hstep, voffB); PG8_STAGE(PG8_SA(0, 0), cA, voffA); PG8_STAGE(PG8_SA(0, 1), cA + hstep, voffA);
        if (wr == 1) PG8_BAR;
        PG8_WAIT_V(2); PG8_BAR;
        PG8_STAGE(PG8_SB(1, 0), cB + kstep, voffB); PG8_STAGE(PG8_SA(1, 0), cA + kstepA, voffA); PG8_STAGE(PG8_SB(1, 1), cB + hstep + kstep, voffB);
        PG8_WAIT_V(6); PG8_BAR;
    } else {
        PG8_STAGE(PG8_SB(0, 0), cB, voffB); PG8_STAGE(PG8_SA(0, 0), cA, voffA); PG8_STAGE(PG8_SB(0, 1), cB + hstep, voffB); PG8_STAGE(PG8_SA(0, 1), cA + hstep, voffA);
        if (wr == 1) PG8_BAR;
        PG8_WAIT_V(4); PG8_BAR;
        PG8_STAGE(PG8_SB(1, 0), cB + kstep, voffB); PG8_STAGE(PG8_SA(1, 0), cA + kstepA, voffA); PG8_STAGE(PG8_SB(1, 1), cB + hstep + kstep, voffB);
        PG8_WAIT_V(6); PG8_BAR;
    }
    for (;;) {
        const bool has_next = S.next(ui + 1, nxt);
        const char* nA = has_next ? (const char*)g.A + (size_t)nxt.pm * tstep + (size_t)nxt.ko * (g.ablk ? 32 : 2) : cA; const char* nB = has_next ? (const char*)g.Bt + (size_t)nxt.pn * tstep + (size_t)nxt.ko * 2 : cB;
        for (int t = 0; t < nt; t += 2) {
            const bool last = (t == nt - 2);
            const char* a1 = cA + (size_t)(t + 1) * kstepA;
            const char* a2 = last ? nA : cA + (size_t)(t + 2) * kstepA; const char* b2 = last ? nB : cB + (size_t)(t + 2) * kstep;
            const char* a3 = a2 + kstepA; const char* b3 = b2 + kstep;
            if (last && has_next) S.a_ready(nxt);
            if constexpr (SP2) {
            PG8_LDB(B0, 0, 0); PG8_LDB(B1, 0, 1); PG8_SCHED; PG8_LDA(At, 0, 0); PG8_STAGE(PG8_SA(1, 1), a1 + hstep, voffA);
            PG8_WAIT_V(8); PG8_WAIT_L(0); PG8_BAR; PG8_MMA(0, 0, At, B0); PG8_MMA(0, 1, At, B1); PG8_BAR; PG8_SCHED;
            PG8_LDA(At, 0, 1); PG8_STAGE(PG8_SB(0, 0), b2, voffB); PG8_STAGE(PG8_SB(0, 1), b2 + hstep, voffB); PG8_STAGE(PG8_SA(0, 0), a2, voffA);
            PG8_WAIT_V(8); PG8_WAIT_L(0); PG8_BAR; PG8_MMA(1, 0, At, B0); PG8_MMA(1, 1, At, B1); PG8_BAR; PG8_SCHED;
            PG8_LDB(B0, 1, 0); PG8_LDB(B1, 1, 1); PG8_SCHED; PG8_LDA(At, 1, 0); PG8_STAGE(PG8_SA(0, 1), a2 + hstep, voffA);
            PG8_WAIT_V(8); PG8_WAIT_L(0); PG8_BAR; PG8_MMA(0, 0, At, B0); PG8_MMA(0, 1, At, B1); PG8_BAR; PG8_SCHED;
            PG8_LDA(At, 1, 1); PG8_STAGE(PG8_SB(1, 0), b3, voffB); PG8_STAGE(PG8_SB(1, 1), b3 + hstep, voffB); PG8_STAGE(PG8_SA(1, 0), a3, voffA);
            PG8_WAIT_V(8); PG8_WAIT_L(0); PG8_BAR; PG8_MMA(1, 0, At, B0); PG8_MMA(1, 1, At, B1); PG8_BAR; PG8_SCHED;
            } else {
            PG8_LDB(B0, 0, 0); PG8_SCHED; PG8_LDA(At, 0, 0); PG8_STAGE(PG8_SA(1, 1), a1 + hstep, voffA);
            PG8_WAIT_L(8); PG8_BAR; PG8_WAIT_L(0); PG8_MMA(0, 0, At, B0); PG8_BAR; PG8_SCHED;
            PG8_LDB(B1, 0, 1); PG8_STAGE(PG8_SB(0, 0), b2, voffB);
            PG8_BAR; PG8_WAIT_L(0); PG8_MMA(0, 1, At, B1); PG8_BAR;
            PG8_LDA(At, 0, 1); PG8_STAGE(PG8_SA(0, 0), a2, voffA);
            PG8_BAR; PG8_WAIT_L(0); PG8_MMA(1, 0, At, B0); PG8_BAR; PG8_SCHED;
            PG8_STAGE(PG8_SB(0, 1), b2 + hstep, voffB);
            PG8_WAIT_V(6); PG8_BAR; PG8_MMA(1, 1, At, B1); PG8_BAR;
            PG8_LDB(B0, 1, 0); PG8_SCHED; PG8_LDA(At, 1, 0); PG8_STAGE(PG8_SA(0, 1), a2 + hstep, voffA);
            PG8_WAIT_L(8); PG8_BAR; PG8_WAIT_L(0); PG8_MMA(0, 0, At, B0); PG8_BAR; PG8_SCHED;
            PG8_LDB(B1, 1, 1); PG8_STAGE(PG8_SB(1, 0), b3, voffB);
            PG8_BAR; PG8_WAIT_L(0); PG8_MMA(0, 1, At, B1); PG8_BAR;
            PG8_LDA(At, 1, 1); PG8_STAGE(PG8_SA(1, 0), a3, voffA);
            PG8_BAR; PG8_WAIT_L(0); PG8_MMA(1, 0, At, B0); PG8_BAR; PG8_SCHED;
            PG8_STAGE(PG8_SB(1, 1), b3 + hstep, voffB);
            PG8_WAIT_V(6); PG8_BAR; PG8_MMA(1, 1, At, B1); PG8_BAR;
            }
        }
        if constexpr (ALIGN_EPI) { if (wr == 0) PG8_BAR; }
        if constexpr (!Epi::AFTER_DRAIN) { const int t2_ = tidx(); const int fr_ = t2_ & 15, fq_ = (t2_ & 63) >> 4;
                                           E(acc, cur, wr, wc, fr_, fq_); S.done(cur); }
        if (!has_next) break;
#pragma unroll
        for (int a = 0; a < 2; ++a)
#pragma unroll
            for (int b = 0; b < 2; ++b)
#pragma unroll
                for (int m = 0; m < 4; ++m)
#pragma unroll
                    for (int n = 0; n < 2; ++n) acc[a][b][m][n] = (f32x4){0.f, 0.f, 0.f, 0.f};
        cur = nxt; cA = nA; cB = nB; ++ui;
        if constexpr (ALIGN_EPI) { if (wr == 1) PG8_BAR; }
    }
    PG8_WAIT_V(0);
    if constexpr (!ALIGN_EPI) { if (wr == 0) PG8_BAR; }
    PG8_BAR;
    if constexpr (Epi::AFTER_DRAIN) { E.fused(acc, cur, wr, wc, fr, fq, lds, wid, lane); S.done(cur); }
#undef PG8_SA
#undef PG8_SB
#undef PG8_STAGE
#undef PG8_LDA
#undef PG8_LDB
#undef PG8_MMA
#undef PG8_WAIT_V
#undef PG8_WAIT_L
#undef PG8_BAR
#undef PG8_SCHED
}
}

template <class F>
__device__ __forceinline__ void tr_item(F fn, int K, bf16_t* WT, LAS float* scr, int kb, int nbk, int lane) {
    asm volatile("" : "+v"(lane));
    const int k0 = 64 * kb, n0 = 32 * nbk;
#pragma unroll 4
    for (int i = 0; i < 32; ++i) { const int kk = 2 * i + (lane >> 5); scr[kk * 33 + (lane & 31)] = fn(k0 + kk, n0 + (lane & 31)); }
    LDS_WAIT(); asm volatile("" ::: "memory");
    const int c = lane & 7;
#pragma unroll
    for (int j = 0; j < 4; ++j) { const int n = (lane >> 3) + 8 * j; const LAS float* s = scr + (8 * c) * 33 + n;
        v4u o; o.x = pk2(s[0 * 33], s[1 * 33]); o.y = pk2(s[2 * 33], s[3 * 33]); o.z = pk2(s[4 * 33], s[5 * 33]); o.w = pk2(s[6 * 33], s[7 * 33]);
        *(GAS v4u*)(WT + (size_t)(n0 + n) * K + k0 + 8 * c) = o; }
    LDS_WAIT(); asm volatile("" ::: "memory");
}
__device__ __forceinline__ float win_src(const P& p, int l, int k, int n) {
    const float* w = p.w_in + ((size_t)l * 1024 + k) * DIN;
    if (n < 512) { const int part = n >> 8, g = (n >> 6) & 3, d = n & 63;
        const float* wf = (part ? ws_wsn(p) : ws_wc(p)) + (size_t)(l * 4 + g) * 4096 + d; float a = 0.f;
        for (int c = 0; c < 64; ++c) a += w[g * 64 + c] * wf[c * 64];
        return a; }
    if (n < 1024) { const int pp = n - 512, H = pp >> 6, pos = pp & 63, d = 32 * ((pos >> 2) & 1) + 16 * (pos >> 5) + 4 * ((pos >> 3) & 3) + (pos & 3); return w[OFF_Q + H * 64 + d]; }
    if (n < 1280) { const int pp = n - 1024; return pp < 128 ? w[OFF_V + pp] : w[OFF_CKV + pp - 128]; }
    if (n < 1536) return w[OFF_CQ + n - 1280];
    const int pp = n - 1536; return pp < 32 ? w[OFF_KR + 16 * ((pp >> 2) & 1) + 4 * (pp >> 3) + (pp & 3)] : 0.f;
}
__device__ __forceinline__ float wuq_src(const P& p, int l, int k, int n) {
    int col; if (n < 384) col = (n >> 6) * 96 + (n & 63); else if (n < 576) { const int pp = n - 384, ps = pp & 31; col = (pp >> 5) * 96 + 64 + 16 * ((ps >> 2) & 1) + 4 * (ps >> 3) + (ps & 3); } else return 0.f;
    return p.w_uq[((size_t)l * 256 + k) * QMW + col] * p.qn_g[l * 256 + k];
}
__device__ __forceinline__ float wukv_src(const P& p, int l, int k, int n) {
    int col; if (n < 384) col = (n >> 6) * 128 + (n & 63); else { const int pp = n - 384; col = (pp >> 6) * 128 + 64 + (pp & 63); }
    return p.w_ukv[((size_t)l * 128 + k) * 768 + col] * p.kvn_g[l * 128 + k];
}
__device__ __forceinline__ void fp_weights_in(const P& p, LAS unsigned char* lds, int bid, int nb) {
    const int tid = tidx(), lane = tid & 63, wave = tid >> 6;
    LAS float* scr = (LAS float*)(lds + wave * 16384);
    const int gw = bid * 8 + wave, NGW = nb * 8;
    constexpr int NBL = NIN_PAD / 32, I_IN = 16 * NBL;
#pragma unroll 1
    for (int it = gw; it < 2 * I_IN; it += NGW) {
        const int l = it / I_IN, r = it % I_IN, kb = r / NBL, nbk = r % NBL;
        if (nbk >= 16) { tr_item([&](int k, int n) { return win_src(p, l, k, n); }, 1024, ws_win_t(p, l), scr, kb, nbk, lane); }
        else {
            int ln = lane; asm volatile("" : "+v"(ln));
            const int part = nbk >> 3, g = (nbk >> 1) & 3, k0 = 64 * kb + 32 * (nbk & 1);
            const float* wx = (part ? ws_wsn(p) : ws_wc(p)) + (size_t)(l * 4 + g) * 4096 + ln;
            const float* wsrc = p.w_in + ((size_t)l * 1024 + k0) * DIN + g * 64;
#pragma unroll 4
            for (int i = 0; i < 8; ++i) { const int e = i * 64 + ln, kk = e >> 4, c4 = e & 15; ((LAS f32x4*)scr)[e] = *(const f32x4*)(wsrc + (size_t)kk * DIN + 4 * c4); }
            float wxr[64];
#pragma unroll
            for (int c = 0; c < 64; ++c) wxr[c] = wx[c * 64];
            LDS_WAIT(); asm volatile("" ::: "memory");
            bf16_t* dst = ws_win_t(p, l) + (size_t)(part * 256 + g * 64 + ln) * 1024 + k0;
#pragma unroll 1
            for (int k8 = 0; k8 < 4; ++k8) {
                float a[8];
#pragma unroll
                for (int j = 0; j < 8; ++j) a[j] = 0.f;
#pragma unroll
                for (int j = 0; j < 8; ++j) {
                    float s0 = 0.f, s1 = 0.f, s2 = 0.f, s3 = 0.f;
#pragma unroll
                    for (int c4 = 0; c4 < 16; ++c4) { const f32x4 w4 = ((LAS f32x4*)scr)[(8 * k8 + j) * 16 + c4];
                        asm("v_fmac_f32 %0, %1, %2" : "+v"(s0) : "v"(wxr[4 * c4]), "v"(w4.x)); asm("v_fmac_f32 %0, %1, %2" : "+v"(s1) : "v"(wxr[4 * c4 + 1]), "v"(w4.y));
                        asm("v_fmac_f32 %0, %1, %2" : "+v"(s2) : "v"(wxr[4 * c4 + 2]), "v"(w4.z)); asm("v_fmac_f32 %0, %1, %2" : "+v"(s3) : "v"(wxr[4 * c4 + 3]), "v"(w4.w)); }
                    a[j] = (s0 + s1) + (s2 + s3);
                    __builtin_amdgcn_sched_barrier(0);
                }
                v4u o; o.x = pk2(a[0], a[1]); o.y = pk2(a[2], a[3]); o.z = pk2(a[4], a[5]); o.w = pk2(a[6], a[7]);
                *(v4u*)(dst + 8 * k8) = o;
            }
            LDS_WAIT(); asm volatile("" ::: "memory");
        }
    }
}
__device__ __forceinline__ void fp_weights(const P& p, LAS unsigned char* lds, int bid, int nb) {
    const int tid = tidx(), lane = tid & 63, wave = tid >> 6;
    LAS float* scr = (LAS float*)(lds + wave * 16384);
    const int gw = bid * 8 + wave, NGW = nb * 8;
    constexpr int I_OUT = 16 * 32, I_1 = 16 * 128, I_2 = 64 * 32, I_UQ = 4 * (NUQ_PAD / 32), I_UKV = 2 * (NUKV / 32);
    constexpr int PER_L = I_OUT + I_1 + I_2 + I_UQ + I_UKV;
#pragma unroll 1
    for (int it = gw; it < 2 * PER_L; it += NGW) {
        const int l = it / PER_L; int r = it % PER_L;
        if (r < I_OUT) { const float* W = p.w_out + (size_t)l * 1024 * 1024; tr_item([&](int k, int n) { return W[(size_t)k * 1024 + n]; }, 1024, ws_wout_t(p, l), scr, r / 32, r % 32, lane); continue; } r -= I_OUT;
        if (r < I_1) { const float* W = p.w_mlp1 + (size_t)l * 1024 * DFF; tr_item([&](int k, int n) { return W[(size_t)k * DFF + n]; }, 1024, ws_w1_t(p, l), scr, r / 128, r % 128, lane); continue; } r -= I_1;
        if (r < I_2) { const float* W = p.w_mlp2 + (size_t)l * DFF * 1024; tr_item([&](int k, int n) { return W[(size_t)k * 1024 + n]; }, DFF, ws_w2_t(p, l), scr, r / 32, r % 32, lane); continue; } r -= I_2;
        if (r < I_UQ) { const int nbl = NUQ_PAD / 32; tr_item([&](int k, int n) { return wuq_src(p, l, k, n); }, 256, ws_wuq_t(p, l), scr, r / nbl, r % nbl, lane); continue; } r -= I_UQ;
        { const int nbl = NUKV / 32; tr_item([&](int k, int n) { return wukv_src(p, l, k, n); }, 128, ws_wukv_t(p, l), scr, r / nbl, r % nbl, lane); }
    }
}

__device__ __forceinline__ void fp_tables(const P& p, int bid, int nb) {
    const int gt = bid * FAST_THREADS + tidx(), GT = nb * FAST_THREADS;
    for (int idx = gt; idx < 4096 * 32; idx += GT) {
        const int s = idx >> 5, j = idx & 31;
        const int pos = (j < 16) ? (s >> 6) : (s & 63), f = j & 15;
        const float inv = powf(10000.0f, -(float)f / 16.0f), ang = (float)pos * inv;
        ws_cosh(p)[idx] = cosf(ang); ws_sinh(p)[idx] = sinf(ang);
    }
    for (int idx = gt; idx < 4096 * 16; idx += GT) {
        const int s = idx >> 4, j = idx & 15;
        const int pos = (j < 8) ? (s >> 6) : (s & 63), f = j & 7;
        const float inv = powf(10000.0f, -(float)f / 8.0f), ang = (float)pos * inv;
        ws_cosr(p)[idx] = cosf(ang); ws_sinr(p)[idx] = sinf(ang);
    }
    for (int idx = gt; idx < 2 * 4 * 64 * 64; idx += GT) {
        const int d = idx & 63, c = (idx >> 6) & 63, lg = idx >> 12;
        float ac = 0.f, as = 0.f;
        for (int c2 = 0; c2 < 64; ++c2) {
            float sn, cs; sincospif((float)((c * c2) & 63) * (1.0f / 32.0f), &sn, &cs);
            const float w = p.w_f[(size_t)(lg * 64 + c2) * 64 + d];
            ac += cs * w; as += sn * w;
        }
        ws_wc(p)[idx] = ac; ws_wsn(p)[idx] = as;
    }
}
__device__ __forceinline__ void fp_mods(const P& p, LAS unsigned char* lds, int bid, int nb) {
    const int tid = tidx(), lane = tid & 63, w = tid >> 6;
    LAS float* sc = (LAS float*)lds;
    LAS float* part = (LAS float*)(lds + 36864);
    if (bid >= 192) return;
    for (int i = tid; i < 9 * 1024; i += FAST_THREADS) {
        const int r = i >> 10, k = i & 1023;
        const float v = (r < 8) ? p.c[r * 1024 + k] : p.c_ctx[k];
        sc[i] = v / (1.0f + expf(-v));
    }
    __syncthreads();
    for (int it = bid; it < 192; it += nb) {
        const int l = it / 96, n = (it % 96) * 64 + lane;
        float acc[9];
#pragma unroll
        for (int r = 0; r < 9; ++r) acc[r] = 0.f;
        const float* wp = p.w_ada + ((size_t)l * 1024 + w * 128) * 6144 + n;
#pragma unroll 16
        for (int k = 0; k < 128; ++k) {
            const float wv = wp[(size_t)k * 6144];
#pragma unroll
            for (int r = 0; r < 9; ++r) acc[r] += sc[r * 1024 + w * 128 + k] * wv;
        }
#pragma unroll
        for (int r = 0; r < 9; ++r) part[(w * 9 + r) * 64 + lane] = acc[r];
        __syncthreads();
        for (int i = tid; i < 9 * 64; i += FAST_THREADS) {
            const int r = i >> 6, c = i & 63; float s = 0.f;
#pragma unroll
            for (int ww = 0; ww < 8; ++ww) s += part[(ww * 9 + r) * 64 + c];
            const int nn = (it % 96) * 64 + c;
            ws_mod(p)[(size_t)(l * 9 + r) * 6144 + nn] = s + p.b_ada[l * 6144 + nn];
        }
        __syncthreads();
    }
}


__device__ __forceinline__ void fp_gm(const P& p, int bid, int nb) {
    const int gt = bid * FAST_THREADS + tidx(), GT = nb * FAST_THREADS;
    for (int i = gt; i < 9 * 1024; i += GT) ws_gfin(p)[i] = p.fin_g[i & 1023];
    for (int i = gt; i < 2 * 2 * 9 * 1024; i += GT) {
        const int k = i & 1023, r = (i >> 10) % 9, lw = i / (9 * 1024), l = lw >> 1, which = lw & 1;
        const float g = (which == 0 ? p.n1g : p.n2g)[l * 1024 + k];
        ws_gm(p, l, which)[r * 1024 + k] = g * (1.0f + ws_mod(p)[(size_t)(l * 9 + r) * 6144 + (which == 0 ? 1024 : 4096) + k]);
    }
}
__device__ __forceinline__ void fp_bias(const P& p, int bid, int nb) {
    const int tid = tidx(), lane = tid & 63, gw = bid * 8 + (tid >> 6), NGW = nb * 8;
#pragma unroll 1
    for (int g = 0; g < 3; ++g) {
        const int nit = g < 2 ? 4096 : NIN_PAD, ldd = nit;
        if (gw >= nit) continue;
        const float* sh = g < 2 ? ws_mod(p) + (size_t)(g * 9) * 6144 + 3072 : ws_mod(p) + (size_t)9 * 6144;
        const bf16_t* wbase = g < 2 ? ws_w1_t(p, g) : ws_win_t(p, 1); float* dst = g < 2 ? ws_bias2(p, g) : ws_bias1(p);
        f32x4 s[9][4];
#pragma unroll
        for (int r = 0; r < 9; ++r) { const float* q = sh + (size_t)r * 6144 + 8 * lane; s[r][0] = *(const f32x4*)q; s[r][1] = *(const f32x4*)(q + 4); s[r][2] = *(const f32x4*)(q + 512); s[r][3] = *(const f32x4*)(q + 516); }
#pragma unroll 1
        for (int n = gw; n < nit; n += NGW) {
            const bf16_t* wrow = wbase + (size_t)n * 1024;
            float w[16];
            { const v4u a = ((const v4u*)wrow)[lane], b = ((const v4u*)wrow)[64 + lane];
              const unsigned u[8] = {a.x, a.y, a.z, a.w, b.x, b.y, b.z, b.w};
#pragma unroll
              for (int j = 0; j < 8; ++j) { w[2 * j] = __uint_as_float(u[j] << 16); w[2 * j + 1] = __uint_as_float(u[j] & 0xffff0000u); } }
            float d[9];
#pragma unroll
            for (int r = 0; r < 9; ++r)
                d[r] = (w[0] * s[r][0].x + w[1] * s[r][0].y) + (w[2] * s[r][0].z + w[3] * s[r][0].w) + (w[4] * s[r][1].x + w[5] * s[r][1].y) + (w[6] * s[r][1].z + w[7] * s[r][1].w)
                     + (w[8] * s[r][2].x + w[9] * s[r][2].y) + (w[10] * s[r][2].z + w[11] * s[r][2].w) + (w[12] * s[r][3].x + w[13] * s[r][3].y) + (w[14] * s[r][3].z + w[15] * s[r][3].w);
#pragma unroll
            for (int o = 1; o < 64; o <<= 1) {
                float t[9];
#pragma unroll
                for (int r = 0; r < 9; ++r) t[r] = shfl_xor_f(d[r], o);
#pragma unroll
                for (int r = 0; r < 9; ++r) d[r] += t[r];
            }
            if (lane < 9) { float v = d[0];
#pragma unroll
                for (int r = 1; r < 9; ++r) v = lane == r ? d[r] : v;
                dst[(size_t)lane * ldd + n] = v; }
        }
    }
}

__device__ __forceinline__ void fp_xn(const P& p, int l, int which, int nrows, int bid, int nb) {
    const int tid = tidx(), lane = tid & 63, gw = bid * 8 + (tid >> 6), NGW = nb * 8;
    const float* g = (which == 0 ? p.n1g : p.n2g) + l * 1024;
    for (int row = gw; row < nrows; row += NGW) {
        const float* h = which == 0 ? hrow_in(p, l, row) : hrow_mid(p, row);
        const float* mod = ws_mod(p) + (size_t)(l * 9 + modrow(row)) * 6144 + (which == 0 ? 0 : 3072);
        f32x4 v[4]; float ss = 0.f;
#pragma unroll
        for (int j = 0; j < 4; ++j) { v[j] = ((const f32x4*)h)[lane + 64 * j]; ss += (v[j].x * v[j].x + v[j].y * v[j].y) + (v[j].z * v[j].z + v[j].w * v[j].w); }
        ss = wave_sum(ss);
        const float rstd = 1.0f / sqrtf(ss * (1.0f / 1024.0f) + EPS);
        bf16_t* o = ws_xn(p) + (size_t)row * 1024;
#pragma unroll
        for (int j = 0; j < 4; ++j) {
            const int c = 4 * lane + 256 * j;
            const f32x4 gg = *(const f32x4*)(g + c), sh = *(const f32x4*)(mod + c), sc = *(const f32x4*)(mod + 1024 + c);
            const f32x4 y = (v[j] * rstd * gg) * (sc + 1.0f) + sh;
            v2u w; w.x = pk2(y.x, y.y); w.y = pk2(y.z, y.w);
            *(v2u*)(o + c) = w;
        }
    }
}

__device__ __forceinline__ void st8(bf16_t* dst, const pg8::f32x4 a, const pg8::f32x4 b) {
    v4u w; w.x = pg8::cvt_pk_bf16(a.x, a.y); w.y = pg8::cvt_pk_bf16(a.z, a.w); w.z = pg8::cvt_pk_bf16(b.x, b.y); w.w = pg8::cvt_pk_bf16(b.z, b.w); *(v4u*)dst = w;
}
__device__ __forceinline__ void st8_nt(bf16_t* dst, const pg8::f32x4 a, const pg8::f32x4 b) {
    v4u w; w.x = pg8::cvt_pk_bf16(a.x, a.y); w.y = pg8::cvt_pk_bf16(a.z, a.w); w.z = pg8::cvt_pk_bf16(b.x, b.y); w.w = pg8::cvt_pk_bf16(b.z, b.w); __builtin_nontemporal_store(w, (v4u*)dst);
}
__device__ __forceinline__ float sq4(const pg8::f32x4 v) { return (v.x * v.x + v.y * v.y) + (v.z * v.z + v.w * v.w); }
struct EpiResidA {
    static constexpr bool PERM = true, AFTER_DRAIN = false;
    const float* hin_lat; const float* hin_ctx;
    const float* gm_in; float* hout; const float* gate; const float* gm; bf16_t* XN; float* RSSH;
    __device__ __forceinline__ void operator()(const pg8::f32x4 (&acc)[2][2][4][2], const pg8::Unit& u, int wr, int wc, int fr, int fq) const {
        const int mr = modrow(u.pm * 256), cb = u.pn * 256 + wc * 32 + 8 * fq;
        pg8::f32x4 gg[2][2], gmv[2][2], rgi[2][2];
#pragma unroll
        for (int bj = 0; bj < 2; ++bj)
#pragma unroll
            for (int n = 0; n < 2; ++n) { gg[bj][n] = *(const pg8::f32x4*)(gate + (size_t)mr * 6144 + cb + bj * 128 + n * 4);
                                          gmv[bj][n] = gm ? *(const pg8::f32x4*)(gm + (size_t)mr * 1024 + cb + bj * 128 + n * 4) : (pg8::f32x4){0.f, 0.f, 0.f, 0.f};
                                          if (!hin_lat) { const pg8::f32x4 g_ = *(const pg8::f32x4*)(gm_in + (size_t)mr * 1024 + cb + bj * 128 + n * 4);
                                                          rgi[bj][n] = (pg8::f32x4){1.0f / g_.x, 1.0f / g_.y, 1.0f / g_.z, 1.0f / g_.w}; } }
#pragma unroll
        for (int ai = 0; ai < 2; ++ai)
#pragma unroll
            for (int m = 0; m < 4; ++m) {
                const int row = u.pm * 256 + ai * 128 + wr * 64 + m * 16 + fr;
                float ss = 0.f;
#pragma unroll
                for (int bj = 0; bj < 2; ++bj) {
                    pg8::f32x4 b0, b1;
                    if (hin_lat) { const float* hi = (row < ML ? hin_lat + (size_t)row * 1024 : hin_ctx + (size_t)(row - ML) * 1024) + cb + bj * 128; b0 = *(const pg8::f32x4*)hi; b1 = *(const pg8::f32x4*)(hi + 4); }
                    else { const v4u w = *(const v4u*)(XN + (size_t)row * 1024 + cb + bj * 128);
                           b0 = (pg8::f32x4){__uint_as_float(w.x << 16), __uint_as_float(w.x & 0xffff0000u), __uint_as_float(w.y << 16), __uint_as_float(w.y & 0xffff0000u)} * rgi[bj][0];
                           b1 = (pg8::f32x4){__uint_as_float(w.z << 16), __uint_as_float(w.z & 0xffff0000u), __uint_as_float(w.w << 16), __uint_as_float(w.w & 0xffff0000u)} * rgi[bj][1]; }
                    const pg8::f32x4 h0 = b0 + gg[bj][0] * acc[ai][bj][m][0], h1 = b1 + gg[bj][1] * acc[ai][bj][m][1];
                    ss += sq4(h0) + sq4(h1);
                    if (hout) { float* ho = hout + (size_t)row * 1024 + cb + bj * 128; *(pg8::f32x4*)ho = h0; *(pg8::f32x4*)(ho + 4) = h1; }
                    if (gm) st8(XN + (size_t)row * 1024 + cb + bj * 128, h0 * gmv[bj][0], h1 * gmv[bj][1]);
                }
                ss += shfl_xor_f(ss, 16); ss += shfl_xor_f(ss, 32);
                if (fq == 0) RSSH[(size_t)row * 16 + u.pn * 4 + wc] = ss;
            }
    }
};
__device__ __forceinline__ float rstd16(const float* rssh, int row, int fq) {
    const pg8::f32x4 a = *(const pg8::f32x4*)(rssh + (size_t)row * 16 + 4 * fq);
    float s = (a.x + a.y) + (a.z + a.w);
    s += shfl_xor_f(s, 16); s += shfl_xor_f(s, 32);
    return 1.0f / sqrtf(s * (1.0f / 1024.0f) + EPS);
}
struct EpiMlp1 {
    static constexpr bool PERM = true, AFTER_DRAIN = false;
    bf16_t* O; const float* RSSH; const float* bias;
    __device__ __forceinline__ void operator()(const pg8::f32x4 (&acc)[2][2][4][2], const pg8::Unit& u, int wr, int wc, int fr, int fq) const {
        const int mr = modrow(u.pm * 256), cb = u.pn * 256 + wc * 32 + 8 * fq;
        pg8::f32x4 bv[2][2];
#pragma unroll
        for (int bj = 0; bj < 2; ++bj)
#pragma unroll
            for (int n = 0; n < 2; ++n) bv[bj][n] = *(const pg8::f32x4*)(bias + (size_t)mr * 4096 + cb + bj * 128 + n * 4);
#pragma unroll
        for (int ai = 0; ai < 2; ++ai)
#pragma unroll
            for (int m = 0; m < 4; ++m) {
                const int row = u.pm * 256 + ai * 128 + wr * 64 + m * 16 + fr;
                const float r = rstd16(RSSH, row, fq);
#pragma unroll
                for (int bj = 0; bj < 2; ++bj) {
                    pg8::f32x4 v[2];
#pragma unroll
                    for (int n = 0; n < 2; ++n) { v[n] = acc[ai][bj][m][n] * r + bv[bj][n];
                        v[n].x = fmaxf(v[n].x, 0.f); v[n].y = fmaxf(v[n].y, 0.f); v[n].z = fmaxf(v[n].z, 0.f); v[n].w = fmaxf(v[n].w, 0.f); v[n] = v[n] * v[n]; }
                    st8_nt(O + ((size_t)((row >> 4) * (DFF >> 5) + ((cb + bj * 128) >> 5)) * 512 + (row & 15) * 32 + 8 * fq), v[0], v[1]);
                }
            }
    }
};
struct EpiInproj {
    static constexpr bool PERM = true, AFTER_DRAIN = false;
    bf16_t *ZF, *QS, *KS, *VS, *CQ, *CKV, *KR; float *RSSQ, *RSSKV; const float *cosh, *sinh, *cosr, *sinr; const float* RSSH; const float* bias;
    __device__ __forceinline__ void operator()(const pg8::f32x4 (&acc_in)[2][2][4][2], const pg8::Unit& u, int wr, int wc, int fr, int fq) const {
        const int pn = u.pn, c8 = wc * 32 + 8 * fq;
        pg8::f32x4 bv[2][2];
#pragma unroll
        for (int bj = 0; bj < 2; ++bj)
#pragma unroll
            for (int n = 0; n < 2; ++n) bv[bj][n] = RSSH ? *(const pg8::f32x4*)(bias + (size_t)modrow(u.pm * 256) * NIN_PAD + pn * 256 + c8 + bj * 128 + n * 4) : (pg8::f32x4){0.f, 0.f, 0.f, 0.f};
#pragma unroll
        for (int ai = 0; ai < 2; ++ai)
#pragma unroll
            for (int m = 0; m < 4; ++m) {
                const int row = u.pm * 256 + ai * 128 + wr * 64 + m * 16 + fr;
                const bool lat = row < ML; const int s = row & 4095;
                pg8::f32x4 a[2][2];
#pragma unroll
                for (int bj = 0; bj < 2; ++bj)
#pragma unroll
                    for (int n = 0; n < 2; ++n) a[bj][n] = acc_in[ai][bj][m][n];
                if (RSSH) { const float r = rstd16(RSSH, row, fq);
#pragma unroll
                    for (int bj = 0; bj < 2; ++bj)
#pragma unroll
                        for (int n = 0; n < 2; ++n) a[bj][n] = a[bj][n] * r + bv[bj][n]; }
                if (pn < 2) {
#pragma unroll
                    for (int bj = 0; bj < 2; ++bj) st8(ZF + (size_t)row * 512 + pn * 256 + bj * 128 + c8, a[bj][0], a[bj][1]);
                } else if (pn < 4) {
                    const int e = wc & 1, i0 = 16 * e + 4 * fq;
#pragma unroll
                    for (int bj = 0; bj < 2; ++bj) {
                        const int H = (pn - 2) * 4 + bj * 2 + (wc >> 1);
                        pg8::f32x4 y1 = a[bj][0], y2 = a[bj][1];
                        if (lat) { const pg8::f32x4 c4 = *(const pg8::f32x4*)(cosh + s * 32 + i0), s4 = *(const pg8::f32x4*)(sinh + s * 32 + i0);
                                   const pg8::f32x4 x1 = y1, x2 = y2; y1 = x1 * c4 - x2 * s4; y2 = x1 * s4 + x2 * c4; }
                        if (H < 6) { y1 = y1 * (0.125f * 1.4426950408889634f); y2 = y2 * (0.125f * 1.4426950408889634f);
                                     st8(QS + (size_t)row * 384 + H * 64 + 32 * e + 8 * fq, y1, y2); }
                        else st8(KS + ((size_t)(((row >> 6) * 2 + (H - 6)) * 8 + 4 * e + fq) * 64 + (row & 63)) * 8, y1, y2);
                    }
                } else if (pn == 4) {
                    st8(VS + ((size_t)((((row >> 6) * 2 + (wc >> 1)) * 2 + (wc & 1)) * 64 + (row & 63)) * 4 + fq) * 8, a[0][0], a[0][1]);
                    st8(CKV + (size_t)row * 128 + c8, a[1][0], a[1][1]);
                    float ss = sq4(a[1][0]) + sq4(a[1][1]);
                    ss += shfl_xor_f(ss, 16); ss += shfl_xor_f(ss, 32);
                    if (fq == 0) RSSKV[(size_t)row * 4 + wc] = ss;
                } else if (pn == 5) {
#pragma unroll
                    for (int bj = 0; bj < 2; ++bj) {
                        st8(CQ + (size_t)row * 256 + bj * 128 + c8, a[bj][0], a[bj][1]);
                        float ss = sq4(a[bj][0]) + sq4(a[bj][1]);
                        ss += shfl_xor_f(ss, 16); ss += shfl_xor_f(ss, 32);
                        if (fq == 0) RSSQ[(size_t)row * 8 + bj * 4 + wc] = ss;
                    }
                } else if (wc == 0) {
                    pg8::f32x4 y1 = a[0][0], y2 = a[0][1];
                    if (lat) { const pg8::f32x4 c4 = *(const pg8::f32x4*)(cosr + s * 16 + 4 * fq), s4 = *(const pg8::f32x4*)(sinr + s * 16 + 4 * fq);
                               const pg8::f32x4 x1 = y1, x2 = y2; y1 = x1 * c4 - x2 * s4; y2 = x1 * s4 + x2 * c4; }
                    st8(KR + ((size_t)((row >> 6) * 4 + fq) * 64 + (row & 63)) * 8, y1, y2);
                }
            }
    }
};
struct EpiUpQ {
    static constexpr bool PERM = true, AFTER_DRAIN = false;
    bf16_t* QM; const float* RSSQ; const float *cosr, *sinr;
    __device__ __forceinline__ void operator()(const pg8::f32x4 (&acc)[2][2][4][2], const pg8::Unit& u, int wr, int wc, int fr, int fq) const {
#pragma unroll
        for (int ai = 0; ai < 2; ++ai)
#pragma unroll
            for (int m = 0; m < 4; ++m) {
                const int row = u.pm * 256 + ai * 128 + wr * 64 + m * 16 + fr;
                const bool lat = row < ML; const int s = row & 4095;
                float r; { const v2u_f pa = *(const v2u_f*)(RSSQ + (size_t)row * 8 + 2 * fq); float s_ = pa.x + pa.y; s_ += shfl_xor_f(s_, 16); s_ += shfl_xor_f(s_, 32);
                           r = (0.10206207261596577f * 1.4426950408889634f) / sqrtf(s_ * (1.0f / 256.0f) + EPS); }
#pragma unroll
                for (int bj = 0; bj < 2; ++bj) {
                    const int grp = u.pn * 8 + bj * 4 + wc;
                    if (grp < 18) {
                        pg8::f32x4 y1 = acc[ai][bj][m][0] * r, y2 = acc[ai][bj][m][1] * r;
                        if (grp >= 12 && lat) { const pg8::f32x4 c4 = *(const pg8::f32x4*)(cosr + s * 16 + 4 * fq), s4 = *(const pg8::f32x4*)(sinr + s * 16 + 4 * fq);
                                                const pg8::f32x4 x1 = y1, x2 = y2; y1 = x1 * c4 - x2 * s4; y2 = x1 * s4 + x2 * c4; }
                        st8(QM + (size_t)row * QMW + grp * 32 + 8 * fq, y1, y2);
                    }
                }
            }
    }
};
struct EpiUpKV {
    static constexpr bool PERM = true, AFTER_DRAIN = false;
    bf16_t *KN, *VM; const float* RSSKV;
    __device__ __forceinline__ void operator()(const pg8::f32x4 (&acc)[2][2][4][2], const pg8::Unit& u, int wr, int wc, int fr, int fq) const {
#pragma unroll
        for (int ai = 0; ai < 2; ++ai)
#pragma unroll
            for (int m = 0; m < 4; ++m) {
                const int row = u.pm * 256 + ai * 128 + wr * 64 + m * 16 + fr;
                float r; { float s_ = RSSKV[(size_t)row * 4 + fq]; s_ += shfl_xor_f(s_, 16); s_ += shfl_xor_f(s_, 32); r = 1.0f / sqrtf(s_ * (1.0f / 128.0f) + EPS); }
#pragma unroll
                for (int bj = 0; bj < 2; ++bj) {
                    const int cb = u.pn * 2 + bj, tile = row >> 6, rit = row & 63;
                    bf16_t* dst;
                    if (cb < 3) { const int head = cb * 2 + (wc >> 1), chunk = (wc & 1) * 4 + fq; dst = KN + ((size_t)((tile * 6 + head) * 8 + chunk) * 64 + rit) * 8; }
                    else { const int head = (cb - 3) * 2 + (wc >> 1); dst = VM + ((size_t)(((tile * 6 + head) * 2 + (wc & 1)) * 64 + rit) * 4 + fq) * 8; }
                    st8(dst, acc[ai][bj][m][0] * r, acc[ai][bj][m][1] * r);
                }
            }
    }
};
namespace attn {
using bf16x8 = __attribute__((ext_vector_type(8))) short;
using s16x4  = __attribute__((ext_vector_type(4))) short;
using f32x16 = __attribute__((ext_vector_type(16))) float;
using u32x4  = __attribute__((ext_vector_type(4))) unsigned;
constexpr int NW = 8, QBLK = 32, KVBLK = 64;
constexpr int SHM_V = 16384, SHM_K = 16384, SHM_ATTN = 2 * SHM_V + 2 * SHM_K + NW * 64 * 4;
constexpr float LOG2E = 1.4426950408889634f;
constexpr float THRN = 8.f;
#define KSWZ(row, colB) ((row) * 256 + ((colB) ^ (((row) & 7) << 4)))
#define SBAR() __builtin_amdgcn_sched_barrier(0)
__device__ __forceinline__ int crow(int r, int hi) { return (r & 3) + 8 * (r >> 2) + 4 * hi; }
__device__ __forceinline__ unsigned cvtpk(float lo, float hi) { unsigned r; asm volatile("v_cvt_pk_bf16_f32 %0, %1, %2" : "=v"(r) : "v"(lo), "v"(hi)); return r; }

template <int MODE> struct Cfg;
template <> struct Cfg<0> { static constexpr int KD = 96; static constexpr float SCALE = 0.10206207261596577f; static constexpr int NLOAD = 3; };
template <> struct Cfg<1> { static constexpr int KD = 64; static constexpr float SCALE = 0.125f; static constexpr int NLOAD = 2; };

template <int MODE>
__device__ __forceinline__ void partialSM(f32x16& p0, f32x16& p1, float& m_reg, float& mn, float& alpha) {
  constexpr float SC = Cfg<MODE>::SCALE, C = SC * LOG2E;
  float pmax = p0[0];
#pragma unroll
  for (int r = 1; r < 16; ++r) pmax = fmaxf(pmax, p0[r]);
#pragma unroll
  for (int r = 0; r < 16; ++r) pmax = fmaxf(pmax, p1[r]);
  { auto rr = __builtin_amdgcn_permlane32_swap(__float_as_uint(pmax), __float_as_uint(pmax), false, false);
    pmax = fmaxf(__uint_as_float(rr[0]), __uint_as_float(rr[1])); }
  if (__builtin_expect(__all(pmax - m_reg <= THRN / SC), 1)) { mn = m_reg; alpha = 1.f; }
  else { mn = fmaxf(m_reg, pmax); alpha = __builtin_amdgcn_exp2f((m_reg - mn) * C); m_reg = mn; }
  const float mnC = -mn * C;
#pragma unroll
  for (int r = 0; r < 16; ++r) p0[r] = fmaf(p0[r], C, mnC);
#pragma unroll
  for (int r = 0; r < 16; ++r) p1[r] = fmaf(p1[r], C, mnC);
#pragma unroll
  for (int r = 0; r < 16; ++r) p0[r] = __builtin_amdgcn_exp2f(p0[r]);
}
__device__ __forceinline__ void finishSM(f32x16& p0, f32x16& p1, float alpha, float& l_reg, bf16x8& pa0, bf16x8& pa1, bf16x8& pa2, bf16x8& pa3) {
#pragma unroll
  for (int r = 0; r < 16; ++r) p1[r] = __builtin_amdgcn_exp2f(p1[r]);
  float ps = 0;
#pragma unroll
  for (int r = 0; r < 16; ++r) ps += p0[r];
#pragma unroll
  for (int r = 0; r < 16; ++r) ps += p1[r];
  { auto rr = __builtin_amdgcn_permlane32_swap(__float_as_uint(ps), __float_as_uint(ps), false, false);
    ps = __uint_as_float(rr[0]) + __uint_as_float(rr[1]); }
  l_reg = l_reg * alpha + ps;
#define PK4(P, BASE, OUT) do { unsigned a0 = cvtpk(P[BASE + 0], P[BASE + 1]), a1 = cvtpk(P[BASE + 2], P[BASE + 3]);   \
    unsigned b0 = cvtpk(P[BASE + 4], P[BASE + 5]), b1 = cvtpk(P[BASE + 6], P[BASE + 7]);                              \
    auto r0 = __builtin_amdgcn_permlane32_swap(a0, b0, false, false); auto r1 = __builtin_amdgcn_permlane32_swap(a1, b1, false, false); \
    u32x4 w = {r0[0], r1[0], r0[1], r1[1]}; OUT = *reinterpret_cast<bf16x8*>(&w); } while (0)
  PK4(p0, 0, pa0); PK4(p0, 8, pa1); PK4(p1, 0, pa2); PK4(p1, 8, pa3);
#undef PK4
}
template <int KD>
__device__ __forceinline__ void qkt(f32x16& p0, f32x16& p1, const char* Ks, const bf16x8* qr, int r32, int hi) {
  p0 = f32x16{}; p1 = f32x16{};
#pragma unroll
  for (int d0 = 0; d0 < KD / 16; ++d0) { const int cb = (d0 * 16 + hi * 8) * 2;
    const bf16x8 b0 = *reinterpret_cast<const bf16x8*>(Ks + KSWZ(r32, cb));
    const bf16x8 b1 = *reinterpret_cast<const bf16x8*>(Ks + KSWZ(32 + r32, cb));
    p0 = __builtin_amdgcn_mfma_f32_32x32x16_bf16(b0, qr[d0], p0, 0, 0, 0);
    p1 = __builtin_amdgcn_mfma_f32_32x32x16_bf16(b1, qr[d0], p1, 0, 0, 0); }
}
__device__ __forceinline__ int v_st(int k, int c) { const int kk = (k & ~0xC) | ((k & 4) << 1) | ((k & 8) >> 1); return ((kk >> 3) * 4 + (c >> 5)) * 512 + ((kk & 7) * 32 + (c & 31)) * 2; }
__device__ __forceinline__ int v_rd_base(int lane) { return ((lane & 3) << 3) | (((lane >> 2) & 3) << 6) | (((lane >> 4) & 1) << 5) | (((lane >> 5) & 1) << 8); }
constexpr int v_rd_off(int d0, int ks, int half) { return d0 * 512 + ks * 4096 + half * 2048; }
template <int OFF> __device__ __forceinline__ s16x4 tr_read(int vb) {
  s16x4 r; asm volatile("ds_read_b64_tr_b16 %0, %1 offset:%2" : "=&v"(r) : "v"(vb), "i"(OFF) : "memory"); return r;
}
template <int D0> __device__ __forceinline__ void pv_one(f32x16& od, int vb, bf16x8 pa0, bf16x8 pa1, bf16x8 pa2, bf16x8 pa3) {
  const s16x4 l0 = tr_read<v_rd_off(D0, 0, 0)>(vb), h0 = tr_read<v_rd_off(D0, 0, 1)>(vb), l1 = tr_read<v_rd_off(D0, 1, 0)>(vb), h1 = tr_read<v_rd_off(D0, 1, 1)>(vb);
  const s16x4 l2 = tr_read<v_rd_off(D0, 2, 0)>(vb), h2 = tr_read<v_rd_off(D0, 2, 1)>(vb), l3 = tr_read<v_rd_off(D0, 3, 0)>(vb), h3 = tr_read<v_rd_off(D0, 3, 1)>(vb);
  asm volatile("s_waitcnt lgkmcnt(0)" ::: "memory"); SBAR();
#define PK(L, H) (bf16x8){L[0], L[1], L[2], L[3], H[0], H[1], H[2], H[3]}
  od = __builtin_amdgcn_mfma_f32_32x32x16_bf16(pa0, PK(l0, h0), od, 0, 0, 0);
  od = __builtin_amdgcn_mfma_f32_32x32x16_bf16(pa1, PK(l1, h1), od, 0, 0, 0);
  od = __builtin_amdgcn_mfma_f32_32x32x16_bf16(pa2, PK(l2, h2), od, 0, 0, 0);
  od = __builtin_amdgcn_mfma_f32_32x32x16_bf16(pa3, PK(l3, h3), od, 0, 0, 0);
#undef PK
}
__device__ __forceinline__ void pv_d0(f32x16* o, int vb, bf16x8 pa0, bf16x8 pa1, bf16x8 pa2, bf16x8 pa3) {
  pv_one<0>(o[0], vb, pa0, pa1, pa2, pa3); pv_one<1>(o[1], vb, pa0, pa1, pa2, pa3);
}
__device__ __forceinline__ void swa_mask(f32x16& p0, f32x16& p1, int kbase, int qpos, int hi) {
#pragma unroll
  for (int r = 0; r < 16; ++r) {
    const int k0 = kbase + crow(r, hi) - qpos, k1 = k0 + 32;
    if (k0 > 128 || k0 < -128) p0[r] = -1e30f;
    if (k1 > 128 || k1 < -128) p1[r] = -1e30f;
  }
}

template <int MODE>
__device__ __forceinline__ void attn_unit(const P& p, int l, bool isctx, int b, int h, int q0, char* lds) {
  constexpr int KD = Cfg<MODE>::KD; constexpr float SC = Cfg<MODE>::SCALE, C = SC * LOG2E;
  const int tid = tidx(), wid = tid >> 6, lane = tid & 63, r32 = lane & 31, hi = lane >> 5;
  char* V_lds = lds; char* K_lds = lds + 2 * SHM_V;
  float* wsf = (float*)(lds + 2 * SHM_V + 2 * SHM_K) + wid * 64; float* li_l = wsf; float* al_l = wsf + 32;
  const bf16_t* QM = ws_qm(p); const bf16_t* KN = ws_kn(p); const bf16_t* VM = ws_vm(p); const bf16_t* KR = ws_kr(p);
  const bf16_t* QS = ws_qs(p); const bf16_t* KS = ws_ks(p); const bf16_t* VS = ws_vs(p);
  const int qrow0 = isctx ? ML + b * 256 : b * 4096 + q0;
  const int qrow = qrow0 + wid * QBLK + r32, qpos = q0 + wid * QBLK + r32;
  const int kvh = h / 3;
  int kstart = 0, NT;
  if (MODE == 0) NT = isctx ? 4 : 68;
  else { if (isctx) NT = 4; else { kstart = max(0, q0 - 128); const int kend = min(S, q0 + 384); NT = 4 + (kend - kstart) / 64; } }
  auto tile_row = [&](int t) -> int {
    if (isctx) return ML + b * 256 + t * 64;
    if (MODE == 0) return t < 64 ? b * 4096 + t * 64 : ML + b * 256 + (t - 64) * 64;
    return t < 4 ? ML + b * 256 + t * 64 : b * 4096 + kstart + (t - 4) * 64;
  };
  float m_reg = -1e30f, l_reg = 0; f32x16 o[2] = {}; bf16x8 qr[KD / 16];
  if (MODE == 0) {
    const bf16_t* Qw = QM + (size_t)qrow * QMW + hi * 8;
#pragma unroll
    for (int d0 = 0; d0 < 4; ++d0) qr[d0] = *reinterpret_cast<const bf16x8*>(Qw + h * 64 + d0 * 16);
#pragma unroll
    for (int d0 = 4; d0 < 6; ++d0) qr[d0] = *reinterpret_cast<const bf16x8*>(Qw + 384 + h * 32 + (d0 - 4) * 16);
  } else {
    const bf16_t* Qw = QS + (size_t)qrow * 384 + h * 64 + hi * 8;
#pragma unroll
    for (int d0 = 0; d0 < 4; ++d0) qr[d0] = *reinterpret_cast<const bf16x8*>(Qw + d0 * 16);
  }
  const int srow = tid >> 3, sch = tid & 7, srow2 = (tid & 255) >> 2, sch2 = tid & 3;
  const int kst = KSWZ(srow, sch * 16), kst2 = KSWZ(srow2, (8 + sch2) * 16), vst = v_st(srow, sch * 8);
  const int vb0 = (int)(uintptr_t)V_lds + v_rd_base(lane);
  struct Slot { bf16x8 k, v, k2; } sl_[2];
#define SLOAD(i, t) do { const int rb_ = tile_row(t); \
    if (MODE == 0) { sl_[i].k = *reinterpret_cast<const bf16x8*>(KN + (size_t)(rb_ + srow) * 384 + h * 64 + sch * 8); \
      sl_[i].v = *reinterpret_cast<const bf16x8*>(VM + (size_t)(rb_ + srow) * 384 + h * 64 + sch * 8); \
      sl_[i].k2 = *reinterpret_cast<const bf16x8*>(KR + (size_t)(rb_ + srow2) * 32 + sch2 * 8); } \
    else { sl_[i].k = *reinterpret_cast<const bf16x8*>(KS + (size_t)(rb_ + srow) * 128 + kvh * 64 + sch * 8); \
      sl_[i].v = *reinterpret_cast<const bf16x8*>(VS + (size_t)(rb_ + srow) * 128 + kvh * 64 + sch * 8); } } while (0)
#define SWRITE(bf, i) do { *(bf16x8*)(V_lds + (bf) * SHM_V + vst) = sl_[i].v; *(bf16x8*)(K_lds + (bf) * SHM_K + kst) = sl_[i].k; \
    if (MODE == 0) *(bf16x8*)(K_lds + (bf) * SHM_K + kst2) = sl_[i].k2; } while (0)
#define SWAIT() do { if (MODE == 0) asm volatile("s_waitcnt vmcnt(3)" ::: "memory"); else asm volatile("s_waitcnt vmcnt(2)" ::: "memory"); } while (0)
#define RESC(a) do { if (__any((a) < 1.f)) { if (hi == 0) al_l[r32] = (a); asm volatile("s_waitcnt lgkmcnt(0)" ::: "memory"); \
    _Pragma("unroll") for (int d = 0; d < 2; ++d) _Pragma("unroll") for (int r = 0; r < 16; ++r) o[d][r] *= al_l[crow(r, hi)]; } } while (0)
#define MASK(P0, P1, t) do { if (MODE == 1 && !isctx && (t) >= 4) swa_mask(P0, P1, kstart + ((t) - 4) * 64, qpos, hi); } while (0)
  f32x16 pA0, pA1, pB0, pB1; float mnA, mnB, alA, alB; bf16x8 pa0, pa1, pa2, pa3;
  constexpr int SE = 0, SO = 1;
  SLOAD(SE, 0); asm volatile("s_waitcnt vmcnt(0)" ::: "memory"); SWRITE(0, SE); __syncthreads();
  qkt<KD>(pA0, pA1, K_lds, qr, r32, hi); MASK(pA0, pA1, 0); partialSM<MODE>(pA0, pA1, m_reg, mnA, alA);
  SLOAD(SO, 1); if (2 < NT) SLOAD(SE, 2);
  SWAIT(); SWRITE(1, SO); __syncthreads();
  for (int j = 1; j + 1 < NT; j += 2) {
    SBAR(); qkt<KD>(pB0, pB1, K_lds + SHM_K, qr, r32, hi);
    finishSM(pA0, pA1, alA, l_reg, pa0, pa1, pa2, pa3); SBAR();
    SLOAD(SO, j + 2); SBAR();
    pv_d0(o, vb0, pa0, pa1, pa2, pa3); MASK(pB0, pB1, j); partialSM<MODE>(pB0, pB1, m_reg, mnB, alB);
    __syncthreads(); SWAIT(); SWRITE(0, SE);
    RESC(alB); __syncthreads();
    SBAR(); qkt<KD>(pA0, pA1, K_lds, qr, r32, hi);
    finishSM(pB0, pB1, alB, l_reg, pa0, pa1, pa2, pa3); SBAR();
    if (j + 3 < NT) SLOAD(SE, j + 3); SBAR();
    pv_d0(o, vb0 + SHM_V, pa0, pa1, pa2, pa3); MASK(pA0, pA1, j + 1); partialSM<MODE>(pA0, pA1, m_reg, mnA, alA);
    __syncthreads(); SWAIT(); SWRITE(1, SO);
    RESC(alA); __syncthreads();
  }
  SBAR(); qkt<KD>(pB0, pB1, K_lds + SHM_K, qr, r32, hi);
  finishSM(pA0, pA1, alA, l_reg, pa0, pa1, pa2, pa3); SBAR();
  pv_d0(o, vb0, pa0, pa1, pa2, pa3); MASK(pB0, pB1, NT - 1); partialSM<MODE>(pB0, pB1, m_reg, mnB, alB);
  __syncthreads(); RESC(alB);
  finishSM(pB0, pB1, alB, l_reg, pa0, pa1, pa2, pa3); SBAR();
  pv_d0(o, vb0 + SHM_V, pa0, pa1, pa2, pa3);
  if (MODE == 1) l_reg += __builtin_amdgcn_exp2f(p.sink[l * 6 + h] * LOG2E - m_reg * C);
  if (hi == 0) li_l[r32] = l_reg; asm volatile("s_waitcnt lgkmcnt(0)" ::: "memory");
  float rli[16];
#pragma unroll
  for (int r = 0; r < 16; ++r) rli[r] = __builtin_amdgcn_rcpf(li_l[crow(r, hi)]);
  bf16_t* Ow = ws_mix(p) + (size_t)(qrow0 + wid * QBLK) * 1024 + (MODE == 0 ? 640 : 256) + h * 64;
  { bf16_t* stg = (bf16_t*)(lds + SHM_ATTN) + wid * 2048;
#pragma unroll
    for (int r = 0; r < 16; ++r) { const int orow = crow(r, hi);
#pragma unroll
      for (int d0 = 0; d0 < 2; ++d0) stg[orow * 64 + d0 * 32 + r32] = f2bf(o[d0][r] * rli[r]); }
    asm volatile("s_waitcnt lgkmcnt(0)" ::: "memory");
#pragma unroll
    for (int i = 0; i < 4; ++i) { const int row = i * 8 + (lane >> 3), ch = lane & 7; const u32x4 v = *(const u32x4*)(stg + row * 64 + ch * 8); *(u32x4*)(Ow + (size_t)row * 1024 + ch * 8) = v; }
    asm volatile("s_waitcnt lgkmcnt(0)" ::: "memory"); }
  __syncthreads();
#undef SLOAD
#undef SWRITE
#undef SWAIT
#undef RESC
#undef MASK
}
#undef KSWZ
#undef SBAR
}

__device__ __forceinline__ bf16_t* ws_fwa(const P& p) { return (bf16_t*)(p.ws + O_FFTW); }
__device__ __forceinline__ bf16_t* ws_fwb(const P& p) { return (bf16_t*)(p.ws + O_FFTW + 32768); }
__device__ __forceinline__ bf16_t* ws_fwc(const P& p) { return (bf16_t*)(p.ws + O_FFTW + 65536); }
__device__ __forceinline__ float2* ws_tw(const P& p) { return (float2*)(p.ws + O_TW); }
__device__ __forceinline__ void fp_fftw(const P& p, int bid, int nb) {
    const int gt = bid * FAST_THREADS + tidx(), GT = nb * FAST_THREADS;
    for (int i = gt; i < 4096; i += GT) { float sn, cs; sincospif((float)i * (1.0f / 2048.0f), &sn, &cs); ws_tw(p)[i] = make_float2(cs, sn); }
    for (int i = gt; i < 128 * 128; i += GT) {
        const int m = i >> 7, k = i & 127, pp = m >> 6, s1p = m & 63, part = k >> 6, s1 = k & 63;
        float sn, cs; sincospif((float)((s1 * s1p) & 63) * (1.0f / 32.0f), &sn, &cs);
        const float v = pp == 0 ? (part == 0 ? cs : -sn) : (part == 0 ? -sn : -cs);
        ws_fwa(p)[i] = f2bf(v);
    }
    for (int i = gt; i < 64 * 128; i += GT) {
        const int m = i >> 7, k = i & 127, part = k >> 6, s2 = k & 63;
        float sn, cs; sincospif((float)((s2 * m) & 63) * (1.0f / 32.0f), &sn, &cs);
        ws_fwb(p)[i] = f2bf((part == 0 ? cs : sn) * (1.0f / 512.0f));
    }
    for (int i = gt; i < 256 * 512; i += GT) {
        const int m = i >> 9, k = i & 511, part = k >> 8, s = k & 255;
        float sn, cs; sincospif((float)((s * m) & 255) * (1.0f / 128.0f), &sn, &cs);
        ws_fwc(p)[i] = f2bf((part == 0 ? cs : -sn) * (1.0f / 128.0f));
    }
}
namespace fft {
using attn::bf16x8; using attn::s16x4; using attn::f32x16;
template <class RowFn> __device__ __forceinline__ void ld_rows(bf16x8 (&v)[8], RowFn rowptr, int c) {
    const int tid = tidx();
#pragma unroll
    for (int i = 0; i < 8; ++i) { const int q = tid + 512 * i, k = q >> 5, cc = q & 31; v[i] = *reinterpret_cast<const bf16x8*>(rowptr(c * 128 + k) + cc * 8); }
}
__device__ __forceinline__ void st_tile(char* lds, const bf16x8 (&v)[8]) {
    const int tid = tidx();
#pragma unroll
    for (int i = 0; i < 8; ++i) { const int q = tid + 512 * i, k = q >> 5, cc = q & 31;
        *(bf16x8*)(lds + ((k >> 6) * 2 + (cc >> 4)) * 16384 + attn::v_st(k & 63, (cc & 15) * 8)) = v[i]; }
}
template <int LDW> __device__ __forceinline__ void ld_w(bf16x8 (&wf)[2][8], const bf16_t* W, int t0, int c) {
    const int lane = tidx() & 63, r32 = lane & 31, hi = lane >> 5;
#pragma unroll
    for (int t = 0; t < 2; ++t) { const bf16_t* wp = W + (size_t)(32 * (t0 + t) + r32) * LDW + c * 128 + 8 * hi;
#pragma unroll
        for (int ks = 0; ks < 8; ++ks) wf[t][ks] = *reinterpret_cast<const bf16x8*>(wp + 16 * ks); }
}
__device__ __forceinline__ void rd_tile(bf16x8 (&bfr)[8], char* lds) {
    const int tid = tidx(), w = tid >> 6, lane = tid & 63;
    const int vb = (int)(uintptr_t)lds + attn::v_rd_base(lane) + (w >> 2) * 16384 + (w & 3) * 512;
#define FFT_RD(ks) { const s16x4 lo_ = attn::tr_read<((ks) >> 2) * 32768 + ((ks) & 3) * 4096>(vb), hi_ = attn::tr_read<((ks) >> 2) * 32768 + ((ks) & 3) * 4096 + 2048>(vb); \
                     bfr[ks] = (bf16x8){lo_[0], lo_[1], lo_[2], lo_[3], hi_[0], hi_[1], hi_[2], hi_[3]}; }
    FFT_RD(0) FFT_RD(1) FFT_RD(2) FFT_RD(3) FFT_RD(4) FFT_RD(5) FFT_RD(6) FFT_RD(7)
#undef FFT_RD
    asm volatile("s_waitcnt lgkmcnt(0)" ::: "memory"); __builtin_amdgcn_sched_barrier(0);
}
__device__ __forceinline__ void mac2(f32x16& a0, f32x16& a1, const bf16x8 (&wf)[2][8], const bf16x8 (&bfr)[8]) {
#pragma unroll
    for (int ks = 0; ks < 8; ++ks) a0 = __builtin_amdgcn_mfma_f32_32x32x16_bf16(wf[0][ks], bfr[ks], a0, 0, 0, 0);
#pragma unroll
    for (int ks = 0; ks < 8; ++ks) a1 = __builtin_amdgcn_mfma_f32_32x32x16_bf16(wf[1][ks], bfr[ks], a1, 0, 0, 0);
}
constexpr int TWL = 131072 + 4096;
}
__device__ __forceinline__ void fp_fft_a(const P& p, bool with_ctx, LAS unsigned char* ldsl, int bid, int nb) {
    char* lds = (char*)ldsl;
    const int tid = tidx(), w = tid >> 6, lane = tid & 63, r32 = lane & 31, hi = lane >> 5;
    const bf16_t* ZF = ws_zf(p); bf16_t* YB = ws_yb(p); bf16_t* MIX = ws_mix(p); const float2* TW = ws_tw(p);
    const int nu = 512 + (with_ctx ? 32 : 0);
    constexpr int WL = 65536, STG = 98304;
#pragma unroll
    for (int i = 0; i < 4; ++i) { const int q = tid + 512 * i, row = q >> 4, c = q & 15; *(v4u*)(lds + WL + row * 256 + ((c ^ (row & 15)) << 4)) = *(const v4u*)(ws_fwa(p) + row * 128 + c * 8); }
    auto rowp = [&](int u, int k) -> const bf16_t* {
        if (u < 512) { const int b = u >> 6, s2 = u & 63; return ZF + (size_t)(b * 4096 + 64 * (k & 63) + s2) * 512 + (k >> 6) * 256; }
        const int b = (u - 512) >> 2; return ZF + (size_t)(ML + b * 256 + (k & 255)) * 512 + (k >> 8) * 256; };
    attn::bf16x8 v[8];
    int u = nb - 1 - bid;
    if (u < nu) fft::ld_rows(v, [&](int k) { return rowp(u, k); }, 0);
    for (; u < nu; u += nb) {
        const int un = u + nb;
        attn::bf16x8 bfr[8];
        bf16_t* stg = (bf16_t*)(lds + STG) + w * 2048;
        if (u < 512) {
            const int b = u >> 6, s2 = u & 63;
            float2 twv = make_float2(0.f, 0.f); if (w == 0) twv = TW[s2 * lane];
            attn::f32x16 acc[4];
#pragma unroll
            for (int t = 0; t < 4; ++t) acc[t] = attn::f32x16{};
            __syncthreads();
            fft::st_tile(lds, v); if (w == 0) *(float2*)(lds + fft::TWL + lane * 8) = twv;
            __syncthreads();
            if (un < nu) fft::ld_rows(v, [&](int k) { return rowp(un, k); }, 0);
            fft::rd_tile(bfr, lds);
            const char* wrow = lds + WL + r32 * 256; const int x = r32 & 15;
#pragma unroll
            for (int t = 0; t < 4; ++t)
#pragma unroll
                for (int ks = 0; ks < 8; ++ks) {
                    const attn::bf16x8 wfr = *(const attn::bf16x8*)(wrow + t * 8192 + (((2 * ks + hi) ^ x) << 4));
                    acc[t] = __builtin_amdgcn_mfma_f32_32x32x16_bf16(wfr, bfr[ks], acc[t], 0, 0, 0);
                }
            const char* twb = lds + fft::TWL + hi * 32;
#pragma unroll
            for (int tt = 0; tt < 2; ++tt) {
#pragma unroll
                for (int r = 0; r < 16; ++r) {
                    const float2 cs = *(const float2*)(twb + (32 * tt + attn::crow(r, 0)) * 8);
                    const float yr = acc[tt][r], yi = acc[tt + 2][r];
                    const unsigned pk = pg8::cvt_pk_bf16(yr * cs.x + yi * cs.y, yi * cs.x - yr * cs.y);
                    stg[attn::crow(r, hi) * 64 + r32] = (bf16_t)(pk & 0xffffu); stg[attn::crow(r, hi) * 64 + 32 + r32] = (bf16_t)(pk >> 16);
                }
                asm volatile("s_waitcnt lgkmcnt(0)" ::: "memory");
#pragma unroll
                for (int i = 0; i < 4; ++i) { const int s1p = 32 * tt + i * 8 + (lane >> 3), c8 = lane & 7;
                    const v4u vv = *(const v4u*)(stg + (i * 8 + (lane >> 3)) * 64 + c8 * 8);
                    *(v4u*)(YB + ((size_t)((b * 64 + s1p) * 64 + s2)) * 512 + (c8 >> 2) * 256 + 32 * w + (c8 & 3) * 8) = vv; }
                asm volatile("s_waitcnt lgkmcnt(0)" ::: "memory");
            }
        } else {
            const int b = (u - 512) >> 2, tq = (u - 512) & 3;
            attn::f32x16 acc[2]; acc[0] = attn::f32x16{}; acc[1] = attn::f32x16{};
            attn::bf16x8 wf[2][8];
#pragma unroll 1
            for (int c = 0; c < 4; ++c) {
                __syncthreads(); fft::st_tile(lds, v); __syncthreads();
                fft::ld_w<512>(wf, ws_fwc(p) + (size_t)(64 * tq) * 512, 0, c);
                __builtin_amdgcn_sched_barrier(0);
                if (c < 3) fft::ld_rows(v, [&](int k) { return rowp(u, k); }, c + 1);
                __builtin_amdgcn_sched_barrier(0);
                fft::rd_tile(bfr, lds);
                fft::mac2(acc[0], acc[1], wf, bfr);
            }
#pragma unroll
            for (int t = 0; t < 2; ++t)
#pragma unroll
                for (int r = 0; r < 16; ++r) stg[(32 * t + attn::crow(r, hi)) * 32 + r32] = f2bf(acc[t][r]);
            asm volatile("s_waitcnt lgkmcnt(0)" ::: "memory");
#pragma unroll
            for (int i = 0; i < 4; ++i) { const int rr = i * 16 + (lane >> 2), c4 = lane & 3; const v4u vv = *(const v4u*)(stg + rr * 32 + c4 * 8);
                *(v4u*)(MIX + (size_t)(ML + b * 256 + 64 * tq + rr) * 1024 + 32 * w + c4 * 8) = vv; }
            asm volatile("s_waitcnt lgkmcnt(0)" ::: "memory");
        }
    }
    __syncthreads();
}
__device__ __forceinline__ void fp_fft_b(const P& p, LAS unsigned char* ldsl, int bid, int nb) {
    char* lds = (char*)ldsl;
    const int tid = tidx(), w = tid >> 6, lane = tid & 63, r32 = lane & 31, hi = lane >> 5;
    const bf16_t* YB = ws_yb(p); bf16_t* MIX = ws_mix(p);
    constexpr int WL = 65536, STG = 98304;
#pragma unroll
    for (int i = 0; i < 2; ++i) { const int q = tid + 512 * i, row = q >> 4, c = q & 15; *(v4u*)(lds + WL + row * 256 + ((c ^ (row & 15)) << 4)) = *(const v4u*)(ws_fwb(p) + row * 128 + c * 8); }
    auto rowp = [&](int u, int k) -> const bf16_t* { const int b = u >> 6, s1p = u & 63; return YB + ((size_t)((b * 64 + s1p) * 64 + (k & 63))) * 512 + (k >> 6) * 256; };
    attn::bf16x8 v[8];
    int u = bid;
    if (u < 512) fft::ld_rows(v, [&](int k) { return rowp(u, k); }, 0);
    for (; u < 512; u += nb) {
        const int b = u >> 6, s1p = u & 63, un = u + nb;
        attn::bf16x8 bfr[8];
        attn::f32x16 acc[2]; acc[0] = attn::f32x16{}; acc[1] = attn::f32x16{};
        __syncthreads(); fft::st_tile(lds, v); __syncthreads();
        if (un < 512) fft::ld_rows(v, [&](int k) { return rowp(un, k); }, 0);
        fft::rd_tile(bfr, lds);
        const char* wrow = lds + WL + r32 * 256; const int x = r32 & 15;
#pragma unroll
        for (int t = 0; t < 2; ++t)
#pragma unroll
            for (int ks = 0; ks < 8; ++ks) {
                const attn::bf16x8 wfr = *(const attn::bf16x8*)(wrow + t * 8192 + (((2 * ks + hi) ^ x) << 4));
                acc[t] = __builtin_amdgcn_mfma_f32_32x32x16_bf16(wfr, bfr[ks], acc[t], 0, 0, 0);
            }
        bf16_t* stg = (bf16_t*)(lds + STG) + w * 2048;
#pragma unroll
        for (int t = 0; t < 2; ++t)
#pragma unroll
            for (int r = 0; r < 16; ++r) stg[(32 * t + attn::crow(r, hi)) * 32 + r32] = f2bf(acc[t][r]);
        asm volatile("s_waitcnt lgkmcnt(0)" ::: "memory");
#pragma unroll
        for (int i = 0; i < 4; ++i) { const int rr = i * 16 + (lane >> 2), c4 = lane & 3; const v4u vv = *(const v4u*)(stg + rr * 32 + c4 * 8);
            *(v4u*)(MIX + (size_t)(b * 4096 + s1p + 64 * rr) * 1024 + 32 * w + c4 * 8) = vv; }
        asm volatile("s_waitcnt lgkmcnt(0)" ::: "memory");
    }
    __syncthreads();
}

namespace hta {
using bf16x8 = __attribute__((ext_vector_type(8))) short;
using s16x4  = __attribute__((ext_vector_type(4))) short;
using f32x16 = __attribute__((ext_vector_type(16))) float;
using u32x4  = __attribute__((ext_vector_type(4))) unsigned;
constexpr int NW = 8, QBLK = 32, KVBLK = 64, NSLOT = 3, SLOTV = 8192;
constexpr float LOG2E = 1.4426950408889634f;
template <int MODE> struct Cfg;
template <> struct Cfg<0> { static constexpr int KD = 96; };
template <> struct Cfg<1> { static constexpr int KD = 64; };
template <int KD> struct Lds { static constexpr int SLOTK = KD * 128, K = 0, V = NSLOT * SLOTK, WS = V + NSLOT * SLOTV, OST = WS + NW * 64 * 4, BYTES = OST + NW * 4096; };
__device__ __forceinline__ int crow(int r, int hi) { return (r & 3) + 8 * (r >> 2) + 4 * hi; }
#define SBAR() __builtin_amdgcn_sched_barrier(0)
__device__ __forceinline__ void glds16(const void* gsrc, unsigned lds_dst) { unsigned keep;
  asm volatile("s_mov_b32 %0, m0\n\ts_mov_b32 m0, %2\n\ts_nop 0\n\tglobal_load_lds_dwordx4 %1, off\n\ts_mov_b32 m0, %0" : "=&s"(keep) : "v"(gsrc), "s"(lds_dst) : "memory"); }
__device__ __forceinline__ float max3f(float a, float b, float c) { float r; asm("v_max3_f32 %0, %1, %2, %3" : "=v"(r) : "v"(a), "v"(b), "v"(c)); return r; }
__device__ __forceinline__ float max2f(float a, float b) { float r; asm("v_max_f32_e32 %0, %1, %2" : "=v"(r) : "v"(a), "v"(b)); return r; }
__device__ __forceinline__ float fadd_s(float a, float b) { float r; asm("v_add_f32_e32 %0, %1, %2" : "=v"(r) : "v"(a), "v"(b)); return r; }
__device__ __forceinline__ float fsub_s(float a, float b) { float r; asm("v_sub_f32_e32 %0, %1, %2" : "=v"(r) : "v"(a), "v"(b)); return r; }
typedef float f32x2_t __attribute__((ext_vector_type(2))); typedef __bf16 bf16x2_t __attribute__((ext_vector_type(2)));
__device__ __forceinline__ unsigned cvtpk_s(float lo, float hi) { f32x2_t v = {lo, hi}; bf16x2_t b = __builtin_convertvector(v, bf16x2_t); return __builtin_bit_cast(unsigned, b); }
#define WAIT_BAR(N) asm volatile("s_waitcnt vmcnt(" #N ") lgkmcnt(0)\n\ts_barrier" ::: "memory")
typedef __attribute__((address_space(3))) const char* lds_cptr;
typedef short v4i16_t __attribute__((ext_vector_type(4)));
__device__ __forceinline__ void kload2(bf16x8* kf, lds_cptr kp, int j) { kf[2 * j] = *(const __attribute__((address_space(3))) bf16x8*)(kp + j * 2048); kf[2 * j + 1] = *(const __attribute__((address_space(3))) bf16x8*)(kp + j * 2048 + 512); }
__device__ __forceinline__ s16x4 vtr(lds_cptr p) { return __builtin_bit_cast(s16x4, __builtin_amdgcn_ds_read_tr16_b64_v4i16((__attribute__((address_space(3))) v4i16_t*)p)); }
__device__ __forceinline__ float rowmax(const f32x16& p0, const f32x16& p1) {
  float a = max3f(p0[0], p0[1], p1[0]), b = max3f(p0[2], p0[3], p1[1]); a = max3f(a, p1[2], p1[3]);
#pragma unroll
  for (int r = 4; r < 16; r += 4) { a = max3f(a, p0[r], p0[r + 1]); b = max3f(b, p0[r + 2], p0[r + 3]); a = max3f(a, p1[r], p1[r + 1]); b = max3f(b, p1[r + 2], p1[r + 3]); }
  const float m = max2f(a, b);
  auto rr = __builtin_amdgcn_permlane32_swap(__float_as_uint(m), __float_as_uint(m), false, false);
  return max2f(__uint_as_float(rr[0]), __uint_as_float(rr[1]));
}
__device__ __forceinline__ void pv(f32x16* o, int vb, bf16x8 pa0, bf16x8 pa1, bf16x8 pa2, bf16x8 pa3) {
#pragma unroll
  for (int d0 = 0; d0 < 2; ++d0) { s16x4 lo[4], hi[4];
#pragma unroll
    for (int ks = 0; ks < 4; ++ks) {
      asm volatile("ds_read_b64_tr_b16 %0,%1 offset:%c2" : "=&v"(lo[ks]) : "v"(vb), "i"(d0 * 4096 + ks * 1024) : "memory");
      asm volatile("ds_read_b64_tr_b16 %0,%1 offset:%c2" : "=&v"(hi[ks]) : "v"(vb), "i"(d0 * 4096 + ks * 1024 + 512) : "memory"); }
    asm volatile("s_waitcnt lgkmcnt(0)" ::: "memory"); SBAR();
#define PK(k) (bf16x8){lo[k][0], lo[k][1], lo[k][2], lo[k][3], hi[k][0], hi[k][1], hi[k][2], hi[k][3]}
    o[d0] = __builtin_amdgcn_mfma_f32_32x32x16_bf16(pa0, PK(0), o[d0], 0, 0, 0);
    o[d0] = __builtin_amdgcn_mfma_f32_32x32x16_bf16(pa1, PK(1), o[d0], 0, 0, 0);
    o[d0] = __builtin_amdgcn_mfma_f32_32x32x16_bf16(pa2, PK(2), o[d0], 0, 0, 0);
    o[d0] = __builtin_amdgcn_mfma_f32_32x32x16_bf16(pa3, PK(3), o[d0], 0, 0, 0);
#undef PK
  }
}
__device__ __forceinline__ void wmask(f32x16& p0, f32x16& p1, int kbase, int qpos, int hi) {
  const float NEG = -INFINITY;
#pragma unroll
  for (int r = 0; r < 16; ++r) { const int k0 = kbase + crow(r, hi) - qpos, k1 = k0 + 32;
    if (k0 > 128 || k0 < -128) p0[r] = NEG;
    if (k1 > 128 || k1 < -128) p1[r] = NEG; }
}

template <int MODE, int THRL>
__device__ __forceinline__ void unit(const P& p, int l, bool isctx, int b, int h, int q0, char* shm) {
  constexpr int KD = Cfg<MODE>::KD, NS = KD / 16, SLOTK = Lds<KD>::SLOTK, LDS_K = Lds<KD>::K, LDS_V = Lds<KD>::V, LDS_WS = Lds<KD>::WS, LDS_OST = Lds<KD>::OST;
  const int tid = tidx(), lane = tid & 63, r32 = lane & 31, hi = lane >> 5; const int wid = __builtin_amdgcn_readfirstlane(tid >> 6);
  const int qrow0 = isctx ? ML + b * 256 : b * 4096 + q0;
  const int qrow = qrow0 + wid * QBLK + r32, qpos = q0 + wid * QBLK + r32;
  const int kvh = h / 3;
  int kstart = 0, NT;
  if (MODE == 0) NT = isctx ? 4 : 68;
  else { if (isctx) NT = 4; else { kstart = max(0, q0 - 128); const int kend = min(S, q0 + 384); NT = 4 + (kend - kstart) / 64; } }
#define RB(t) (isctx ? ML + b * 256 + (t) * 64 : (MODE == 0 ? ((t) < 64 ? b * 4096 + (t) * 64 : ML + b * 256 + ((t) - 64) * 64) : ((t) < 4 ? ML + b * 256 + (t) * 64 : b * 4096 + kstart + ((t) - 4) * 64)))
  const unsigned lds0 = (unsigned)(uintptr_t)shm;
  float* wsf = (float*)(shm + LDS_WS) + wid * 64;
  const bf16_t* ksrc = (MODE == 0 ? ws_kn(p) + (size_t)(h * 8 + wid) * 512 : ws_ks(p) + (size_t)(kvh * 8 + wid) * 512) + lane * 8;
  const bf16_t* ksrc2 = ws_kr(p) + (size_t)(wid & 3) * 512 + lane * 8;
  const bf16_t* vsrc = (MODE == 0 ? ws_vm(p) + (size_t)(h * 2 + (wid >> 2)) * 2048 : ws_vs(p) + (size_t)(kvh * 2 + (wid >> 2)) * 2048) + (wid & 3) * 512 + lane * 8;
  constexpr int NH = MODE == 0 ? 6 : 2;
  const unsigned kdst = lds0 + LDS_K + wid * 1024, kdst2 = lds0 + LDS_K + (8 + (wid & 3)) * 1024, vdst = lds0 + LDS_V + wid * 1024;
#define KSL(x) (KD == 96 ? (x) + ((x) >> 1) : (x))
#define DMA_K(t, slot) do { const int tl_ = RB(t) >> 6; glds16(ksrc + (size_t)tl_ * (NH * 8 * 512), (unsigned)__builtin_amdgcn_readfirstlane(kdst + KSL(slot))); \
    if (MODE == 0) glds16(ksrc2 + (size_t)tl_ * (4 * 512), (unsigned)__builtin_amdgcn_readfirstlane(kdst2 + KSL(slot))); } while (0)
#define DMA_V(t, slot) glds16(vsrc + (size_t)(RB(t) >> 6) * (NH * 2 * 2048), (unsigned)__builtin_amdgcn_readfirstlane(vdst + (slot)))
  const int vb0 = (int)(lds0 + LDS_V) + ((lane >> 4) & 1) * 32 + (lane & 3) * 8 + (4 * hi + ((lane & 15) >> 2)) * 64;
  bf16x8 kf[2 * NS];
  const lds_cptr shm3 = (lds_cptr)shm; const lds_cptr kp0 = shm3 + LDS_K + hi * 1024 + r32 * 16; const lds_cptr vp0 = shm3 + LDS_V + ((lane >> 4) & 1) * 32 + (lane & 3) * 8 + (4 * hi + ((lane & 15) >> 2)) * 64;
  DMA_K(0, 0); DMA_V(0, 0); DMA_K(1, SLOTV);
  bf16x8 qr[NS];
  if (MODE == 0) {
    const bf16_t* Qw = ws_qm(p) + (size_t)qrow * QMW + hi * 8;
#pragma unroll
    for (int d0 = 0; d0 < 4; ++d0) qr[d0] = *reinterpret_cast<const bf16x8*>(Qw + h * 64 + d0 * 16);
#pragma unroll
    for (int d0 = 4; d0 < NS; ++d0) qr[d0] = *reinterpret_cast<const bf16x8*>(Qw + 384 + h * 32 + (d0 - 4) * 16);
  } else {
    const bf16_t* Qw = ws_qs(p) + (size_t)qrow * 384 + h * 64 + hi * 8;
#pragma unroll
    for (int d0 = 0; d0 < NS; ++d0) qr[d0] = *reinterpret_cast<const bf16x8*>(Qw + d0 * 16);
  }
  float mhat = 0.f, l_reg = 0.f; f32x16 o[2]; o[0] = f32x16{}; o[1] = f32x16{}; f32x16 negm = f32x16{}; asm volatile("" : "+v"(negm));
#define CMASK(P0, P1, t) do { if (MODE == 1 && !isctx && (t) >= 4) wmask(P0, P1, kstart + ((t) - 4) * 64, qpos, hi); } while (0)
  bool resc = false;
#define START(P0, P1) do { const float rm = rowmax(P0, P1); resc = false; \
    { const float dl = rm; mhat = fadd_s(mhat, dl); \
      _Pragma("unroll") for (int r = 0; r < 16; ++r) { P0[r] = fsub_s(P0[r], dl); P1[r] = fsub_s(P1[r], dl); } \
      _Pragma("unroll") for (int r = 0; r < 16; ++r) negm[r] = -mhat; asm volatile("" : "+v"(negm)); } \
    _Pragma("unroll") for (int r = 0; r < 16; ++r) P0[r] = __builtin_amdgcn_exp2f(P0[r]); } while (0)
#define RESC() do { if (resc) { asm volatile("s_waitcnt lgkmcnt(0)" ::: "memory"); \
      _Pragma("unroll") for (int d_ = 0; d_ < 2; ++d_) _Pragma("unroll") for (int r = 0; r < 16; ++r) o[d_][r] *= wsf[crow(r, hi)]; } } while (0)
  f32x16 pA0, pA1, pB0, pB1;
  int sl_prev = 0, sl_cur = 0, sl_next = SLOTV;
#define ROT() do { sl_prev = sl_cur; sl_cur = sl_next; sl_next = (sl_next == (NSLOT - 1) * SLOTV) ? 0 : sl_next + SLOTV; } while (0)
  DMA_K(2, 2 * SLOTV);
  WAIT_BAR(0);
  { const char* kb = shm + LDS_K + hi * 1024 + r32 * 16;
#pragma unroll
    for (int d0 = 0; d0 < NS; ++d0) {
      const bf16x8 b0 = *reinterpret_cast<const bf16x8*>(kb + d0 * 2048);
      const bf16x8 b1 = *reinterpret_cast<const bf16x8*>(kb + d0 * 2048 + 512);
      if (d0 == 0) { pA0 = __builtin_amdgcn_mfma_f32_32x32x16_bf16(b0, qr[0], negm, 0, 0, 0); pA1 = __builtin_amdgcn_mfma_f32_32x32x16_bf16(b1, qr[0], negm, 0, 0, 0); }
      else { pA0 = __builtin_amdgcn_mfma_f32_32x32x16_bf16(b0, qr[d0], pA0, 0, 0, 0); pA1 = __builtin_amdgcn_mfma_f32_32x32x16_bf16(b1, qr[d0], pA1, 0, 0, 0); } } }
  asm volatile("s_nop 15\n\ts_nop 7" : "+v"(pA0), "+v"(pA1)); CMASK(pA0, pA1, 0);
  START(pA0, pA1);
  _Pragma("unroll") for (int r = 0; r < 16; ++r) pA1[r] = __builtin_amdgcn_exp2f(pA1[r]);
  WAIT_BAR(0);
  DMA_K(3, 0); DMA_V(1, SLOTV);
  ROT();
#pragma unroll
  for (int j = 0; j < NS; ++j) kload2(kf, kp0 + KSL(sl_cur), j);
  if (MODE == 0) WAIT_BAR(3); else WAIT_BAR(2);
  s16x4 vlo[8], vhi[8]; u32x4 pw0, pw1, pw2, pw3;
#define PKW(P, B) cvtpk_s(P[B], P[B + 1])
#define PAF(k) __builtin_bit_cast(bf16x8, pw##k)
#define VFR(i) (bf16x8){vlo[i][0], vlo[i][1], vlo[i][2], vlo[i][3], vhi[i][0], vhi[i][1], vhi[i][2], vhi[i][3]}
#define PIN(x) asm volatile("" : "+v"(x))
#define MX3(a, b, c) __builtin_fmaxf(__builtin_fmaxf((a), (b)), (c))
#define PR(P, i) __builtin_shufflevector(P, P, i, (i) + 1)
#define GAPA(MF, PA, PB, W0, W1, PW) do { MF; s2 += PA; s2 += PB; PIN(s2); W0; W1; PIN(PW); SBAR(); } while (0)
#define GAPA1(MF, PA, W0, W1, PW) do { MF; s2 += PA; PIN(s2); W0; W1; PIN(PW); SBAR(); } while (0)
#define GAPA0(MF) do { MF; SBAR(); } while (0)
#define EX(v) __builtin_amdgcn_exp2f(v)
#define GAPB(MF, X, B) do { MF; X[B] = EX(X[B]); X[B + 1] = EX(X[B + 1]); X[B + 2] = EX(X[B + 2]); X[B + 3] = EX(X[B + 3]); PIN(X); SBAR(); } while (0)
#define VRD(i) do { vlo[i] = vtr(vp_ + (((i) >> 2) * 4096 + ((i) & 3) * 1024)); vhi[i] = vtr(vp_ + (((i) >> 2) * 4096 + ((i) & 3) * 1024 + 512)); } while (0)
#define KRD(G, j) do { if (G) { kload2(kf, kp0 + KSL(sl_next), j); SBAR(); } } while (0)
#define STEP(C0, C1, P0, P1, t, GK, GV, GL) do { SBAR(); \
    const lds_cptr vp_ = vp0 + sl_prev; \
    f32x2_t s2 = PR(P0, 0); \
    if constexpr (NS == 4) { VRD(0); SBAR(); \
    GAPA(C0 = __builtin_amdgcn_mfma_f32_32x32x16_bf16(kf[0], qr[0], negm, 0, 0, 0), PR(P0, 2), PR(P0, 4),     pw0[0] = PKW(P0, 0), pw0[1] = PKW(P0, 2), pw0); \
    VRD(4); SBAR(); GAPA(C1 = __builtin_amdgcn_mfma_f32_32x32x16_bf16(kf[1], qr[0], negm, 0, 0, 0), PR(P0, 6), PR(P0, 8),     pw0[2] = PKW(P0, 4), pw0[3] = PKW(P0, 6), pw0); \
    VRD(1); SBAR(); GAPA(C0 = __builtin_amdgcn_mfma_f32_32x32x16_bf16(kf[2], qr[1], C0, 0, 0, 0),   PR(P0, 10), PR(P0, 12), pw1[0] = PKW(P0, 8), pw1[1] = PKW(P0, 10), pw1); \
    VRD(5); SBAR(); GAPA(C1 = __builtin_amdgcn_mfma_f32_32x32x16_bf16(kf[3], qr[1], C1, 0, 0, 0),   PR(P0, 14), PR(P1, 0),   pw1[2] = PKW(P0, 12), pw1[3] = PKW(P0, 14), pw1); \
    VRD(2); SBAR(); GAPA(C0 = __builtin_amdgcn_mfma_f32_32x32x16_bf16(kf[4], qr[2], C0, 0, 0, 0),   PR(P1, 2), PR(P1, 4),     pw2[0] = PKW(P1, 0), pw2[1] = PKW(P1, 2), pw2); \
    VRD(6); SBAR(); GAPA(C1 = __builtin_amdgcn_mfma_f32_32x32x16_bf16(kf[5], qr[2], C1, 0, 0, 0),   PR(P1, 6), PR(P1, 8),     pw2[2] = PKW(P1, 4), pw2[3] = PKW(P1, 6), pw2); \
    VRD(3); SBAR(); GAPA(C0 = __builtin_amdgcn_mfma_f32_32x32x16_bf16(kf[6], qr[3], C0, 0, 0, 0),   PR(P1, 10), PR(P1, 12), pw3[0] = PKW(P1, 8), pw3[1] = PKW(P1, 10), pw3); \
    VRD(7); SBAR(); GAPA1(C1 = __builtin_amdgcn_mfma_f32_32x32x16_bf16(kf[7], qr[3], C1, 0, 0, 0),   PR(P1, 14),       pw3[2] = PKW(P1, 12), pw3[3] = PKW(P1, 14), pw3); \
    } else { \
    VRD(0); SBAR(); C0 = __builtin_amdgcn_mfma_f32_32x32x16_bf16(kf[0], qr[0], negm, 0, 0, 0); s2 += PR(P0, 2); PIN(s2); pw0[0] = PKW(P0, 0); pw0[1] = PKW(P0, 2); PIN(pw0); SBAR(); \
    VRD(4); SBAR(); C1 = __builtin_amdgcn_mfma_f32_32x32x16_bf16(kf[1], qr[0], negm, 0, 0, 0); s2 += PR(P0, 4); PIN(s2); pw0[2] = PKW(P0, 4); PIN(pw0); SBAR(); \
    C0 = __builtin_amdgcn_mfma_f32_32x32x16_bf16(kf[2], qr[1], C0, 0, 0, 0); s2 += PR(P0, 6); s2 += PR(P0, 8); PIN(s2); pw0[3] = PKW(P0, 6); PIN(pw0); SBAR(); \
    VRD(1); SBAR(); C1 = __builtin_amdgcn_mfma_f32_32x32x16_bf16(kf[3], qr[1], C1, 0, 0, 0); s2 += PR(P0, 10); PIN(s2); pw1[0] = PKW(P0, 8); pw1[1] = PKW(P0, 10); PIN(pw1); SBAR(); \
    VRD(5); SBAR(); C0 = __builtin_amdgcn_mfma_f32_32x32x16_bf16(kf[4], qr[2], C0, 0, 0, 0); s2 += PR(P0, 12); PIN(s2); pw1[2] = PKW(P0, 12); PIN(pw1); SBAR(); \
    C1 = __builtin_amdgcn_mfma_f32_32x32x16_bf16(kf[5], qr[2], C1, 0, 0, 0); s2 += PR(P0, 14); s2 += PR(P1, 0); PIN(s2); pw1[3] = PKW(P0, 14); PIN(pw1); SBAR(); \
    VRD(2); SBAR(); C0 = __builtin_amdgcn_mfma_f32_32x32x16_bf16(kf[6], qr[3], C0, 0, 0, 0); s2 += PR(P1, 2); PIN(s2); pw2[0] = PKW(P1, 0); pw2[1] = PKW(P1, 2); PIN(pw2); SBAR(); \
    VRD(6); SBAR(); C1 = __builtin_amdgcn_mfma_f32_32x32x16_bf16(kf[7], qr[3], C1, 0, 0, 0); s2 += PR(P1, 4); PIN(s2); pw2[2] = PKW(P1, 4); PIN(pw2); SBAR(); \
    C0 = __builtin_amdgcn_mfma_f32_32x32x16_bf16(kf[8], qr[4], C0, 0, 0, 0); s2 += PR(P1, 6); s2 += PR(P1, 8); PIN(s2); pw2[3] = PKW(P1, 6); PIN(pw2); SBAR(); \
    VRD(3); SBAR(); C1 = __builtin_amdgcn_mfma_f32_32x32x16_bf16(kf[9], qr[4], C1, 0, 0, 0); s2 += PR(P1, 10); PIN(s2); pw3[0] = PKW(P1, 8); pw3[1] = PKW(P1, 10); PIN(pw3); SBAR(); \
    VRD(7); SBAR(); C0 = __builtin_amdgcn_mfma_f32_32x32x16_bf16(kf[10], qr[5], C0, 0, 0, 0); s2 += PR(P1, 12); PIN(s2); pw3[2] = PKW(P1, 12); PIN(pw3); SBAR(); \
    C1 = __builtin_amdgcn_mfma_f32_32x32x16_bf16(kf[11], qr[5], C1, 0, 0, 0); s2 += PR(P1, 14); PIN(s2); pw3[3] = PKW(P1, 14); PIN(pw3); SBAR(); \
    } \
    l_reg += s2[0] + s2[1]; \
    if (GK) { DMA_K((t) + 3, sl_cur); } if (GV) { DMA_V((t) + 1, sl_next); } \
    CMASK(C0, C1, t); \
    { float a = MX3(C0[0], C0[1], C1[0]), b_ = MX3(C0[2], C0[3], C1[1]); a = MX3(a, C1[2], C1[3]); \
      _Pragma("unroll") for (int r = 4; r < 16; r += 4) { a = MX3(a, C0[r], C0[r + 1]); b_ = MX3(b_, C0[r + 2], C0[r + 3]); a = MX3(a, C1[r], C1[r + 1]); b_ = MX3(b_, C1[r + 2], C1[r + 3]); } \
      float rm = __builtin_fmaxf(a, b_); { auto rr = __builtin_amdgcn_permlane32_swap(__float_as_uint(rm), __float_as_uint(rm), false, false); rm = __builtin_fmaxf(__uint_as_float(rr[0]), __uint_as_float(rr[1])); } \
      resc = false; \
      if (__builtin_expect(__any(rm > (float)THRL), 0)) { const float dl = __builtin_fmaxf(rm, 0.f); mhat += dl; \
        _Pragma("unroll") for (int r = 0; r < 16; ++r) { C0[r] -= dl; C1[r] -= dl; } \
        _Pragma("unroll") for (int r = 0; r < 16; ++r) negm[r] = -mhat; asm volatile("" : "+v"(negm)); \
        const float f = __builtin_amdgcn_exp2f(-dl); l_reg *= f; if (hi == 0) wsf[r32] = f; resc = true; } } \
    SBAR(); \
    GAPB(o[0] = __builtin_amdgcn_mfma_f32_32x32x16_bf16(PAF(0), VFR(0), o[0], 0, 0, 0), C0, 0); \
    GAPB(o[1] = __builtin_amdgcn_mfma_f32_32x32x16_bf16(PAF(0), VFR(4), o[1], 0, 0, 0), C0, 4); \
    KRD(GL, 0); GAPB(o[0] = __builtin_amdgcn_mfma_f32_32x32x16_bf16(PAF(1), VFR(1), o[0], 0, 0, 0), C0, 8); \
    KRD(GL, 1); GAPB(o[1] = __builtin_amdgcn_mfma_f32_32x32x16_bf16(PAF(1), VFR(5), o[1], 0, 0, 0), C0, 12); \
    KRD(GL, 2); GAPB(o[0] = __builtin_amdgcn_mfma_f32_32x32x16_bf16(PAF(2), VFR(2), o[0], 0, 0, 0), C1, 0); \
    KRD(GL, 3); GAPB(o[1] = __builtin_amdgcn_mfma_f32_32x32x16_bf16(PAF(2), VFR(6), o[1], 0, 0, 0), C1, 4); \
    if constexpr (NS == 6) { KRD(GL, 4); } GAPB(o[0] = __builtin_amdgcn_mfma_f32_32x32x16_bf16(PAF(3), VFR(3), o[0], 0, 0, 0), C1, 8); \
    if constexpr (NS == 6) { KRD(GL, 5); } GAPB(o[1] = __builtin_amdgcn_mfma_f32_32x32x16_bf16(PAF(3), VFR(7), o[1], 0, 0, 0), C1, 12); \
    } while (0)
#define WB_FULL() do { if (MODE == 0) WAIT_BAR(3); else WAIT_BAR(2); } while (0)
  int t = 1;
  for (; t + 5 < NT; t += 2) {
    STEP(pB0, pB1, pA0, pA1, t, true, true, true);     WB_FULL(); RESC(); ROT();
    STEP(pA0, pA1, pB0, pB1, t + 1, true, true, true); WB_FULL(); RESC(); ROT();
  }
#define ENDW(tt) do { if ((tt) + 3 < NT) { WB_FULL(); } else if ((tt) + 2 < NT) { WAIT_BAR(1); } else { WAIT_BAR(0); } } while (0)
  for (; t + 1 < NT; t += 2) {
    STEP(pB0, pB1, pA0, pA1, t, (t + 3 < NT), (t + 1 < NT), (t + 1 < NT));       ENDW(t);     RESC(); ROT();
    STEP(pA0, pA1, pB0, pB1, t + 1, (t + 4 < NT), (t + 2 < NT), (t + 2 < NT));   ENDW(t + 1); RESC(); ROT();
  }
  STEP(pB0, pB1, pA0, pA1, NT - 1, false, false, false); RESC();
  { float sacc = pB0[0] + pB0[1]; _Pragma("unroll") for (int r = 2; r < 16; ++r) sacc += pB0[r]; _Pragma("unroll") for (int r = 0; r < 16; ++r) sacc += pB1[r]; l_reg += sacc;
    pw0 = (u32x4){PKW(pB0, 0), PKW(pB0, 2), PKW(pB0, 4), PKW(pB0, 6)}; pw1 = (u32x4){PKW(pB0, 8), PKW(pB0, 10), PKW(pB0, 12), PKW(pB0, 14)}; pw2 = (u32x4){PKW(pB1, 0), PKW(pB1, 2), PKW(pB1, 4), PKW(pB1, 6)}; pw3 = (u32x4){PKW(pB1, 8), PKW(pB1, 10), PKW(pB1, 12), PKW(pB1, 14)};
    SBAR(); pv(o, vb0 + sl_cur, PAF(0), PAF(1), PAF(2), PAF(3)); }
#undef PKW
#undef PAF
#undef VFR
#undef PIN
#undef MX3
#undef GAPA
#undef GAPA1
#undef PR
#undef GAPA0
#undef GAPB
#undef EX
#undef VRD
#undef KRD
#undef STEP
#undef ENDW
#undef WB_FULL
  { auto rr = __builtin_amdgcn_permlane32_swap(__float_as_uint(l_reg), __float_as_uint(l_reg), false, false); l_reg = __uint_as_float(rr[0]) + __uint_as_float(rr[1]); }
  if (MODE == 1) l_reg += __builtin_amdgcn_exp2f(p.sink[l * 6 + h] * LOG2E - mhat);
  if (hi == 0) wsf[32 + r32] = l_reg; asm volatile("s_waitcnt lgkmcnt(0)" ::: "memory");
  float rli[16];
#pragma unroll
  for (int r = 0; r < 16; ++r) rli[r] = __builtin_amdgcn_rcpf(wsf[32 + crow(r, hi)]);
  bf16_t* Ow = ws_mix(p) + (size_t)(qrow0 + wid * QBLK) * 1024 + (MODE == 0 ? 640 : 256) + h * 64;
  { bf16_t* stg = (bf16_t*)(shm + LDS_OST) + wid * 2048;
#pragma unroll
    for (int r = 0; r < 16; ++r) { const int orow = crow(r, hi);
#pragma unroll
      for (int d0 = 0; d0 < 2; ++d0) stg[orow * 64 + d0 * 32 + r32] = f2bf(o[d0][r] * rli[r]); }
    asm volatile("s_waitcnt lgkmcnt(0)" ::: "memory");
#pragma unroll
    for (int i = 0; i < 4; ++i) { const int row = i * 8 + (lane >> 3), ch = lane & 7; const u32x4 v = *(const u32x4*)(stg + row * 64 + ch * 8); *(u32x4*)(Ow + (size_t)row * 1024 + ch * 8) = v; } }
  asm volatile("s_waitcnt lgkmcnt(0)\n\ts_barrier" ::: "memory");
#undef DMA_K
#undef DMA_V
#undef KSL
#undef RB
#undef CMASK
#undef START
#undef RESC
#undef ROT
}
#undef SBAR
#undef WAIT_BAR
}

__device__ __forceinline__ void fp_attn(const P& p, int l, bool with_ctx, LAS unsigned char* lds, int bid, int nb) {
    const int n_lat = 8 * 6 * 16, n_ctx = with_ctx ? 8 * 6 : 0, per = n_lat + n_ctx;
    const int vcu = (nb % 8 == 0) ? (bid % 8) * (nb / 8) + bid / 8 : bid;
    for (int u = vcu; u < 2 * per; u += nb) {
        const int mode = u / per; int r = u % per;
        bool isctx = false; int b, h, q0;
        if (r < n_lat) { b = r / 96; const int r2 = r % 96; h = r2 / 16; q0 = (r2 % 16) * 256; }
        else { isctx = true; r -= n_lat; b = r / 6; h = r % 6; q0 = 0; }
        if (mode == 0) hta::unit<0, 8>(p, l, isctx, b, h, q0, (char*)lds);
        else hta::unit<1, 8>(p, l, isctx, b, h, q0, (char*)lds);
    }
}


__device__ __forceinline__ void fp_final(const P& p, int bid, int nb) {
    const int lane = tidx() & 63, gw = bid * 8 + (tidx() >> 6), nw = nb * 8;
    for (int row = gw; row < ML; row += nw) {
        const float pr = lane < 16 ? ws_rssh(p)[(size_t)row * 16 + lane] : 0.f;
        const float r = 1.0f / sqrtf(wave_sum(pr) * (1.0f / 1024.0f) + EPS);
        const v4u* x = (const v4u*)(ws_xn(p) + (size_t)row * 1024); f32x4* o = (f32x4*)(p.out + (size_t)row * D);
#pragma unroll
        for (int j = 0; j < 2; ++j) { const v4u w = x[lane + 64 * j];
            __builtin_nontemporal_store((f32x4){__uint_as_float(w.x << 16), __uint_as_float(w.x & 0xffff0000u), __uint_as_float(w.y << 16), __uint_as_float(w.y & 0xffff0000u)} * r, o + 2 * (lane + 64 * j));
            __builtin_nontemporal_store((f32x4){__uint_as_float(w.z << 16), __uint_as_float(w.z & 0xffff0000u), __uint_as_float(w.w << 16), __uint_as_float(w.w & 0xffff0000u)} * r, o + 2 * (lane + 64 * j) + 1); }
    }
}


struct CtxSplitOrder {
    int G, c;
    __device__ __forceinline__ bool next(int i, pg8::Unit& u) const { const int v = i * G + c; if (v >= 256) return false; const int t = v & 31, ks = v >> 5; u.pm = ML / 256 + (t >> 2); u.pn = t & 3; u.ko = ks * 512; return true; }
    __device__ __forceinline__ void a_ready(const pg8::Unit&) const {}
    __device__ __forceinline__ void done(const pg8::Unit&) const {}
};
struct EpiSlab {
    static constexpr bool PERM = true, AFTER_DRAIN = false;
    float* slab;
    __device__ __forceinline__ void operator()(const pg8::f32x4 (&acc)[2][2][4][2], const pg8::Unit& u, int wr, int wc, int fr, int fq) const {
        float* base = slab + (size_t)(u.ko >> 9) * MC * 1024 + u.pn * 256 + wc * 32 + 8 * fq;
#pragma unroll
        for (int ai = 0; ai < 2; ++ai)
#pragma unroll
            for (int m = 0; m < 4; ++m) {
                float* o = base + (size_t)(u.pm * 256 - ML + ai * 128 + wr * 64 + m * 16 + fr) * 1024;
#pragma unroll
                for (int bj = 0; bj < 2; ++bj) { *(pg8::f32x4*)(o + bj * 128) = acc[ai][bj][m][0]; *(pg8::f32x4*)(o + bj * 128 + 4) = acc[ai][bj][m][1]; }
            }
    }
};
__device__ __forceinline__ void fp_ctx_finalize(const P& p, int bid, int nb) {
    const int tid = tidx(), lane = tid & 63, gw = bid * 8 + (tid >> 6), NGW = nb * 8;
    const float* slab = (const float*)(p.ws + O_MIX);
    const float* gate = ws_mod(p) + (size_t)8 * 6144 + 5120; const float* gm = ws_gm(p, 1, 0) + 8 * 1024; const float* gmi = ws_gm(p, 0, 1) + 8 * 1024;
    for (int r = gw; r < MC; r += NGW) {
        bf16_t* xr = ws_xn(p) + (size_t)(ML + r) * 1024; float ss = 0.f;
#pragma unroll
        for (int j = 0; j < 4; ++j) {
            const int c = 4 * lane + 256 * j;
            f32x4 s = *(const f32x4*)(slab + (size_t)r * 1024 + c);
#pragma unroll
            for (int ks = 1; ks < 8; ++ks) s += *(const f32x4*)(slab + ((size_t)ks * MC + r) * 1024 + c);
            const v2u w_ = *(const v2u*)(xr + c); const f32x4 gi = *(const f32x4*)(gmi + c);
            const f32x4 ho = (f32x4){__uint_as_float(w_.x << 16) / gi.x, __uint_as_float(w_.x & 0xffff0000u) / gi.y, __uint_as_float(w_.y << 16) / gi.z, __uint_as_float(w_.y & 0xffff0000u) / gi.w};
            const f32x4 hn = ho + *(const f32x4*)(gate + c) * s;
            ss += (hn.x * hn.x + hn.y * hn.y) + (hn.z * hn.z + hn.w * hn.w);
            const f32x4 y = hn * *(const f32x4*)(gm + c);
            v2u w; w.x = pk2(y.x, y.y); w.y = pk2(y.z, y.w); *(v2u*)(xr + c) = w;
        }
        ss = wave_sum(ss);
        if (lane < 16) ws_rssh(p)[(size_t)(ML + r) * 16 + lane] = lane == 0 ? ss : 0.f;
    }
}
__device__ __forceinline__ void run_fast(const P& p_arg, int l, int ph, LAS unsigned char* lds, int bid, int nb) {
#if MEGA && defined(__HIP_DEVICE_COMPILE__)
    const __attribute__((address_space(4))) P* kp = (const __attribute__((address_space(4))) P*)__builtin_amdgcn_kernarg_segment_ptr();
    asm volatile("" : "+s"(kp));
    const P p = *kp;
#else
    const P& p = p_arg;
#endif
    const bool last = (l == DEPTH - 1);
    const int nrows = last ? ML : MT;
    switch (ph) {
        case 100: fp_mods(p, lds, bid, nb); fp_tables(p, bid, nb); fp_fftw(p, bid, nb); fp_weights(p, lds, bid, nb); break;
        case 112: fp_weights_in(p, lds, bid, nb); fp_gm(p, bid, nb); break;
        case 114: fp_bias(p, bid, nb); break;
        case 113: fp_final(p, bid, nb); break;
        case 110: fp_fft_a(p, !last, lds, bid, nb); break;
        case 111: fp_fft_b(p, lds, bid, nb); break;
        case 101: fp_xn(p, l, 0, MT, bid, nb); break;
        case 102: { pg8::Gemm g{ws_xn(p), ws_win_t(p, l), MT, NIN_PAD, 1024, 1024, 0}; pg8::StaticOrder S; S.init(MT, NIN_PAD, nb, bid);
                    EpiInproj E{ws_zf(p), ws_qs(p), ws_ks(p), ws_vs(p), ws_cq(p), ws_ckv(p), ws_kr(p), ws_rssq(p), ws_rsskv(p), ws_cosh(p), ws_sinh(p), ws_cosr(p), ws_sinr(p),
                                l == 0 ? nullptr : ws_rssh(p), ws_bias1(p)};
                    pg8::gemm_phase<EpiInproj, pg8::StaticOrder, true, true>(lds, g, S, E); } break;
        case 108: { pg8::Gemm g{ws_cq(p), ws_wuq_t(p, l), nrows, NUQ_PAD, 256, 256, 0}; pg8::StaticOrder S; S.init(nrows, NUQ_PAD, nb, bid);
                    EpiUpQ E{ws_qm(p), ws_rssq(p), ws_cosr(p), ws_sinr(p)}; pg8::gemm_phase<EpiUpQ, pg8::StaticOrder, true, true>(lds, g, S, E); } break;
        case 109: { pg8::Gemm g{ws_ckv(p), ws_wukv_t(p, l), MT, NUKV, 128, 128, 0}; pg8::StaticOrder S; S.init(MT, NUKV, nb, bid);
                    EpiUpKV E{ws_kn(p), ws_vm(p), ws_rsskv(p)}; pg8::gemm_phase<EpiUpKV, pg8::StaticOrder, true, true>(lds, g, S, E); } break;
        case 107: fp_attn(p, l, !last, lds, bid, nb); break;
        case 103: { pg8::Gemm g{ws_mix(p), ws_wout_t(p, l), nrows, 1024, 1024, 1024, 0}; pg8::StaticOrder S; S.init(nrows, 1024, nb, bid);
                    EpiResidA E{l == 0 ? p.x : nullptr, p.ctx, ws_gm(p, 1, 0), nullptr, ws_mod(p) + (size_t)(l * 9) * 6144 + 2048, ws_gm(p, l, 1), ws_xn(p), ws_rssh(p)};
                    pg8::gemm_phase<EpiResidA, pg8::StaticOrder, true, true>(lds, g, S, E); } break;
        case 104: fp_xn(p, l, 1, nrows, bid, nb); break;
        case 105: { pg8::Gemm g{ws_xn(p), ws_w1_t(p, l), nrows, DFF, 1024, 1024, 0}; pg8::StaticOrder S; S.init(nrows, DFF, nb, bid);
                    EpiMlp1 E{ws_hid(p), ws_rssh(p), ws_bias2(p, l)}; pg8::gemm_phase<EpiMlp1, pg8::StaticOrder, true, true>(lds, g, S, E); } break;
        case 106: { const int mrows = ML;
                    pg8::Gemm g{ws_hid(p), ws_w2_t(p, l), mrows, 1024, DFF, DFF, 1}; pg8::StaticOrder S; S.init(mrows, 1024, nb, bid);
                    EpiResidA E{nullptr, nullptr, ws_gm(p, l, 1), nullptr, ws_mod(p) + (size_t)(l * 9) * 6144 + 5120, last ? ws_gfin(p) : ws_gm(p, 1, 0), ws_xn(p), ws_rssh(p)};
                    pg8::gemm_phase<EpiResidA, pg8::StaticOrder, true, true>(lds, g, S, E); } break;
        case 117: { pg8::Gemm g{ws_hid(p), ws_w2_t(p, 0), MT, 1024, 512, DFF, 1}; CtxSplitOrder S{nb, bid};
                    EpiSlab E{(float*)(p.ws + O_MIX)}; pg8::gemm_phase<EpiSlab, CtxSplitOrder, true, true>(lds, g, S, E); } break;
        case 118: fp_ctx_finalize(p, bid, nb); break;
    }
}
typedef GAS unsigned gu32;
#define RLX_AGENT __ATOMIC_RELAXED, __HIP_MEMORY_SCOPE_AGENT
#define XB_TMO      128
#define XB_XCNT(j)  (256  + 64 * (j))
#define XB_XSUB(j)  (1280 + 64 * (j))
#define XB_XGEN(j)  (2304 + 64 * (j))
#define XB_TOP      3328
#define XB_TOPGEN   3392
#define XCD_BAR_WORDS 3456
#define XB_SPIN_CAP (1u << 18)

__device__ __forceinline__ unsigned xb_ld(unsigned* p)              { return __hip_atomic_load(p, __ATOMIC_RELAXED, __HIP_MEMORY_SCOPE_AGENT); }
__device__ __forceinline__ unsigned xb_add(unsigned* p, unsigned v) { return __hip_atomic_fetch_add(p, v, __ATOMIC_RELAXED, __HIP_MEMORY_SCOPE_AGENT); }
__device__ __forceinline__ unsigned xb_xcc_id() { return (unsigned)__builtin_amdgcn_s_getreg((3 << 11) | 20) & 0xFu; }
#define XB_SPIN(cond, bar) do { unsigned _sp = 0; while (cond) { __builtin_amdgcn_s_sleep(1); \
    if ((++_sp & 255u) == 0u) { if (xb_ld(&(bar)[XB_TMO])) break; if (_sp > XB_SPIN_CAP) { atomicAdd(&(bar)[XB_TMO], 1u); break; } } } } while (0)

struct XcdBarrier {
    unsigned* bar; unsigned x;
    volatile LAS unsigned* st;
};

__device__ __forceinline__ XcdBarrier xcd_barrier_post(unsigned* bar, volatile LAS unsigned* st) {
    XcdBarrier b; b.bar = bar; b.x = xb_xcc_id(); b.st = st;
    if (threadIdx.x == 0) (void)xb_add(&bar[XB_XCNT(b.x)], 1u);
    return b;
}
__device__ __forceinline__ void xcd_barrier_complete(unsigned* bar, unsigned x, unsigned& nloc, unsigned& nx) {
    const unsigned G = gridDim.x * gridDim.y * gridDim.z;
    unsigned sum, cnt, mine, sp = 0u;
    for (;;) {
        sum = 0u; cnt = 0u; mine = 0u;
#pragma unroll
        for (unsigned j = 0; j < 16; ++j) { const unsigned c = xb_ld(&bar[XB_XCNT(j)]); sum += c; cnt += (c > 0u) ? 1u : 0u; mine = (j == x) ? c : mine; }
        if (sum == G) break;
        __builtin_amdgcn_s_sleep(1);
        if ((++sp & 255u) == 0u) { if (xb_ld(&bar[XB_TMO])) break; if (sp > XB_SPIN_CAP) { atomicAdd(&bar[XB_TMO], 1u); break; } }
    }
    nloc = mine > 0u ? mine : 1u; nx = cnt > 0u ? cnt : 1u;
}

__device__ __forceinline__ void xcd_barrier(const XcdBarrier& b) {
    asm volatile("s_waitcnt vmcnt(0)" ::: "memory");
    __syncthreads();
    if (threadIdx.x == 0) {
        unsigned* bar = b.bar;
        __builtin_amdgcn_s_waitcnt(0);
        unsigned nloc = b.st[0], nx = b.st[1];
        if (nloc == 0u) { xcd_barrier_complete(bar, b.x, nloc, nx); b.st[0] = nloc; b.st[1] = nx; }
        const unsigned old = xb_add(&bar[XB_XSUB(b.x)], 1u);
        const unsigned gen = old / nloc;
        if (old + 1u == (gen + 1u) * nloc) {
            __builtin_amdgcn_fence(__ATOMIC_RELEASE, "agent");
            asm volatile("s_waitcnt vmcnt(0)" ::: "memory");
            const unsigned og = xb_add(&bar[XB_TOP], 1u);
            const unsigned tg = og / nx;
            if (og + 1u == (tg + 1u) * nx) xb_add(&bar[XB_TOPGEN], 1u);
            else XB_SPIN(xb_ld(&bar[XB_TOPGEN]) == tg, bar);
            __builtin_amdgcn_fence(__ATOMIC_ACQUIRE, "agent");
            xb_add(&bar[XB_XGEN(b.x)], 1u);
            asm volatile("s_waitcnt vmcnt(0)" ::: "memory");
        } else {
            XB_SPIN(xb_ld(&bar[XB_XGEN(b.x)]) == gen, bar);
            __builtin_amdgcn_fence(__ATOMIC_ACQUIRE, "agent");
            asm volatile("s_waitcnt vmcnt(0)" ::: "memory");
        }
    }
    __syncthreads();
}

#if MEGA
constexpr size_t O_CTL = 476 * MiB; constexpr size_t CTL_BYTES = 65536;
constexpr int LDS_MISC_OFF = 131072 + 320;
__device__ __forceinline__ void gsync(LAS unsigned char* lds) {
#if defined(__HIP_DEVICE_COMPILE__)
    const __attribute__((address_space(4))) P* kp = (const __attribute__((address_space(4))) P*)__builtin_amdgcn_kernarg_segment_ptr();
    asm volatile("" : "+s"(kp));
    XcdBarrier b; b.bar = (unsigned*)(kp->ws + O_CTL); b.x = xb_xcc_id(); b.st = (volatile LAS unsigned*)(lds + LDS_MISC_OFF) + 8;
    xcd_barrier(b);
#endif
}
__global__ void __launch_bounds__(FAST_THREADS, 2) mega_kernel(P p) {
    extern __shared__ __attribute__((aligned(16))) unsigned char lds_raw[];
    LAS unsigned char* lds = (LAS unsigned char*)lds_raw;
    cg::grid_group grid = cg::this_grid();
    const int bid = blockIdx.x, nb = gridDim.x;
    volatile LAS unsigned* MISC = (volatile LAS unsigned*)(lds + LDS_MISC_OFF);
    if (threadIdx.x < 32) MISC[threadIdx.x] = 0u;
    __syncthreads();
    (void)xcd_barrier_post((unsigned*)(p.ws + O_CTL), MISC + 8);
#define PH(l, ph) do { run_fast(p, l, ph, lds, bid, nb); if (PROBE_PH == (ph)) { gsync(lds); run_fast(p, l, ph, lds, bid, nb); } } while (0)
#define GSYNC() gsync(lds)
    if (nb == 0x7fffffff) grid.sync();
    PH(0, 100); GSYNC();
    PH(0, 112); PH(0, 101); GSYNC();
#pragma unroll 1
    for (int l = 0; l < DEPTH; ++l) {
        PH(l, 102); GSYNC();
        PH(l, 108); PH(l, 109); PH(l, 110); if (l == 0) PH(l, 114); GSYNC();
        PH(l, 107); PH(l, 111); GSYNC();
        PH(l, 103); GSYNC();
        PH(l, 105); GSYNC();
        PH(l, 106); if (l == 0) PH(l, 117); GSYNC();
        if (l == 0) { PH(l, 118); GSYNC(); }
    }
    PH(0, 113);
}
#else
template <int PH> __global__ void __launch_bounds__(FAST_THREADS, 2) k_fast(P p, int l) {
    extern __shared__ __attribute__((aligned(16))) unsigned char lds_raw[];
    run_fast(p, l, PH, (LAS unsigned char*)lds_raw, blockIdx.x, gridDim.x);
}
#endif

extern "C" void kernel_launch(void* const* d_in, const int* in_sizes, int n_in, void* d_out, int out_size, void* d_ws, size_t ws_size, hipStream_t stream) {
    if (n_in != 19 || ws_size < WS_NEED) { fprintf(stderr, "kernel_launch: unexpected n_in %d / ws_size %zu\n", n_in, ws_size); return; }
    P p{};
    p.x = (const float*)d_in[0]; p.c = (const float*)d_in[1]; p.ctx = (const float*)d_in[2]; p.c_ctx = (const float*)d_in[3];
    p.w_ada = (const float*)d_in[4]; p.b_ada = (const float*)d_in[5]; p.n1g = (const float*)d_in[6]; p.n2g = (const float*)d_in[7];
    p.w_in = (const float*)d_in[8]; p.w_f = (const float*)d_in[9]; p.sink = (const float*)d_in[10]; p.qn_g = (const float*)d_in[11];
    p.w_uq = (const float*)d_in[12]; p.kvn_g = (const float*)d_in[13]; p.w_ukv = (const float*)d_in[14]; p.w_out = (const float*)d_in[15];
    p.w_mlp1 = (const float*)d_in[16]; p.w_mlp2 = (const float*)d_in[17]; p.fin_g = (const float*)d_in[18];
    p.out = (float*)d_out; p.ws = (unsigned char*)d_ws;
#if MEGA
    static int grid_blocks = 0;
    if (!grid_blocks) {
        if (hipFuncSetAttribute((const void*)mega_kernel, hipFuncAttributeMaxDynamicSharedMemorySize, FAST_LDS) != hipSuccess) { fprintf(stderr, "hipFuncSetAttribute failed\n"); return; }
        int dev = 0, cus = 0, per_cu = 0;
        hipGetDevice(&dev);
        hipDeviceGetAttribute(&cus, hipDeviceAttributeMultiprocessorCount, dev);
        hipOccupancyMaxActiveBlocksPerMultiprocessor(&per_cu, mega_kernel, FAST_THREADS, FAST_LDS);
        if (per_cu < 1) { fprintf(stderr, "occupancy query says %d blocks per CU\n", per_cu); return; }
        grid_blocks = cus;
    }
    if (hipMemsetAsync((char*)d_ws + O_CTL, 0, CTL_BYTES, stream) != hipSuccess) { fprintf(stderr, "hipMemsetAsync failed\n"); return; }
    void* args[] = {&p};
    hipError_t e = hipLaunchCooperativeKernel((void*)mega_kernel, dim3(grid_blocks), dim3(FAST_THREADS), args, FAST_LDS, stream);
    if (e != hipSuccess) fprintf(stderr, "cooperative launch failed: %s (grid %d)\n", hipGetErrorString(e), grid_blocks);
#else
    static int init = 0;
    if (!init) {
#define SETA(PH) if (hipFuncSetAttribute((const void*)k_fast<PH>, hipFuncAttributeMaxDynamicSharedMemorySize, FAST_LDS) != hipSuccess) { fprintf(stderr, "hipFuncSetAttribute failed\n"); return; }
        SETA(100) SETA(101) SETA(102) SETA(103) SETA(104) SETA(105) SETA(106) SETA(107) SETA(108) SETA(109) SETA(110) SETA(111) SETA(112) SETA(113) SETA(114) SETA(117) SETA(118)
        init = 1; }
    const int GF = 256;
#define FAST(l, ph) k_fast<ph><<<GF, FAST_THREADS, FAST_LDS, stream>>>(p, l)
    FAST(0, 100); FAST(0, 112);
    for (int l = 0; l < DEPTH; ++l) {
        if (l == 0) FAST(l, 101); FAST(l, 102); FAST(l, 108); FAST(l, 109); FAST(l, 110); if (l == 0) FAST(l, 114); FAST(l, 107); FAST(l, 111);
        FAST(l, 103); FAST(l, 105); FAST(l, 106); if (l == 0) { FAST(l, 117); FAST(l, 118); }
    }
    FAST(0, 113);
#endif
}
```

```cpp
#include <hip/hip_runtime.h>
#include <hip/hip_cooperative_groups.h>
#include <stdint.h>
#include <stdio.h>
namespace cg = cooperative_groups;
#ifndef MEGA
#define MEGA 1
#endif
#ifndef PROBE_PH
#define PROBE_PH 0
#endif

typedef unsigned short bf16_t;
constexpr int D = 1024, NB = 8, S = 4096, L = 256, DEPTH = 2;
constexpr int ML = NB * S, MC = NB * L, MT = ML + MC;
constexpr int DIN = 1312, DFF = 4096;
constexpr int OFF_Q = 256, OFF_K = 640, OFF_V = 768, OFF_CQ = 896, OFF_CKV = 1152, OFF_KR = 1280;
constexpr int QMW = 576;
constexpr float EPS = 1e-6f;

constexpr size_t MiB = 1u << 20;
constexpr size_t O_MOD = 0, O_TAB = 1 * MiB, O_WF = 3 * MiB, O_HC = 5 * MiB, O_RSSQ = 13 * MiB, O_RSSKV = 14 * MiB + 512 * 1024, O_TW = 15 * MiB + 256 * 1024;
constexpr size_t O_ZF = 16 * MiB, O_YB = 50 * MiB, O_QS = 82 * MiB, O_KS = 108 * MiB, O_VS = 117 * MiB, O_CQ = 126 * MiB, O_CKV = 143 * MiB, O_KR = 152 * MiB,
                 O_QM = 155 * MiB, O_KN = 194 * MiB, O_VM = 220 * MiB, O_HID = 16 * MiB;
constexpr size_t O_WIN_T = 290 * MiB, O_WOUT_T = 297 * MiB, O_W1_T = 301 * MiB, O_W2_T = 317 * MiB, O_WUQ_T = 333 * MiB, O_WUKV_T = 334 * MiB, O_FFTW = 335 * MiB,
                 O_XN = 336 * MiB, O_MIX = 404 * MiB, O_RSSH = 472 * MiB;
constexpr size_t WS_NEED = 477 * MiB;

struct P {
    const float *x, *c, *ctx, *c_ctx, *w_ada, *b_ada, *n1g, *n2g, *w_in, *w_f, *sink, *qn_g, *w_uq, *kvn_g, *w_ukv, *w_out, *w_mlp1, *w_mlp2, *fin_g;
    float* out;
    unsigned char* ws;
};

__device__ __forceinline__ int tidx() { int t = threadIdx.x; asm volatile("" : "+v"(t)); return t; }
__device__ __forceinline__ float shfl_xor_f(float v, int mask) {
    const int lane = tidx() & 63; return __int_as_float(__builtin_amdgcn_ds_bpermute((lane ^ mask) << 2, __float_as_int(v)));
}
__device__ __forceinline__ float bf2f(bf16_t v) { return __uint_as_float(((unsigned)v) << 16); }
__device__ __forceinline__ bf16_t f2bf(float f) { unsigned u = __float_as_uint(f); u += 0x7fffu + ((u >> 16) & 1u); return (bf16_t)(u >> 16); }

__device__ __forceinline__ float* ws_mod(const P& p) { return (float*)(p.ws + O_MOD); }
__device__ __forceinline__ float* ws_cosT(const P& p) { return (float*)(p.ws + O_TAB); }
__device__ __forceinline__ float* ws_sinT(const P& p) { return (float*)(p.ws + O_TAB) + 4096; }
__device__ __forceinline__ float* ws_cosh(const P& p) { return (float*)(p.ws + O_TAB) + 8192; }
__device__ __forceinline__ float* ws_sinh(const P& p) { return ws_cosh(p) + 4096 * 32; }
__device__ __forceinline__ float* ws_cosr(const P& p) { return ws_sinh(p) + 4096 * 32; }
__device__ __forceinline__ float* ws_sinr(const P& p) { return ws_cosr(p) + 4096 * 16; }
__device__ __forceinline__ float* ws_wc(const P& p) { return (float*)(p.ws + O_WF); }
__device__ __forceinline__ float* ws_wsn(const P& p) { return (float*)(p.ws + O_WF) + 2 * 4 * 64 * 64; }
__device__ __forceinline__ float* ws_hc(const P& p) { return (float*)(p.ws + O_HC); }
__device__ __forceinline__ float* ws_rssq(const P& p) { return (float*)(p.ws + O_RSSQ); }
__device__ __forceinline__ float* ws_rsskv(const P& p) { return (float*)(p.ws + O_RSSKV); }
__device__ __forceinline__ float* ws_rssh(const P& p) { return (float*)(p.ws + O_RSSH); }
__device__ __forceinline__ float* ws_gm(const P& p, int l, int which) { return (float*)(p.ws + 475 * MiB) + (size_t)(l * 2 + which) * 9 * 1024; }
__device__ __forceinline__ float* ws_bias2(const P& p, int l) { return (float*)(p.ws + 475 * MiB + 256 * 1024) + (size_t)l * 9 * 4096; }
__device__ __forceinline__ float* ws_bias1(const P& p) { return (float*)(p.ws + 475 * MiB + 768 * 1024); }
__device__ __forceinline__ float* ws_gfin(const P& p) { return (float*)(p.ws + 475 * MiB + 896 * 1024); }
__device__ __forceinline__ bf16_t* ws_zf(const P& p) { return (bf16_t*)(p.ws + O_ZF); }
__device__ __forceinline__ bf16_t* ws_yb(const P& p) { return (bf16_t*)(p.ws + O_YB); }
__device__ __forceinline__ bf16_t* ws_qs(const P& p) { return (bf16_t*)(p.ws + O_QS); }
__device__ __forceinline__ bf16_t* ws_ks(const P& p) { return (bf16_t*)(p.ws + O_KS); }
__device__ __forceinline__ bf16_t* ws_vs(const P& p) { return (bf16_t*)(p.ws + O_VS); }
__device__ __forceinline__ bf16_t* ws_cq(const P& p) { return (bf16_t*)(p.ws + O_CQ); }
__device__ __forceinline__ bf16_t* ws_ckv(const P& p) { return (bf16_t*)(p.ws + O_CKV); }
__device__ __forceinline__ bf16_t* ws_kr(const P& p) { return (bf16_t*)(p.ws + O_KR); }
__device__ __forceinline__ bf16_t* ws_qm(const P& p) { return (bf16_t*)(p.ws + O_QM); }
__device__ __forceinline__ bf16_t* ws_kn(const P& p) { return (bf16_t*)(p.ws + O_KN); }
__device__ __forceinline__ bf16_t* ws_vm(const P& p) { return (bf16_t*)(p.ws + O_VM); }
__device__ __forceinline__ bf16_t* ws_mix(const P& p) { return (bf16_t*)(p.ws + O_MIX); }
__device__ __forceinline__ bf16_t* ws_hid(const P& p) { return (bf16_t*)(p.ws + O_HID); }

__device__ __forceinline__ int modrow(int row) { return row < ML ? (row >> 12) : 8; }
__device__ __forceinline__ const float* hrow_in(const P& p, int l, int row) {
    if (row < ML) return (l == 0 ? p.x : p.out) + (size_t)row * D;
    return (l == 0 ? p.ctx : ws_hc(p)) + (size_t)(row - ML) * D;
}
__device__ __forceinline__ float* hrow_mid(const P& p, int row) {
    if (row < ML) return p.out + (size_t)row * D;
    return ws_hc(p) + (size_t)(row - ML) * D;
}
__device__ __forceinline__ float wave_sum(float v) {
#pragma unroll
    for (int o = 1; o < 64; o <<= 1) v += shfl_xor_f(v, o);
    return v;
}

#define GAS __attribute__((address_space(1)))
#define LAS __attribute__((address_space(3)))
typedef unsigned v4u __attribute__((ext_vector_type(4)));
typedef unsigned v2u __attribute__((ext_vector_type(2)));
typedef float f32x4 __attribute__((ext_vector_type(4)));
typedef float v2u_f __attribute__((ext_vector_type(2)));
#define LDS_WAIT() asm volatile("s_waitcnt lgkmcnt(0)" ::: "memory")
__device__ __forceinline__ unsigned pk2(float lo, float hi) { return (unsigned)f2bf(lo) | ((unsigned)f2bf(hi) << 16); }

constexpr int FAST_THREADS = 512, FAST_LDS = 147456;
constexpr int NIN_PAD = 1792, NUQ_PAD = 768, NUKV = 768;
__device__ __forceinline__ bf16_t* ws_win_t(const P& p, int l) { return (bf16_t*)(p.ws + O_WIN_T) + (size_t)l * NIN_PAD * 1024; }
__device__ __forceinline__ bf16_t* ws_wout_t(const P& p, int l) { return (bf16_t*)(p.ws + O_WOUT_T) + (size_t)l * 1024 * 1024; }
__device__ __forceinline__ bf16_t* ws_w1_t(const P& p, int l) { return (bf16_t*)(p.ws + O_W1_T) + (size_t)l * 4096 * 1024; }
__device__ __forceinline__ bf16_t* ws_w2_t(const P& p, int l) { return (bf16_t*)(p.ws + O_W2_T) + (size_t)l * 1024 * 4096; }
__device__ __forceinline__ bf16_t* ws_wuq_t(const P& p, int l) { return (bf16_t*)(p.ws + O_WUQ_T) + (size_t)l * NUQ_PAD * 256; }
__device__ __forceinline__ bf16_t* ws_wukv_t(const P& p, int l) { return (bf16_t*)(p.ws + O_WUKV_T) + (size_t)l * NUKV * 128; }
__device__ __forceinline__ bf16_t* ws_xn(const P& p) { return (bf16_t*)(p.ws + O_XN); }

namespace pg8 {
#define PG8_LAS __attribute__((address_space(3)))
typedef unsigned short bf16_t;
typedef short bf16x8 __attribute__((ext_vector_type(8)));
typedef float f32x4 __attribute__((ext_vector_type(4)));
typedef unsigned u32x4 __attribute__((ext_vector_type(4)));
constexpr int BM = 256, BK = 64, HALF = 128, HTB = HALF * BK * 2  , STAGE_BYTES = 8 * HTB, NXCD = 8, WGM = 8;

__host__ __device__ __forceinline__ int lds_byte(int r, int c) { const int st = (r >> 4) * 2 + (c >> 5), rr = r & 15, cc = c & 31, ob = rr * 64 + cc * 2; return st * 1024 + (ob ^ (((ob >> 9) & 1) << 5)); }
__host__ __device__ __forceinline__ void stage_rc(int b, int& R, int& C) { const int st = b / 1024, sb = b % 1024, swz = sb ^ (((sb >> 9) & 1) << 5); R = (st >> 1) * 16 + swz / 64; C = (st & 1) * 32 + (swz % 64) / 2; }
__host__ __device__ __forceinline__ int perm32(int rho) { const int n = rho >> 4, i = rho & 15; return 8 * (i >> 2) + 4 * n + (i & 3); }

struct Unit { int pm, pn, ko; };
struct Gemm { const bf16_t* A; const bf16_t* Bt; int M, N, K, ld; int ablk = 0; };

struct StaticOrder {
    int nM, nN, nwg, G, c;
    __host__ __device__ void init(int M, int N, int G_, int c_) { nM = M / BM; nN = N / BM; nwg = nM * nN; G = G_; c = c_; }
    __host__ __device__ bool next(int i, Unit& u) const {
        const long L = (long)i * G + c; if (L >= nwg) return false;
        int wgid = (int)L; { const int q = nwg / NXCD, r = nwg % NXCD, xcd = wgid % NXCD, off = wgid / NXCD; wgid = (xcd < r ? xcd * (q + 1) : r * (q + 1) + (xcd - r) * q) + off; }
        const int nig = WGM * nN, gid = wgid / nig, fm = gid * WGM, gsz = (nM - fm) < WGM ? (nM - fm) : WGM;
        u.pm = fm + ((wgid % nig) % gsz); u.pn = (wgid % nig) / gsz; u.ko = 0; return true;
    }
    __device__ __forceinline__ void a_ready(const Unit&) const {}
    __device__ __forceinline__ void done(const Unit&) const {}
};

__device__ __forceinline__ unsigned cvt_pk_bf16(float lo, float hi) { unsigned r; asm volatile("v_cvt_pk_bf16_f32 %0, %1, %2" : "=v"(r) : "v"(lo), "v"(hi)); return r; }
typedef float f32x2 __attribute__((ext_vector_type(2)));
__device__ __forceinline__ void glds_piece(const char* sbase, unsigned voff, unsigned lds_dst) {
    unsigned keep;
    asm volatile("s_mov_b32 %0, m0\n\ts_mov_b32 m0, %3\n\ts_nop 0\n\tglobal_load_lds_dwordx4 %1, %2\n\ts_mov_b32 m0, %0" : "=&s"(keep) : "v"(voff), "s"(sbase), "s"(lds_dst) : "memory");
}
template <class Epi, class Sched, bool ALIGN_EPI = false, bool SP2 = false>
__device__ __forceinline__ void gemm_phase(PG8_LAS unsigned char* lds, const Gemm g, const Sched& S, const Epi& E) {
    const int tid = tidx(), wid = __builtin_amdgcn_readfirstlane(tid >> 6), lane = tid & 63, wr = wid >> 2, wc = wid & 3, fr = lane & 15, fq = lane >> 4;
    const int K = g.K, nt = K / BK;
    unsigned voffA[2], voffB[2];
#pragma unroll
    for (int i = 0; i < 2; ++i) { int R, C; stage_rc(tid * 16 + i * 8192, R, C); const int Rb = Epi::PERM ? ((R & ~31) + perm32(R & 31)) : R;
        voffA[i] = g.ablk ? (unsigned)(((R >> 4) * (g.ld >> 5) + (C >> 5)) * 512 + (R & 15) * 32 + (C & 31)) * 2u : (unsigned)(R * g.ld + C) * 2u; voffB[i] = (unsigned)(Rb * g.ld + C) * 2u; }
    const size_t kstep = (size_t)(BK * 2);
    const size_t kstepA = g.ablk ? (size_t)2048 : kstep;
    const size_t hstep = (size_t)HALF * g.ld * 2;
    const size_t tstep = 2 * hstep;
    const unsigned ldsbase = (unsigned)(uintptr_t)lds;
    const unsigned ldsw = (unsigned)wid * 1024u;
    const int aoff = lds_byte(wr * 64 + fr, fq * 8), boff = lds_byte(wc * 32 + fr, fq * 8);
#define PG8_SA(b, h) (((b) * 2 + (h)) * HTB)
#define PG8_SB(b, h) ((4 + (b) * 2 + (h)) * HTB)
#define PG8_STAGE(bufoff, gbase, voff) do { _Pragma("unroll") for (int _i = 0; _i < 2; ++_i) \
        glds_piece((const char*)(gbase), (voff)[_i], (unsigned)__builtin_amdgcn_readfirstlane((int)(ldsbase + (bufoff) + ldsw + _i * 8192))); } while (0)
#define PG8_LDA(dst, b, h) do { _Pragma("unroll") for (int m = 0; m < 4; ++m) _Pragma("unroll") for (int k = 0; k < 2; ++k) dst[m][k] = *(const PG8_LAS bf16x8*)(lds + PG8_SA(b, h) + aoff + m * 2048 + k * 1024); } while (0)
#define PG8_LDB(dst, b, h) do { _Pragma("unroll") for (int n = 0; n < 2; ++n) _Pragma("unroll") for (int k = 0; k < 2; ++k) dst[n][k] = *(const PG8_LAS bf16x8*)(lds + PG8_SB(b, h) + boff + n * 2048 + k * 1024); } while (0)
#define PG8_MMA(ai, bj, At, Bt) do { __builtin_amdgcn_s_setprio(1); _Pragma("unroll") for (int k = 0; k < 2; ++k) _Pragma("unroll") for (int m = 0; m < 4; ++m) _Pragma("unroll") for (int n = 0; n < 2; ++n)   \
        acc[ai][bj][m][n] = __builtin_amdgcn_mfma_f32_16x16x32_bf16(Bt[n][k], At[m][k], acc[ai][bj][m][n], 0, 0, 0); __builtin_amdgcn_s_setprio(0); } while (0)
#define PG8_WAIT_V(n) asm volatile("s_waitcnt vmcnt(" #n ")" ::: "memory")
#define PG8_WAIT_L(n) asm volatile("s_waitcnt lgkmcnt(" #n ")" ::: "memory")
#define PG8_BAR __builtin_amdgcn_s_barrier()
#define PG8_SCHED __builtin_amdgcn_sched_barrier(0)
    Unit cur, nxt; int ui = 0;
    if (!S.next(0, cur)) return;
    f32x4 acc[2][2][4][2];
#pragma unroll
    for (int a = 0; a < 2; ++a)
#pragma unroll
        for (int b = 0; b < 2; ++b)
#pragma unroll
            for (int m = 0; m < 4; ++m)
#pragma unroll
                for (int n = 0; n < 2; ++n) acc[a][b][m][n] = (f32x4){0.f, 0.f, 0.f, 0.f};
    bf16x8 At[4][2], B0[2][2], B1[2][2];
    const char* cA = (const char*)g.A + (size_t)cur.pm * tstep + (size_t)cur.ko * (g.ablk ? 32 : 2); const char* cB = (const char*)g.Bt + (size_t)cur.pn * tstep + (size_t)cur.ko * 2;
    S.a_ready(cur);
    if constexpr (SP2) {
        PG8_STAGE(PG8_SB(0, 0), cB, voffB); PG8_STAGE(PG8_SB(0, 1), cB + hstep, voffB); PG8_STAGE(PG8_SA(0, 0), cA, voffA); PG8_STAGE(PG8_SA(0, 1), cA + hstep, voffA);
        if (wr == 1) PG8_BAR;
        PG8_WAIT_V(2); PG8_BAR;
        PG8_STAGE(PG8_SB(1, 0), cB + kstep, voffB); PG8_STAGE(PG8_SA(1, 0), cA + kstepA, voffA); PG8_STAGE(PG8_SB(1, 1), cB + hstep + kstep, voffB);
        PG8_WAIT_V(6); PG8_BAR;
    } else {
        PG8_STAGE(PG8_SB(0, 0), cB, voffB); PG8_STAGE(PG8_SA(0, 0), cA, voffA); PG8_STAGE(PG8_SB(0, 1), cB + hstep, voffB); PG8_STAGE(PG8_SA(0, 1), cA + hstep, voffA);
        if (wr == 1) PG8_BAR;
        PG8_WAIT_V(4); PG8_BAR;
        PG8_STAGE(PG8_SB(1, 0), cB + kstep, voffB); PG8_STAGE(PG8_SA(1, 0), cA + kstepA, voffA); PG8_STAGE(PG8_SB(1, 1), cB + hstep + kstep, voffB);
        PG8_WAIT_V(6); PG8_BAR;
    }
    for (;;) {
        const bool has_next = S.next(ui + 1, nxt);
        const char* nA = has_next ? (const char*)g.A + (size_t)nxt.pm * tstep + (size_t)nxt.ko * (g.ablk ? 32 : 2) : cA; const char* nB = has_next ? (const char*)g.Bt + (size_t)nxt.pn * tstep + (size_t)nxt.ko * 2 : cB;
        for (int t = 0; t < nt; t += 2) {
            const bool last = (t == nt - 2);
            const char* a1 = cA + (size_t)(t + 1) * kstepA;
            const char* a2 = last ? nA : cA + (size_t)(t + 2) * kstepA; const char* b2 = last ? nB : cB + (size_t)(t + 2) * kstep;
            const char* a3 = a2 + kstepA; const char* b3 = b2 + kstep;
            if (last && has_next) S.a_ready(nxt);
            if constexpr (SP2) {
            PG8_LDB(B0, 0, 0); PG8_LDB(B1, 0, 1); PG8_SCHED; PG8_LDA(At, 0, 0); PG8_STAGE(PG8_SA(1, 1), a1 + hstep, voffA);
            PG8_WAIT_V(8); PG8_WAIT_L(0); PG8_BAR; PG8_MMA(0, 0, At, B0); PG8_MMA(0, 1, At, B1); PG8_BAR; PG8_SCHED;
            PG8_LDA(At, 0, 1); PG8_STAGE(PG8_SB(0, 0), b2, voffB); PG8_STAGE(PG8_SB(0, 1), b2 + hstep, voffB); PG8_STAGE(PG8_SA(0, 0), a2, voffA);
            PG8_WAIT_V(8); PG8_WAIT_L(0); PG8_BAR; PG8_MMA(1, 0, At, B0); PG8_MMA(1, 1, At, B1); PG8_BAR; PG8_SCHED;
            PG8_LDB(B0, 1, 0); PG8_LDB(B1, 1, 1); PG8_SCHED; PG8_LDA(At, 1, 0); PG8_STAGE(PG8_SA(0, 1), a2 + hstep, voffA);
            PG8_WAIT_V(8); PG8_WAIT_L(0); PG8_BAR; PG8_MMA(0, 0, At, B0); PG8_MMA(0, 1, At, B1); PG8_BAR; PG8_SCHED;
            PG8_LDA(At, 1, 1); PG8_STAGE(PG8_SB(1, 0), b3, voffB); PG8_STAGE(PG8_SB(1, 1), b3 + hstep, voffB); PG8_STAGE(PG8_SA(1, 0), a3, voffA);
            PG8_WAIT_V(8); PG8_WAIT_L(0); PG8_BAR; PG8_MMA(1, 0, At, B0); PG8_MMA(1, 1, At, B1); PG8_BAR; PG8_SCHED;
            } else {
            PG8_LDB(B0, 0, 0); PG8_SCHED; PG8_LDA(At, 0, 0); PG8_STAGE(PG8_SA(1, 1), a1 + hstep, voffA);
            PG8_WAIT_L(8); PG8_BAR; PG8_WAIT_L(0); PG8_MMA(0, 0, At, B0); PG8_BAR; PG8_SCHED;
            PG8_LDB(B1, 0, 1); PG8_STAGE(PG8_SB(0, 0), b2, voffB);
            PG8_BAR; PG8_WAIT_L(0); PG8_MMA(0, 1, At, B1); PG8_BAR;
            PG8_LDA(At, 0, 1); PG8_STAGE(PG8_SA(0, 0), a2, voffA);
            PG8_BAR; PG8_WAIT_L(0); PG8_MMA(1, 0, At, B0); PG8_BAR; PG8_SCHED;
            PG8_STAGE(PG8_SB(0, 1), b2 + hstep, voffB);
            PG8_WAIT_V(6); PG8_BAR; PG8_MMA(1, 1, At, B1); PG8_BAR;
            PG8_LDB(B0, 1, 0); PG8_SCHED; PG8_LDA(At, 1, 0); PG8_STAGE(PG8_SA(0, 1), a2 + hstep, voffA);
            PG8_WAIT_L(8); PG8_BAR; PG8_WAIT_L(0); PG8_MMA(0, 0, At, B0); PG8_BAR; PG8_SCHED;
            PG8_LDB(B1, 1, 1); PG8_STAGE(PG8_SB(1, 0), b3, voffB);
            PG8_BAR; PG8_WAIT_L(0); PG8_MMA(0, 1, At, B1); PG8_BAR;
            PG8_LDA(At, 1, 1); PG8_STAGE(PG8_SA(1, 0), a3, voffA);
            PG8_BAR; PG8_WAIT_L(0); PG8_MMA(1, 0, At, B0); PG8_BAR; PG8_SCHED;
            PG8_STAGE(PG8_SB(1, 1), b3 + hstep, voffB);
            PG8_WAIT_V(6); PG8_BAR; PG8_MMA(1, 1, At, B1); PG8_BAR;
            }
        }
        if constexpr (ALIGN_EPI) { if (wr == 0) PG8_BAR; }
        if constexpr (!Epi::AFTER_DRAIN) { const int t2_ = tidx(); const int fr_ = t2_ & 15, fq_ = (t2_ & 63) >> 4;
                                           E(acc, cur, wr, wc, fr_, fq_); S.done(cur);
                                           if constexpr (Epi::DRAIN_AFTER) __builtin_amdgcn_s_waitcnt(0x0F70); else __builtin_amdgcn_s_waitcnt(0x0F78); }
        if (!has_next) break;
#pragma unroll
        for (int a = 0; a < 2; ++a)
#pragma unroll
            for (int b = 0; b < 2; ++b)
#pragma unroll
                for (int m = 0; m < 4; ++m)
#pragma unroll
                    for (int n = 0; n < 2; ++n) acc[a][b][m][n] = (f32x4){0.f, 0.f, 0.f, 0.f};
        cur = nxt; cA = nA; cB = nB; ++ui;
        if constexpr (ALIGN_EPI) { if (wr == 1) PG8_BAR; }
    }
    PG8_WAIT_V(0);
    if constexpr (!ALIGN_EPI) { if (wr == 0) PG8_BAR; }
    PG8_BAR;
    if constexpr (Epi::AFTER_DRAIN) { E.fused(acc, cur, wr, wc, fr, fq, lds, wid, lane); S.done(cur); }
#undef PG8_SA
#undef PG8_SB
#undef PG8_STAGE
#undef PG8_LDA
#undef PG8_LDB
#undef PG8_MMA
#undef PG8_WAIT_V
#undef PG8_WAIT_L
#undef PG8_BAR
#undef PG8_SCHED
}
}

template <class F>
__device__ __forceinline__ void tr_item(F fn, int K, bf16_t* WT, LAS float* scr, int kb, int nbk, int lane) {
    asm volatile("" : "+v"(lane));
    const int k0 = 64 * kb, n0 = 32 * nbk;
#pragma unroll 4
    for (int i = 0; i < 32; ++i) { const int kk = 2 * i + (lane >> 5); scr[kk * 33 + (lane & 31)] = fn(k0 + kk, n0 + (lane & 31)); }
    LDS_WAIT(); asm volatile("" ::: "memory");
    const int c = lane & 7;
#pragma unroll
    for (int j = 0; j < 4; ++j) { const int n = (lane >> 3) + 8 * j; const LAS float* s = scr + (8 * c) * 33 + n;
        v4u o; o.x = pk2(s[0 * 33], s[1 * 33]); o.y = pk2(s[2 * 33], s[3 * 33]); o.z = pk2(s[4 * 33], s[5 * 33]); o.w = pk2(s[6 * 33], s[7 * 33]);
        *(GAS v4u*)(WT + (size_t)(n0 + n) * K + k0 + 8 * c) = o; }
    LDS_WAIT(); asm volatile("" ::: "memory");
}
__device__ __forceinline__ float win_src(const P& p, int l, int k, int n) {
    const float* w = p.w_in + ((size_t)l * 1024 + k) * DIN;
    if (n < 512) { const int part = n >> 8, g = (n >> 6) & 3, d = n & 63;
        const float* wf = (part ? ws_wsn(p) : ws_wc(p)) + (size_t)(l * 4 + g) * 4096 + d; float a = 0.f;
        for (int c = 0; c < 64; ++c) a += w[g * 64 + c] * wf[c * 64];
        return a; }
    if (n < 1024) { const int pp = n - 512, H = pp >> 6, pos = pp & 63, d = 32 * ((pos >> 2) & 1) + 16 * (pos >> 5) + 4 * ((pos >> 3) & 3) + (pos & 3); return w[OFF_Q + H * 64 + d]; }
    if (n < 1280) { const int pp = n - 1024; return pp < 128 ? w[OFF_V + pp] : w[OFF_CKV + pp - 128]; }
    if (n < 1536) return w[OFF_CQ + n - 1280];
    const int pp = n - 1536; return pp < 32 ? w[OFF_KR + 16 * ((pp >> 2) & 1) + 4 * (pp >> 3) + (pp & 3)] : 0.f;
}
__device__ __forceinline__ float wuq_src(const P& p, int l, int k, int n) {
    int col; if (n < 384) col = (n >> 6) * 96 + (n & 63); else if (n < 576) { const int pp = n - 384, ps = pp & 31; col = (pp >> 5) * 96 + 64 + 16 * ((ps >> 2) & 1) + 4 * (ps >> 3) + (ps & 3); } else return 0.f;
    return p.w_uq[((size_t)l * 256 + k) * QMW + col] * p.qn_g[l * 256 + k];
}
__device__ __forceinline__ float wukv_src(const P& p, int l, int k, int n) {
    int col; if (n < 384) col = (n >> 6) * 128 + (n & 63); else { const int pp = n - 384; col = (pp >> 6) * 128 + 64 + (pp & 63); }
    return p.w_ukv[((size_t)l * 128 + k) * 768 + col] * p.kvn_g[l * 128 + k];
}
__device__ __forceinline__ void fp_weights_in(const P& p, LAS unsigned char* lds, int bid, int nb) {
    const int tid = tidx(), lane = tid & 63, wave = tid >> 6;
    LAS float* scr = (LAS float*)(lds + wave * 16384);
    const int gw = bid * 8 + wave, NGW = nb * 8;
    constexpr int NBL = NIN_PAD / 32, I_IN = 16 * NBL;
#pragma unroll 1
    for (int it = gw; it < 2 * I_IN; it += NGW) {
        const int l = it / I_IN, r = it % I_IN, kb = r / NBL, nbk = r % NBL;
        if (nbk >= 16) { tr_item([&](int k, int n) { return win_src(p, l, k, n); }, 1024, ws_win_t(p, l), scr, kb, nbk, lane); }
        else {
            int ln = lane; asm volatile("" : "+v"(ln));
            const int part = nbk >> 3, g = (nbk >> 1) & 3, k0 = 64 * kb + 32 * (nbk & 1);
            const float* wx = (part ? ws_wsn(p) : ws_wc(p)) + (size_t)(l * 4 + g) * 4096 + ln;
            const float* wsrc = p.w_in + ((size_t)l * 1024 + k0) * DIN + g * 64;
#pragma unroll 4
            for (int i = 0; i < 8; ++i) { const int e = i * 64 + ln, kk = e >> 4, c4 = e & 15; ((LAS f32x4*)scr)[e] = *(const f32x4*)(wsrc + (size_t)kk * DIN + 4 * c4); }
            float wxr[64];
#pragma unroll
            for (int c = 0; c < 64; ++c) wxr[c] = wx[c * 64];
            LDS_WAIT(); asm volatile("" ::: "memory");
            bf16_t* dst = ws_win_t(p, l) + (size_t)(part * 256 + g * 64 + ln) * 1024 + k0;
#pragma unroll 1
            for (int k8 = 0; k8 < 4; ++k8) {
                float a[8];
#pragma unroll
                for (int j = 0; j < 8; ++j) a[j] = 0.f;
#pragma unroll
                for (int j = 0; j < 8; ++j) {
                    float s0 = 0.f, s1 = 0.f, s2 = 0.f, s3 = 0.f;
#pragma unroll
                    for (int c4 = 0; c4 < 16; ++c4) { const f32x4 w4 = ((LAS f32x4*)scr)[(8 * k8 + j) * 16 + c4];
                        asm("v_fmac_f32 %0, %1, %2" : "+v"(s0) : "v"(wxr[4 * c4]), "v"(w4.x)); asm("v_fmac_f32 %0, %1, %2" : "+v"(s1) : "v"(wxr[4 * c4 + 1]), "v"(w4.y));
                        asm("v_fmac_f32 %0, %1, %2" : "+v"(s2) : "v"(wxr[4 * c4 + 2]), "v"(w4.z)); asm("v_fmac_f32 %0, %1, %2" : "+v"(s3) : "v"(wxr[4 * c4 + 3]), "v"(w4.w)); }
                    a[j] = (s0 + s1) + (s2 + s3);
                    __builtin_amdgcn_sched_barrier(0);
                }
                v4u o; o.x = pk2(a[0], a[1]); o.y = pk2(a[2], a[3]); o.z = pk2(a[4], a[5]); o.w = pk2(a[6], a[7]);
                *(v4u*)(dst + 8 * k8) = o;
            }
            LDS_WAIT(); asm volatile("" ::: "memory");
        }
    }
}
__device__ __forceinline__ void fp_weights(const P& p, LAS unsigned char* lds, int bid, int nb) {
    const int tid = tidx(), lane = tid & 63, wave = tid >> 6;
    LAS float* scr = (LAS float*)(lds + wave * 16384);
    const int gw = bid * 8 + wave, NGW = nb * 8;
    constexpr int I_OUT = 16 * 32, I_1 = 16 * 128, I_2 = 64 * 32, I_UQ = 4 * (NUQ_PAD / 32), I_UKV = 2 * (NUKV / 32);
    constexpr int PER_L = I_OUT + I_1 + I_2 + I_UQ + I_UKV;
#pragma unroll 1
    for (int it = gw; it < 2 * PER_L; it += NGW) {
        const int l = it / PER_L; int r = it % PER_L;
        if (r < I_OUT) { const float* W = p.w_out + (size_t)l * 1024 * 1024; tr_item([&](int k, int n) { return W[(size_t)k * 1024 + n]; }, 1024, ws_wout_t(p, l), scr, r / 32, r % 32, lane); continue; } r -= I_OUT;
        if (r < I_1) { const float* W = p.w_mlp1 + (size_t)l * 1024 * DFF; tr_item([&](int k, int n) { return W[(size_t)k * DFF + n]; }, 1024, ws_w1_t(p, l), scr, r / 128, r % 128, lane); continue; } r -= I_1;
        if (r < I_2) { const float* W = p.w_mlp2 + (size_t)l * DFF * 1024; tr_item([&](int k, int n) { return W[(size_t)k * 1024 + n]; }, DFF, ws_w2_t(p, l), scr, r / 32, r % 32, lane); continue; } r -= I_2;
        if (r < I_UQ) { const int nbl = NUQ_PAD / 32; tr_item([&](int k, int n) { return wuq_src(p, l, k, n); }, 256, ws_wuq_t(p, l), scr, r / nbl, r % nbl, lane); continue; } r -= I_UQ;
        { const int nbl = NUKV / 32; tr_item([&](int k, int n) { return wukv_src(p, l, k, n); }, 128, ws_wukv_t(p, l), scr, r / nbl, r % nbl, lane); }
    }
}

__device__ __forceinline__ void fp_tables(const P& p, int bid, int nb) {
    const int gt = bid * FAST_THREADS + tidx(), GT = nb * FAST_THREADS;
    for (int idx = gt; idx < 4096 * 32; idx += GT) {
        const int s = idx >> 5, j = idx & 31;
        const int pos = (j < 16) ? (s >> 6) : (s & 63), f = j & 15;
        const float inv = powf(10000.0f, -(float)f / 16.0f), ang = (float)pos * inv;
        ws_cosh(p)[idx] = cosf(ang); ws_sinh(p)[idx] = sinf(ang);
    }
    for (int idx = gt; idx < 4096 * 16; idx += GT) {
        const int s = idx >> 4, j = idx & 15;
        const int pos = (j < 8) ? (s >> 6) : (s & 63), f = j & 7;
        const float inv = powf(10000.0f, -(float)f / 8.0f), ang = (float)pos * inv;
        ws_cosr(p)[idx] = cosf(ang); ws_sinr(p)[idx] = sinf(ang);
    }
    for (int idx = gt; idx < 2 * 4 * 64 * 64; idx += GT) {
        const int d = idx & 63, c = (idx >> 6) & 63, lg = idx >> 12;
        float ac = 0.f, as = 0.f;
        for (int c2 = 0; c2 < 64; ++c2) {
            float sn, cs; sincospif((float)((c * c2) & 63) * (1.0f / 32.0f), &sn, &cs);
            const float w = p.w_f[(size_t)(lg * 64 + c2) * 64 + d];
            ac += cs * w; as += sn * w;
        }
        ws_wc(p)[idx] = ac; ws_wsn(p)[idx] = as;
    }
}
__device__ __forceinline__ void fp_mods(const P& p, LAS unsigned char* lds, int bid, int nb) {
    const int tid = tidx(), lane = tid & 63, w = tid >> 6;
    LAS float* sc = (LAS float*)lds;
    LAS float* part = (LAS float*)(lds + 36864);
    if (bid >= 192) return;
    for (int i = tid; i < 9 * 1024; i += FAST_THREADS) {
        const int r = i >> 10, k = i & 1023;
        const float v = (r < 8) ? p.c[r * 1024 + k] : p.c_ctx[k];
        sc[i] = v / (1.0f + expf(-v));
    }
    __syncthreads();
    for (int it = bid; it < 192; it += nb) {
        const int l = it / 96, n = (it % 96) * 64 + lane;
        float acc[9];
#pragma unroll
        for (int r = 0; r < 9; ++r) acc[r] = 0.f;
        const float* wp = p.w_ada + ((size_t)l * 1024 + w * 128) * 6144 + n;
#pragma unroll 16
        for (int k = 0; k < 128; ++k) {
            const float wv = wp[(size_t)k * 6144];
#pragma unroll
            for (int r = 0; r < 9; ++r) acc[r] += sc[r * 1024 + w * 128 + k] * wv;
        }
#pragma unroll
        for (int r = 0; r < 9; ++r) part[(w * 9 + r) * 64 + lane] = acc[r];
        __syncthreads();
        for (int i = tid; i < 9 * 64; i += FAST_THREADS) {
            const int r = i >> 6, c = i & 63; float s = 0.f;
#pragma unroll
            for (int ww = 0; ww < 8; ++ww) s += part[(ww * 9 + r) * 64 + c];
            const int nn = (it % 96) * 64 + c;
            ws_mod(p)[(size_t)(l * 9 + r) * 6144 + nn] = s + p.b_ada[l * 6144 + nn];
        }
        __syncthreads();
    }
}


__device__ __forceinline__ void fp_gm(const P& p, int bid, int nb) {
    const int gt = bid * FAST_THREADS + tidx(), GT = nb * FAST_THREADS;
    for (int i = gt; i < 9 * 1024; i += GT) ws_gfin(p)[i] = p.fin_g[i & 1023];
    for (int i = gt; i < 2 * 2 * 9 * 1024; i += GT) {
        const int k = i & 1023, r = (i >> 10) % 9, lw = i / (9 * 1024), l = lw >> 1, which = lw & 1;
        const float g = (which == 0 ? p.n1g : p.n2g)[l * 1024 + k];
        ws_gm(p, l, which)[r * 1024 + k] = g * (1.0f + ws_mod(p)[(size_t)(l * 9 + r) * 6144 + (which == 0 ? 1024 : 4096) + k]);
    }
}
__device__ __forceinline__ void fp_bias(const P& p, int bid, int nb) {
    const int tid = tidx(), lane = tid & 63, gw = bid * 8 + (tid >> 6), NGW = nb * 8;
#pragma unroll 1
    for (int g = 0; g < 3; ++g) {
        const int nit = g < 2 ? 4096 : NIN_PAD, ldd = nit;
        if (gw >= nit) continue;
        const float* sh = g < 2 ? ws_mod(p) + (size_t)(g * 9) * 6144 + 3072 : ws_mod(p) + (size_t)9 * 6144;
        const bf16_t* wbase = g < 2 ? ws_w1_t(p, g) : ws_win_t(p, 1); float* dst = g < 2 ? ws_bias2(p, g) : ws_bias1(p);
        f32x4 s[9][4];
#pragma unroll
        for (int r = 0; r < 9; ++r) { const float* q = sh + (size_t)r * 6144 + 8 * lane; s[r][0] = *(const f32x4*)q; s[r][1] = *(const f32x4*)(q + 4); s[r][2] = *(const f32x4*)(q + 512); s[r][3] = *(const f32x4*)(q + 516); }
#pragma unroll 1
        for (int n = gw; n < nit; n += NGW) {
            const bf16_t* wrow = wbase + (size_t)n * 1024;
            float w[16];
            { const v4u a = ((const v4u*)wrow)[lane], b = ((const v4u*)wrow)[64 + lane];
              const unsigned u[8] = {a.x, a.y, a.z, a.w, b.x, b.y, b.z, b.w};
#pragma unroll
              for (int j = 0; j < 8; ++j) { w[2 * j] = __uint_as_float(u[j] << 16); w[2 * j + 1] = __uint_as_float(u[j] & 0xffff0000u); } }
            float d[9];
#pragma unroll
            for (int r = 0; r < 9; ++r)
                d[r] = (w[0] * s[r][0].x + w[1] * s[r][0].y) + (w[2] * s[r][0].z + w[3] * s[r][0].w) + (w[4] * s[r][1].x + w[5] * s[r][1].y) + (w[6] * s[r][1].z + w[7] * s[r][1].w)
                     + (w[8] * s[r][2].x + w[9] * s[r][2].y) + (w[10] * s[r][2].z + w[11] * s[r][2].w) + (w[12] * s[r][3].x + w[13] * s[r][3].y) + (w[14] * s[r][3].z + w[15] * s[r][3].w);
#pragma unroll
            for (int o = 1; o < 64; o <<= 1) {
                float t[9];
#pragma unroll
                for (int r = 0; r < 9; ++r) t[r] = shfl_xor_f(d[r], o);
#pragma unroll
                for (int r = 0; r < 9; ++r) d[r] += t[r];
            }
            if (lane < 9) { float v = d[0];
#pragma unroll
                for (int r = 1; r < 9; ++r) v = lane == r ? d[r] : v;
                dst[(size_t)lane * ldd + n] = v; }
        }
    }
}

__device__ __forceinline__ void fp_xn(const P& p, int l, int which, int nrows, int bid, int nb) {
    const int tid = tidx(), lane = tid & 63, gw = bid * 8 + (tid >> 6), NGW = nb * 8;
    const float* g = (which == 0 ? p.n1g : p.n2g) + l * 1024;
    for (int row = gw; row < nrows; row += NGW) {
        const float* h = which == 0 ? hrow_in(p, l, row) : hrow_mid(p, row);
        const float* mod = ws_mod(p) + (size_t)(l * 9 + modrow(row)) * 6144 + (which == 0 ? 0 : 3072);
        f32x4 v[4]; float ss = 0.f;
#pragma unroll
        for (int j = 0; j < 4; ++j) { v[j] = ((const f32x4*)h)[lane + 64 * j]; ss += (v[j].x * v[j].x + v[j].y * v[j].y) + (v[j].z * v[j].z + v[j].w * v[j].w); }
        ss = wave_sum(ss);
        const float rstd = 1.0f / sqrtf(ss * (1.0f / 1024.0f) + EPS);
        bf16_t* o = ws_xn(p) + (size_t)row * 1024;
#pragma unroll
        for (int j = 0; j < 4; ++j) {
            const int c = 4 * lane + 256 * j;
            const f32x4 gg = *(const f32x4*)(g + c), sh = *(const f32x4*)(mod + c), sc = *(const f32x4*)(mod + 1024 + c);
            const f32x4 y = (v[j] * rstd * gg) * (sc + 1.0f) + sh;
            v2u w; w.x = pk2(y.x, y.y); w.y = pk2(y.z, y.w);
            *(v2u*)(o + c) = w;
        }
    }
}

__device__ __forceinline__ void st8(bf16_t* dst, const pg8::f32x4 a, const pg8::f32x4 b) {
    v4u w; w.x = pg8::cvt_pk_bf16(a.x, a.y); w.y = pg8::cvt_pk_bf16(a.z, a.w); w.z = pg8::cvt_pk_bf16(b.x, b.y); w.w = pg8::cvt_pk_bf16(b.z, b.w); *(v4u*)dst = w;
}
__device__ __forceinline__ void st8_nt(bf16_t* dst, const pg8::f32x4 a, const pg8::f32x4 b) {
    v4u w; w.x = pg8::cvt_pk_bf16(a.x, a.y); w.y = pg8::cvt_pk_bf16(a.z, a.w); w.z = pg8::cvt_pk_bf16(b.x, b.y); w.w = pg8::cvt_pk_bf16(b.z, b.w); __builtin_nontemporal_store(w, (v4u*)dst);
}
__device__ __forceinline__ float sq4(const pg8::f32x4 v) { return (v.x * v.x + v.y * v.y) + (v.z * v.z + v.w * v.w); }
template <bool F32IN> struct EpiResidA {
    static constexpr bool PERM = true, AFTER_DRAIN = false; static constexpr bool DRAIN_AFTER = false;
    const float* hin_lat; const float* hin_ctx;
    const float* gm_in; float* hout; const float* gate; const float* gm; bf16_t* XN; float* RSSH;
    __device__ __forceinline__ void row_out(const pg8::f32x4 (&acc)[2][2][4][2], const pg8::f32x4 (&b)[2][2], const pg8::f32x4 (&gg)[2][2], const pg8::f32x4 (&gmv)[2][2],
                                            int ai, int m, int row, int cb, int pn, int wc, int fq) const {
        float ss = 0.f;
#pragma unroll
        for (int bj = 0; bj < 2; ++bj) {
            const pg8::f32x4 h0 = b[bj][0] + gg[bj][0] * acc[ai][bj][m][0], h1 = b[bj][1] + gg[bj][1] * acc[ai][bj][m][1];
            ss += sq4(h0) + sq4(h1);
            if (hout) { float* ho = hout + (size_t)row * 1024 + cb + bj * 128; *(pg8::f32x4*)ho = h0; *(pg8::f32x4*)(ho + 4) = h1; }
            if (gm) st8(XN + (size_t)row * 1024 + cb + bj * 128, h0 * gmv[bj][0], h1 * gmv[bj][1]);
        }
        ss += shfl_xor_f(ss, 16); ss += shfl_xor_f(ss, 32);
        if (fq == 0) RSSH[(size_t)row * 16 + pn * 4 + wc] = ss;
    }
    __device__ __forceinline__ void operator()(const pg8::f32x4 (&acc)[2][2][4][2], const pg8::Unit& u, int wr, int wc, int fr, int fq) const {
        const int mr = modrow(u.pm * 256), cb = u.pn * 256 + wc * 32 + 8 * fq;
        pg8::f32x4 gg[2][2], gmv[2][2], rgi[2][2];
#pragma unroll
        for (int bj = 0; bj < 2; ++bj)
#pragma unroll
            for (int n = 0; n < 2; ++n) { gg[bj][n] = *(const pg8::f32x4*)(gate + (size_t)mr * 6144 + cb + bj * 128 + n * 4);
                                          gmv[bj][n] = gm ? *(const pg8::f32x4*)(gm + (size_t)mr * 1024 + cb + bj * 128 + n * 4) : (pg8::f32x4){0.f, 0.f, 0.f, 0.f};
                                          if constexpr (!F32IN) { const pg8::f32x4 g_ = *(const pg8::f32x4*)(gm_in + (size_t)mr * 1024 + cb + bj * 128 + n * 4);
                                                          rgi[bj][n] = (pg8::f32x4){1.0f / g_.x, 1.0f / g_.y, 1.0f / g_.z, 1.0f / g_.w}; } }
        if constexpr (F32IN) {
#pragma unroll
            for (int g = 0; g < 4; ++g) {
                pg8::f32x4 raw[2][2][2];
#pragma unroll
                for (int k = 0; k < 2; ++k) { const int ai = g >> 1, m = (g & 1) * 2 + k, row = u.pm * 256 + ai * 128 + wr * 64 + m * 16 + fr;
                    const float* hi = (row < ML ? hin_lat + (size_t)row * 1024 : hin_ctx + (size_t)(row - ML) * 1024) + cb;
#pragma unroll
                    for (int bj = 0; bj < 2; ++bj) { raw[k][bj][0] = *(const pg8::f32x4*)(hi + bj * 128); raw[k][bj][1] = *(const pg8::f32x4*)(hi + bj * 128 + 4); } }
#pragma unroll
                for (int k = 0; k < 2; ++k) { const int ai = g >> 1, m = (g & 1) * 2 + k, row = u.pm * 256 + ai * 128 + wr * 64 + m * 16 + fr;
                    row_out(acc, raw[k], gg, gmv, ai, m, row, cb, u.pn, wc, fq); }
            }
        } else {
#pragma unroll
            for (int ai = 0; ai < 2; ++ai) {
                v4u raw[4][2];
#pragma unroll
                for (int m = 0; m < 4; ++m) { const int row = u.pm * 256 + ai * 128 + wr * 64 + m * 16 + fr;
#pragma unroll
                    for (int bj = 0; bj < 2; ++bj) raw[m][bj] = *(const v4u*)(XN + (size_t)row * 1024 + cb + bj * 128); }
#pragma unroll
                for (int m = 0; m < 4; ++m) { const int row = u.pm * 256 + ai * 128 + wr * 64 + m * 16 + fr;
                    pg8::f32x4 b[2][2];
#pragma unroll
                    for (int bj = 0; bj < 2; ++bj) { const v4u w = raw[m][bj];
                        b[bj][0] = (pg8::f32x4){__uint_as_float(w.x << 16), __uint_as_float(w.x & 0xffff0000u), __uint_as_float(w.y << 16), __uint_as_float(w.y & 0xffff0000u)} * rgi[bj][0];
                        b[bj][1] = (pg8::f32x4){__uint_as_float(w.z << 16), __uint_as_float(w.z & 0xffff0000u), __uint_as_float(w.w << 16), __uint_as_float(w.w & 0xffff0000u)} * rgi[bj][1]; }
                    row_out(acc, b, gg, gmv, ai, m, row, cb, u.pn, wc, fq); }
            }
        }
    }
};
__device__ __forceinline__ float rstd16(const float* rssh, int row, int fq) {
    const pg8::f32x4 a = *(const pg8::f32x4*)(rssh + (size_t)row * 16 + 4 * fq);
    float s = (a.x + a.y) + (a.z + a.w);
    s += shfl_xor_f(s, 16); s += shfl_xor_f(s, 32);
    return 1.0f / sqrtf(s * (1.0f / 1024.0f) + EPS);
}
__device__ __forceinline__ void rstd16x8(float (&rr)[2][4], const float* rssh, int row0, int fq) {
    pg8::f32x4 pa[2][4];
#pragma unroll
    for (int ai = 0; ai < 2; ++ai)
#pragma unroll
        for (int m = 0; m < 4; ++m) pa[ai][m] = *(const pg8::f32x4*)(rssh + (size_t)(row0 + ai * 128 + m * 16) * 16 + 4 * fq);
#pragma unroll
    for (int ai = 0; ai < 2; ++ai)
#pragma unroll
        for (int m = 0; m < 4; ++m) { float s = (pa[ai][m].x + pa[ai][m].y) + (pa[ai][m].z + pa[ai][m].w); s += shfl_xor_f(s, 16); s += shfl_xor_f(s, 32); rr[ai][m] = 1.0f / sqrtf(s * (1.0f / 1024.0f) + EPS); }
}
struct EpiMlp1 {
    static constexpr bool PERM = true, AFTER_DRAIN = false; static constexpr bool DRAIN_AFTER = false;
    bf16_t* O; const float* RSSH; const float* bias;
    __device__ __forceinline__ void operator()(const pg8::f32x4 (&acc)[2][2][4][2], const pg8::Unit& u, int wr, int wc, int fr, int fq) const {
        const int mr = modrow(u.pm * 256), cb = u.pn * 256 + wc * 32 + 8 * fq;
        pg8::f32x4 bv[2][2];
#pragma unroll
        for (int bj = 0; bj < 2; ++bj)
#pragma unroll
            for (int n = 0; n < 2; ++n) bv[bj][n] = *(const pg8::f32x4*)(bias + (size_t)mr * 4096 + cb + bj * 128 + n * 4);
        float rr[2][4];
        rstd16x8(rr, RSSH, u.pm * 256 + wr * 64 + fr, fq);
#pragma unroll
        for (int ai = 0; ai < 2; ++ai)
#pragma unroll
            for (int m = 0; m < 4; ++m) {
                const int row = u.pm * 256 + ai * 128 + wr * 64 + m * 16 + fr;
                const float r = rr[ai][m];
#pragma unroll
                for (int bj = 0; bj < 2; ++bj) {
                    pg8::f32x4 v[2];
#pragma unroll
                    for (int n = 0; n < 2; ++n) { v[n] = acc[ai][bj][m][n] * r + bv[bj][n];
                        v[n].x = fmaxf(v[n].x, 0.f); v[n].y = fmaxf(v[n].y, 0.f); v[n].z = fmaxf(v[n].z, 0.f); v[n].w = fmaxf(v[n].w, 0.f); v[n] = v[n] * v[n]; }
                    st8_nt(O + ((size_t)((row >> 4) * (DFF >> 5) + ((cb + bj * 128) >> 5)) * 512 + (row & 15) * 32 + 8 * fq), v[0], v[1]);
                }
            }
    }
};
struct EpiInproj {
    static constexpr bool PERM = true, AFTER_DRAIN = false; static constexpr bool DRAIN_AFTER = false;
    bf16_t *ZF, *QS, *KS, *VS, *CQ, *CKV, *KR; float *RSSQ, *RSSKV; const float *cosh, *sinh, *cosr, *sinr; const float* RSSH; const float* bias;
    __device__ __forceinline__ void operator()(const pg8::f32x4 (&acc_in)[2][2][4][2], const pg8::Unit& u, int wr, int wc, int fr, int fq) const {
        const int pn = u.pn, c8 = wc * 32 + 8 * fq;
        pg8::f32x4 bv[2][2];
#pragma unroll
        for (int bj = 0; bj < 2; ++bj)
#pragma unroll
            for (int n = 0; n < 2; ++n) bv[bj][n] = (RSSH && (pn != 6 || wc == 0)) ? *(const pg8::f32x4*)(bias + (size_t)modrow(u.pm * 256) * NIN_PAD + pn * 256 + c8 + bj * 128 + n * 4) : (pg8::f32x4){0.f, 0.f, 0.f, 0.f};
        float rr[2][4];
        if (RSSH && (pn != 6 || wc == 0)) rstd16x8(rr, RSSH, u.pm * 256 + wr * 64 + fr, fq);
        const bool rot = (pn == 2 || pn == 3), rotk = (pn == 6 && wc == 0);
        pg8::f32x4 tc[2][4], ts[2][4];
        if (rot || rotk) {
#pragma unroll
            for (int ai = 0; ai < 2; ++ai)
#pragma unroll
                for (int m = 0; m < 4; ++m) { const int row = u.pm * 256 + ai * 128 + wr * 64 + m * 16 + fr, s = row & 4095;
                    const float* pc = rot ? cosh + s * 32 + 16 * (wc & 1) + 4 * fq : cosr + s * 16 + 4 * fq; const float* ps = rot ? sinh + s * 32 + 16 * (wc & 1) + 4 * fq : sinr + s * 16 + 4 * fq;
                    if (row < ML) { tc[ai][m] = *(const pg8::f32x4*)pc; ts[ai][m] = *(const pg8::f32x4*)ps; } else { tc[ai][m] = (pg8::f32x4){1.f, 1.f, 1.f, 1.f}; ts[ai][m] = (pg8::f32x4){0.f, 0.f, 0.f, 0.f}; } }
        }
        __builtin_amdgcn_s_waitcnt(0x0F70);
#pragma unroll
        for (int ai = 0; ai < 2; ++ai)
#pragma unroll
            for (int m = 0; m < 4; ++m) {
                const int row = u.pm * 256 + ai * 128 + wr * 64 + m * 16 + fr;
                const bool lat = row < ML; const int s = row & 4095;
                pg8::f32x4 a[2][2];
#pragma unroll
                for (int bj = 0; bj < 2; ++bj)
#pragma unroll
                    for (int n = 0; n < 2; ++n) a[bj][n] = acc_in[ai][bj][m][n];
                if (RSSH) { const float r = rr[ai][m];
#pragma unroll
                    for (int bj = 0; bj < 2; ++bj)
#pragma unroll
                        for (int n = 0; n < 2; ++n) a[bj][n] = a[bj][n] * r + bv[bj][n]; }
                if (pn < 2) {
#pragma unroll
                    for (int bj = 0; bj < 2; ++bj) st8(ZF + (size_t)row * 512 + pn * 256 + bj * 128 + c8, a[bj][0], a[bj][1]);
                } else if (pn < 4) {
                    const int e = wc & 1, i0 = 16 * e + 4 * fq;
#pragma unroll
                    for (int bj = 0; bj < 2; ++bj) {
                        const int H = (pn - 2) * 4 + bj * 2 + (wc >> 1);
                        pg8::f32x4 y1 = a[bj][0], y2 = a[bj][1];
                        if (lat) { const pg8::f32x4 c4 = tc[ai][m], s4 = ts[ai][m];
                                   const pg8::f32x4 x1 = y1, x2 = y2; y1 = x1 * c4 - x2 * s4; y2 = x1 * s4 + x2 * c4; }
                        if (H < 6) { y1 = y1 * (0.125f * 1.4426950408889634f); y2 = y2 * (0.125f * 1.4426950408889634f);
                                     st8(QS + (size_t)row * 384 + H * 64 + 32 * e + 8 * fq, y1, y2); }
                        else st8(KS + ((size_t)(((row >> 6) * 2 + (H - 6)) * 8 + 4 * e + fq) * 64 + (row & 63)) * 8, y1, y2);
                    }
                } else if (pn == 4) {
                    st8(VS + ((size_t)((((row >> 6) * 2 + (wc >> 1)) * 2 + (wc & 1)) * 64 + (row & 63)) * 4 + fq) * 8, a[0][0], a[0][1]);
                    st8(CKV + (size_t)row * 128 + c8, a[1][0], a[1][1]);
                    float ss = sq4(a[1][0]) + sq4(a[1][1]);
                    ss += shfl_xor_f(ss, 16); ss += shfl_xor_f(ss, 32);
                    if (fq == 0) RSSKV[(size_t)row * 4 + wc] = ss;
                } else if (pn == 5) {
#pragma unroll
                    for (int bj = 0; bj < 2; ++bj) {
                        st8(CQ + (size_t)row * 256 + bj * 128 + c8, a[bj][0], a[bj][1]);
                        float ss = sq4(a[bj][0]) + sq4(a[bj][1]);
                        ss += shfl_xor_f(ss, 16); ss += shfl_xor_f(ss, 32);
                        if (fq == 0) RSSQ[(size_t)row * 8 + bj * 4 + wc] = ss;
                    }
                } else if (wc == 0) {
                    pg8::f32x4 y1 = a[0][0], y2 = a[0][1];
                    if (lat) { const pg8::f32x4 c4 = tc[ai][m], s4 = ts[ai][m];
                               const pg8::f32x4 x1 = y1, x2 = y2; y1 = x1 * c4 - x2 * s4; y2 = x1 * s4 + x2 * c4; }
                    st8(KR + ((size_t)((row >> 6) * 4 + fq) * 64 + (row & 63)) * 8, y1, y2);
                }
            }
    }
};
struct EpiUpQ {
    static constexpr bool PERM = true, AFTER_DRAIN = false; static constexpr bool DRAIN_AFTER = false;
    bf16_t* QM; const float* RSSQ; const float *cosr, *sinr;
    __device__ __forceinline__ void operator()(const pg8::f32x4 (&acc)[2][2][4][2], const pg8::Unit& u, int wr, int wc, int fr, int fq) const {
        v2u_f pq[2][4]; pg8::f32x4 tc[2][4], ts[2][4];
        const bool anyrot = (u.pn * 8 + 4 + wc >= 12) || (u.pn * 8 + wc >= 12);
#pragma unroll
        for (int ai = 0; ai < 2; ++ai)
#pragma unroll
            for (int m = 0; m < 4; ++m) { const int row = u.pm * 256 + ai * 128 + wr * 64 + m * 16 + fr, s = row & 4095;
                pq[ai][m] = *(const v2u_f*)(RSSQ + (size_t)row * 8 + 2 * fq);
                if (anyrot && row < ML) { tc[ai][m] = *(const pg8::f32x4*)(cosr + s * 16 + 4 * fq); ts[ai][m] = *(const pg8::f32x4*)(sinr + s * 16 + 4 * fq); }
                else { tc[ai][m] = (pg8::f32x4){1.f, 1.f, 1.f, 1.f}; ts[ai][m] = (pg8::f32x4){0.f, 0.f, 0.f, 0.f}; } }
        __builtin_amdgcn_s_waitcnt(0x0F70);
#pragma unroll
        for (int ai = 0; ai < 2; ++ai)
#pragma unroll
            for (int m = 0; m < 4; ++m) {
                const int row = u.pm * 256 + ai * 128 + wr * 64 + m * 16 + fr;
                const bool lat = row < ML;
                float r; { const v2u_f pa = pq[ai][m]; float s_ = pa.x + pa.y; s_ += shfl_xor_f(s_, 16); s_ += shfl_xor_f(s_, 32);
                           r = (0.10206207261596577f * 1.4426950408889634f) / sqrtf(s_ * (1.0f / 256.0f) + EPS); }
#pragma unroll
                for (int bj = 0; bj < 2; ++bj) {
                    const int grp = u.pn * 8 + bj * 4 + wc;
                    if (grp < 18) {
                        pg8::f32x4 y1 = acc[ai][bj][m][0] * r, y2 = acc[ai][bj][m][1] * r;
                        if (grp >= 12 && lat) { const pg8::f32x4 c4 = tc[ai][m], s4 = ts[ai][m];
                                                const pg8::f32x4 x1 = y1, x2 = y2; y1 = x1 * c4 - x2 * s4; y2 = x1 * s4 + x2 * c4; }
                        st8(QM + (size_t)row * QMW + grp * 32 + 8 * fq, y1, y2);
                    }
                }
            }
    }
};
struct EpiUpKV {
    static constexpr bool PERM = true, AFTER_DRAIN = false; static constexpr bool DRAIN_AFTER = false;
    bf16_t *KN, *VM; const float* RSSKV;
    __device__ __forceinline__ void operator()(const pg8::f32x4 (&acc)[2][2][4][2], const pg8::Unit& u, int wr, int wc, int fr, int fq) const {
        float pk_[2][4];
#pragma unroll
        for (int ai = 0; ai < 2; ++ai)
#pragma unroll
            for (int m = 0; m < 4; ++m) pk_[ai][m] = RSSKV[(size_t)(u.pm * 256 + ai * 128 + wr * 64 + m * 16 + fr) * 4 + fq];
        __builtin_amdgcn_s_waitcnt(0x0F70);
#pragma unroll
        for (int ai = 0; ai < 2; ++ai)
#pragma unroll
            for (int m = 0; m < 4; ++m) {
                const int row = u.pm * 256 + ai * 128 + wr * 64 + m * 16 + fr;
                float r; { float s_ = pk_[ai][m]; s_ += shfl_xor_f(s_, 16); s_ += shfl_xor_f(s_, 32); r = 1.0f / sqrtf(s_ * (1.0f / 128.0f) + EPS); }
#pragma unroll
                for (int bj = 0; bj < 2; ++bj) {
                    const int cb = u.pn * 2 + bj, tile = row >> 6, rit = row & 63;
                    bf16_t* dst;
                    if (cb < 3) { const int head = cb * 2 + (wc >> 1), chunk = (wc & 1) * 4 + fq; dst = KN + ((size_t)((tile * 6 + head) * 8 + chunk) * 64 + rit) * 8; }
                    else { const int head = (cb - 3) * 2 + (wc >> 1); dst = VM + ((size_t)(((tile * 6 + head) * 2 + (wc & 1)) * 64 + rit) * 4 + fq) * 8; }
                    st8(dst, acc[ai][bj][m][0] * r, acc[ai][bj][m][1] * r);
                }
            }
    }
};
namespace attn {
using bf16x8 = __attribute__((ext_vector_type(8))) short;
using s16x4  = __attribute__((ext_vector_type(4))) short;
using f32x16 = __attribute__((ext_vector_type(16))) float;
using u32x4  = __attribute__((ext_vector_type(4))) unsigned;
constexpr int NW = 8, QBLK = 32, KVBLK = 64;
constexpr int SHM_V = 16384, SHM_K = 16384, SHM_ATTN = 2 * SHM_V + 2 * SHM_K + NW * 64 * 4;
constexpr float LOG2E = 1.4426950408889634f;
constexpr float THRN = 8.f;
#define KSWZ(row, colB) ((row) * 256 + ((colB) ^ (((row) & 7) << 4)))
#define SBAR() __builtin_amdgcn_sched_barrier(0)
__device__ __forceinline__ int crow(int r, int hi) { return (r & 3) + 8 * (r >> 2) + 4 * hi; }
__device__ __forceinline__ unsigned cvtpk(float lo, float hi) { unsigned r; asm volatile("v_cvt_pk_bf16_f32 %0, %1, %2" : "=v"(r) : "v"(lo), "v"(hi)); return r; }

template <int MODE> struct Cfg;
template <> struct Cfg<0> { static constexpr int KD = 96; static constexpr float SCALE = 0.10206207261596577f; static constexpr int NLOAD = 3; };
template <> struct Cfg<1> { static constexpr int KD = 64; static constexpr float SCALE = 0.125f; static constexpr int NLOAD = 2; };

template <int MODE>
__device__ __forceinline__ void partialSM(f32x16& p0, f32x16& p1, float& m_reg, float& mn, float& alpha) {
  constexpr float SC = Cfg<MODE>::SCALE, C = SC * LOG2E;
  float pmax = p0[0];
#pragma unroll
  for (int r = 1; r < 16; ++r) pmax = fmaxf(pmax, p0[r]);
#pragma unroll
  for (int r = 0; r < 16; ++r) pmax = fmaxf(pmax, p1[r]);
  { auto rr = __builtin_amdgcn_permlane32_swap(__float_as_uint(pmax), __float_as_uint(pmax), false, false);
    pmax = fmaxf(__uint_as_float(rr[0]), __uint_as_float(rr[1])); }
  if (__builtin_expect(__all(pmax - m_reg <= THRN / SC), 1)) { mn = m_reg; alpha = 1.f; }
  else { mn = fmaxf(m_reg, pmax); alpha = __builtin_amdgcn_exp2f((m_reg - mn) * C); m_reg = mn; }
  const float mnC = -mn * C;
#pragma unroll
  for (int r = 0; r < 16; ++r) p0[r] = fmaf(p0[r], C, mnC);
#pragma unroll
  for (int r = 0; r < 16; ++r) p1[r] = fmaf(p1[r], C, mnC);
#pragma unroll
  for (int r = 0; r < 16; ++r) p0[r] = __builtin_amdgcn_exp2f(p0[r]);
}
__device__ __forceinline__ void finishSM(f32x16& p0, f32x16& p1, float alpha, float& l_reg, bf16x8& pa0, bf16x8& pa1, bf16x8& pa2, bf16x8& pa3) {
#pragma unroll
  for (int r = 0; r < 16; ++r) p1[r] = __builtin_amdgcn_exp2f(p1[r]);
  float ps = 0;
#pragma unroll
  for (int r = 0; r < 16; ++r) ps += p0[r];
#pragma unroll
  for (int r = 0; r < 16; ++r) ps += p1[r];
  { auto rr = __builtin_amdgcn_permlane32_swap(__float_as_uint(ps), __float_as_uint(ps), false, false);
    ps = __uint_as_float(rr[0]) + __uint_as_float(rr[1]); }
  l_reg = l_reg * alpha + ps;
#define PK4(P, BASE, OUT) do { unsigned a0 = cvtpk(P[BASE + 0], P[BASE + 1]), a1 = cvtpk(P[BASE + 2], P[BASE + 3]);   \
    unsigned b0 = cvtpk(P[BASE + 4], P[BASE + 5]), b1 = cvtpk(P[BASE + 6], P[BASE + 7]);                              \
    auto r0 = __builtin_amdgcn_permlane32_swap(a0, b0, false, false); auto r1 = __builtin_amdgcn_permlane32_swap(a1, b1, false, false); \
    u32x4 w = {r0[0], r1[0], r0[1], r1[1]}; OUT = *reinterpret_cast<bf16x8*>(&w); } while (0)
  PK4(p0, 0, pa0); PK4(p0, 8, pa1); PK4(p1, 0, pa2); PK4(p1, 8, pa3);
#undef PK4
}
template <int KD>
__device__ __forceinline__ void qkt(f32x16& p0, f32x16& p1, const char* Ks, const bf16x8* qr, int r32, int hi) {
  p0 = f32x16{}; p1 = f32x16{};
#pragma unroll
  for (int d0 = 0; d0 < KD / 16; ++d0) { const int cb = (d0 * 16 + hi * 8) * 2;
    const bf16x8 b0 = *reinterpret_cast<const bf16x8*>(Ks + KSWZ(r32, cb));
    const bf16x8 b1 = *reinterpret_cast<const bf16x8*>(Ks + KSWZ(32 + r32, cb));
    p0 = __builtin_amdgcn_mfma_f32_32x32x16_bf16(b0, qr[d0], p0, 0, 0, 0);
    p1 = __builtin_amdgcn_mfma_f32_32x32x16_bf16(b1, qr[d0], p1, 0, 0, 0); }
}
__device__ __forceinline__ int v_st(int k, int c) { const int kk = (k & ~0xC) | ((k & 4) << 1) | ((k & 8) >> 1); return ((kk >> 3) * 4 + (c >> 5)) * 512 + ((kk & 7) * 32 + (c & 31)) * 2; }
__device__ __forceinline__ int v_rd_base(int lane) { return ((lane & 3) << 3) | (((lane >> 2) & 3) << 6) | (((lane >> 4) & 1) << 5) | (((lane >> 5) & 1) << 8); }
constexpr int v_rd_off(int d0, int ks, int half) { return d0 * 512 + ks * 4096 + half * 2048; }
template <int OFF> __device__ __forceinline__ s16x4 tr_read(int vb) {
  s16x4 r; asm volatile("ds_read_b64_tr_b16 %0, %1 offset:%2" : "=&v"(r) : "v"(vb), "i"(OFF) : "memory"); return r;
}
template <int D0> __device__ __forceinline__ void pv_one(f32x16& od, int vb, bf16x8 pa0, bf16x8 pa1, bf16x8 pa2, bf16x8 pa3) {
  const s16x4 l0 = tr_read<v_rd_off(D0, 0, 0)>(vb), h0 = tr_read<v_rd_off(D0, 0, 1)>(vb), l1 = tr_read<v_rd_off(D0, 1, 0)>(vb), h1 = tr_read<v_rd_off(D0, 1, 1)>(vb);
  const s16x4 l2 = tr_read<v_rd_off(D0, 2, 0)>(vb), h2 = tr_read<v_rd_off(D0, 2, 1)>(vb), l3 = tr_read<v_rd_off(D0, 3, 0)>(vb), h3 = tr_read<v_rd_off(D0, 3, 1)>(vb);
  asm volatile("s_waitcnt lgkmcnt(0)" ::: "memory"); SBAR();
#define PK(L, H) (bf16x8){L[0], L[1], L[2], L[3], H[0], H[1], H[2], H[3]}
  od = __builtin_amdgcn_mfma_f32_32x32x16_bf16(pa0, PK(l0, h0), od, 0, 0, 0);
  od = __builtin_amdgcn_mfma_f32_32x32x16_bf16(pa1, PK(l1, h1), od, 0, 0, 0);
  od = __builtin_amdgcn_mfma_f32_32x32x16_bf16(pa2, PK(l2, h2), od, 0, 0, 0);
  od = __builtin_amdgcn_mfma_f32_32x32x16_bf16(pa3, PK(l3, h3), od, 0, 0, 0);
#undef PK
}
__device__ __forceinline__ void pv_d0(f32x16* o, int vb, bf16x8 pa0, bf16x8 pa1, bf16x8 pa2, bf16x8 pa3) {
  pv_one<0>(o[0], vb, pa0, pa1, pa2, pa3); pv_one<1>(o[1], vb, pa0, pa1, pa2, pa3);
}
__device__ __forceinline__ void swa_mask(f32x16& p0, f32x16& p1, int kbase, int qpos, int hi) {
#pragma unroll
  for (int r = 0; r < 16; ++r) {
    const int k0 = kbase + crow(r, hi) - qpos, k1 = k0 + 32;
    if (k0 > 128 || k0 < -128) p0[r] = -1e30f;
    if (k1 > 128 || k1 < -128) p1[r] = -1e30f;
  }
}

template <int MODE>
__device__ __forceinline__ void attn_unit(const P& p, int l, bool isctx, int b, int h, int q0, char* lds) {
  constexpr int KD = Cfg<MODE>::KD; constexpr float SC = Cfg<MODE>::SCALE, C = SC * LOG2E;
  const int tid = tidx(), wid = tid >> 6, lane = tid & 63, r32 = lane & 31, hi = lane >> 5;
  char* V_lds = lds; char* K_lds = lds + 2 * SHM_V;
  float* wsf = (float*)(lds + 2 * SHM_V + 2 * SHM_K) + wid * 64; float* li_l = wsf; float* al_l = wsf + 32;
  const bf16_t* QM = ws_qm(p); const bf16_t* KN = ws_kn(p); const bf16_t* VM = ws_vm(p); const bf16_t* KR = ws_kr(p);
  const bf16_t* QS = ws_qs(p); const bf16_t* KS = ws_ks(p); const bf16_t* VS = ws_vs(p);
  const int qrow0 = isctx ? ML + b * 256 : b * 4096 + q0;
  const int qrow = qrow0 + wid * QBLK + r32, qpos = q0 + wid * QBLK + r32;
  const int kvh = h / 3;
  int kstart = 0, NT;
  if (MODE == 0) NT = isctx ? 4 : 68;
  else { if (isctx) NT = 4; else { kstart = max(0, q0 - 128); const int kend = min(S, q0 + 384); NT = 4 + (kend - kstart) / 64; } }
  auto tile_row = [&](int t) -> int {
    if (isctx) return ML + b * 256 + t * 64;
    if (MODE == 0) return t < 64 ? b * 4096 + t * 64 : ML + b * 256 + (t - 64) * 64;
    return t < 4 ? ML + b * 256 + t * 64 : b * 4096 + kstart + (t - 4) * 64;
  };
  float m_reg = -1e30f, l_reg = 0; f32x16 o[2] = {}; bf16x8 qr[KD / 16];
  if (MODE == 0) {
    const bf16_t* Qw = QM + (size_t)qrow * QMW + hi * 8;
#pragma unroll
    for (int d0 = 0; d0 < 4; ++d0) qr[d0] = *reinterpret_cast<const bf16x8*>(Qw + h * 64 + d0 * 16);
#pragma unroll
    for (int d0 = 4; d0 < 6; ++d0) qr[d0] = *reinterpret_cast<const bf16x8*>(Qw + 384 + h * 32 + (d0 - 4) * 16);
  } else {
    const bf16_t* Qw = QS + (size_t)qrow * 384 + h * 64 + hi * 8;
#pragma unroll
    for (int d0 = 0; d0 < 4; ++d0) qr[d0] = *reinterpret_cast<const bf16x8*>(Qw + d0 * 16);
  }
  const int srow = tid >> 3, sch = tid & 7, srow2 = (tid & 255) >> 2, sch2 = tid & 3;
  const int kst = KSWZ(srow, sch * 16), kst2 = KSWZ(srow2, (8 + sch2) * 16), vst = v_st(srow, sch * 8);
  const int vb0 = (int)(uintptr_t)V_lds + v_rd_base(lane);
  struct Slot { bf16x8 k, v, k2; } sl_[2];
#define SLOAD(i, t) do { const int rb_ = tile_row(t); \
    if (MODE == 0) { sl_[i].k = *reinterpret_cast<const bf16x8*>(KN + (size_t)(rb_ + srow) * 384 + h * 64 + sch * 8); \
      sl_[i].v = *reinterpret_cast<const bf16x8*>(VM + (size_t)(rb_ + srow) * 384 + h * 64 + sch * 8); \
      sl_[i].k2 = *reinterpret_cast<const bf16x8*>(KR + (size_t)(rb_ + srow2) * 32 + sch2 * 8); } \
    else { sl_[i].k = *reinterpret_cast<const bf16x8*>(KS + (size_t)(rb_ + srow) * 128 + kvh * 64 + sch * 8); \
      sl_[i].v = *reinterpret_cast<const bf16x8*>(VS + (size_t)(rb_ + srow) * 128 + kvh * 64 + sch * 8); } } while (0)
#define SWRITE(bf, i) do { *(bf16x8*)(V_lds + (bf) * SHM_V + vst) = sl_[i].v; *(bf16x8*)(K_lds + (bf) * SHM_K + kst) = sl_[i].k; \
    if (MODE == 0) *(bf16x8*)(K_lds + (bf) * SHM_K + kst2) = sl_[i].k2; } while (0)
#define SWAIT() do { if (MODE == 0) asm volatile("s_waitcnt vmcnt(3)" ::: "memory"); else asm volatile("s_waitcnt vmcnt(2)" ::: "memory"); } while (0)
#define RESC(a) do { if (__any((a) < 1.f)) { if (hi == 0) al_l[r32] = (a); asm volatile("s_waitcnt lgkmcnt(0)" ::: "memory"); \
    _Pragma("unroll") for (int d = 0; d < 2; ++d) _Pragma("unroll") for (int r = 0; r < 16; ++r) o[d][r] *= al_l[crow(r, hi)]; } } while (0)
#define MASK(P0, P1, t) do { if (MODE == 1 && !isctx && (t) >= 4) swa_mask(P0, P1, kstart + ((t) - 4) * 64, qpos, hi); } while (0)
  f32x16 pA0, pA1, pB0, pB1; float mnA, mnB, alA, alB; bf16x8 pa0, pa1, pa2, pa3;
  constexpr int SE = 0, SO = 1;
  SLOAD(SE, 0); asm volatile("s_waitcnt vmcnt(0)" ::: "memory"); SWRITE(0, SE); __syncthreads();
  qkt<KD>(pA0, pA1, K_lds, qr, r32, hi); MASK(pA0, pA1, 0); partialSM<MODE>(pA0, pA1, m_reg, mnA, alA);
  SLOAD(SO, 1); if (2 < NT) SLOAD(SE, 2);
  SWAIT(); SWRITE(1, SO); __syncthreads();
  for (int j = 1; j + 1 < NT; j += 2) {
    SBAR(); qkt<KD>(pB0, pB1, K_lds + SHM_K, qr, r32, hi);
    finishSM(pA0, pA1, alA, l_reg, pa0, pa1, pa2, pa3); SBAR();
    SLOAD(SO, j + 2); SBAR();
    pv_d0(o, vb0, pa0, pa1, pa2, pa3); MASK(pB0, pB1, j); partialSM<MODE>(pB0, pB1, m_reg, mnB, alB);
    __syncthreads(); SWAIT(); SWRITE(0, SE);
    RESC(alB); __syncthreads();
    SBAR(); qkt<KD>(pA0, pA1, K_lds, qr, r32, hi);
    finishSM(pB0, pB1, alB, l_reg, pa0, pa1, pa2, pa3); SBAR();
    if (j + 3 < NT) SLOAD(SE, j + 3); SBAR();
    pv_d0(o, vb0 + SHM_V, pa0, pa1, pa2, pa3); MASK(pA0, pA1, j + 1); partialSM<MODE>(pA0, pA1, m_reg, mnA, alA);
    __syncthreads(); SWAIT(); SWRITE(1, SO);
    RESC(alA); __syncthreads();
  }
  SBAR(); qkt<KD>(pB0, pB1, K_lds + SHM_K, qr, r32, hi);
  finishSM(pA0, pA1, alA, l_reg, pa0, pa1, pa2, pa3); SBAR();
  pv_d0(o, vb0, pa0, pa1, pa2, pa3); MASK(pB0, pB1, NT - 1); partialSM<MODE>(pB0, pB1, m_reg, mnB, alB);
  __syncthreads(); RESC(alB);
  finishSM(pB0, pB1, alB, l_reg, pa0, pa1, pa2, pa3); SBAR();
  pv_d0(o, vb0 + SHM_V, pa0, pa1, pa2, pa3);
  if (MODE == 1) l_reg += __builtin_amdgcn_exp2f(p.sink[l * 6 + h] * LOG2E - m_reg * C);
  if (hi == 0) li_l[r32] = l_reg; asm volatile("s_waitcnt lgkmcnt(0)" ::: "memory");
  float rli[16];
#pragma unroll
  for (int r = 0; r < 16; ++r) rli[r] = __builtin_amdgcn_rcpf(li_l[crow(r, hi)]);
  bf16_t* Ow = ws_mix(p) + (size_t)(qrow0 + wid * QBLK) * 1024 + (MODE == 0 ? 640 : 256) + h * 64;
  { bf16_t* stg = (bf16_t*)(lds + SHM_ATTN) + wid * 2048;
#pragma unroll
    for (int r = 0; r < 16; ++r) { const int orow = crow(r, hi);
#pragma unroll
      for (int d0 = 0; d0 < 2; ++d0) stg[orow * 64 + d0 * 32 + r32] = f2bf(o[d0][r] * rli[r]); }
    asm volatile("s_waitcnt lgkmcnt(0)" ::: "memory");
#pragma unroll
    for (int i = 0; i < 4; ++i) { const int row = i * 8 + (lane >> 3), ch = lane & 7; const u32x4 v = *(const u32x4*)(stg + row * 64 + ch * 8); *(u32x4*)(Ow + (size_t)row * 1024 + ch * 8) = v; }
    asm volatile("s_waitcnt lgkmcnt(0)" ::: "memory"); }
  __syncthreads();
#undef SLOAD
#undef SWRITE
#undef SWAIT
#undef RESC
#undef MASK
}
#undef KSWZ
#undef SBAR
}

__device__ __forceinline__ bf16_t* ws_fwa(const P& p) { return (bf16_t*)(p.ws + O_FFTW); }
__device__ __forceinline__ bf16_t* ws_fwb(const P& p) { return (bf16_t*)(p.ws + O_FFTW + 32768); }
__device__ __forceinline__ bf16_t* ws_fwc(const P& p) { return (bf16_t*)(p.ws + O_FFTW + 65536); }
__device__ __forceinline__ float2* ws_tw(const P& p) { return (float2*)(p.ws + O_TW); }
__device__ __forceinline__ void fp_fftw(const P& p, int bid, int nb) {
    const int gt = bid * FAST_THREADS + tidx(), GT = nb * FAST_THREADS;
    for (int i = gt; i < 4096; i += GT) { float sn, cs; sincospif((float)i * (1.0f / 2048.0f), &sn, &cs); ws_tw(p)[i] = make_float2(cs, sn); }
    for (int i = gt; i < 128 * 128; i += GT) {
        const int m = i >> 7, k = i & 127, pp = m >> 6, s1p = m & 63, part = k >> 6, s1 = k & 63;
        float sn, cs; sincospif((float)((s1 * s1p) & 63) * (1.0f / 32.0f), &sn, &cs);
        const float v = pp == 0 ? (part == 0 ? cs : -sn) : (part == 0 ? -sn : -cs);
        ws_fwa(p)[i] = f2bf(v);
    }
    for (int i = gt; i < 64 * 128; i += GT) {
        const int m = i >> 7, k = i & 127, part = k >> 6, s2 = k & 63;
        float sn, cs; sincospif((float)((s2 * m) & 63) * (1.0f / 32.0f), &sn, &cs);
        ws_fwb(p)[i] = f2bf((part == 0 ? cs : sn) * (1.0f / 512.0f));
    }
    for (int i = gt; i < 256 * 512; i += GT) {
        const int m = i >> 9, k = i & 511, part = k >> 8, s = k & 255;
        float sn, cs; sincospif((float)((s * m) & 255) * (1.0f / 128.0f), &sn, &cs);
        ws_fwc(p)[i] = f2bf((part == 0 ? cs : -sn) * (1.0f / 128.0f));
    }
}
namespace fft {
using attn::bf16x8; using attn::s16x4; using attn::f32x16;
template <class RowFn> __device__ __forceinline__ void ld_rows(bf16x8 (&v)[8], RowFn rowptr, int c) {
    const int tid = tidx();
#pragma unroll
    for (int i = 0; i < 8; ++i) { const int q = tid + 512 * i, k = q >> 5, cc = q & 31; v[i] = *reinterpret_cast<const bf16x8*>(rowptr(c * 128 + k) + cc * 8); }
}
__device__ __forceinline__ void st_tile(char* lds, const bf16x8 (&v)[8]) {
    const int tid = tidx();
#pragma unroll
    for (int i = 0; i < 8; ++i) { const int q = tid + 512 * i, k = q >> 5, cc = q & 31;
        *(bf16x8*)(lds + ((k >> 6) * 2 + (cc >> 4)) * 16384 + attn::v_st(k & 63, (cc & 15) * 8)) = v[i]; }
}
template <int LDW> __device__ __forceinline__ void ld_w(bf16x8 (&wf)[2][8], const bf16_t* W, int t0, int c) {
    const int lane = tidx() & 63, r32 = lane & 31, hi = lane >> 5;
#pragma unroll
    for (int t = 0; t < 2; ++t) { const bf16_t* wp = W + (size_t)(32 * (t0 + t) + r32) * LDW + c * 128 + 8 * hi;
#pragma unroll
        for (int ks = 0; ks < 8; ++ks) wf[t][ks] = *reinterpret_cast<const bf16x8*>(wp + 16 * ks); }
}
__device__ __forceinline__ void rd_tile(bf16x8 (&bfr)[8], char* lds) {
    const int tid = tidx(), w = tid >> 6, lane = tid & 63;
    const int vb = (int)(uintptr_t)lds + attn::v_rd_base(lane) + (w >> 2) * 16384 + (w & 3) * 512;
#define FFT_RD(ks) { const s16x4 lo_ = attn::tr_read<((ks) >> 2) * 32768 + ((ks) & 3) * 4096>(vb), hi_ = attn::tr_read<((ks) >> 2) * 32768 + ((ks) & 3) * 4096 + 2048>(vb); \
                     bfr[ks] = (bf16x8){lo_[0], lo_[1], lo_[2], lo_[3], hi_[0], hi_[1], hi_[2], hi_[3]}; }
    FFT_RD(0) FFT_RD(1) FFT_RD(2) FFT_RD(3) FFT_RD(4) FFT_RD(5) FFT_RD(6) FFT_RD(7)
#undef FFT_RD
    asm volatile("s_waitcnt lgkmcnt(0)" ::: "memory"); __builtin_amdgcn_sched_barrier(0);
}
__device__ __forceinline__ void mac2(f32x16& a0, f32x16& a1, const bf16x8 (&wf)[2][8], const bf16x8 (&bfr)[8]) {
#pragma unroll
    for (int ks = 0; ks < 8; ++ks) a0 = __builtin_amdgcn_mfma_f32_32x32x16_bf16(wf[0][ks], bfr[ks], a0, 0, 0, 0);
#pragma unroll
    for (int ks = 0; ks < 8; ++ks) a1 = __builtin_amdgcn_mfma_f32_32x32x16_bf16(wf[1][ks], bfr[ks], a1, 0, 0, 0);
}
constexpr int TWL = 131072 + 4096;
}
__device__ __forceinline__ void fp_fft_a(const P& p, bool with_ctx, LAS unsigned char* ldsl, int bid, int nb) {
    char* lds = (char*)ldsl;
    const int tid = tidx(), w = tid >> 6, lane = tid & 63, r32 = lane & 31, hi = lane >> 5;
    const bf16_t* ZF = ws_zf(p); bf16_t* YB = ws_yb(p); bf16_t* MIX = ws_mix(p); const float2* TW = ws_tw(p);
    const int nu = 512 + (with_ctx ? 32 : 0);
    constexpr int WL = 65536, STG = 98304;
#pragma unroll
    for (int i = 0; i < 4; ++i) { const int q = tid + 512 * i, row = q >> 4, c = q & 15; *(v4u*)(lds + WL + row * 256 + ((c ^ (row & 15)) << 4)) = *(const v4u*)(ws_fwa(p) + row * 128 + c * 8); }
    auto rowp = [&](int u, int k) -> const bf16_t* {
        if (u < 512) { const int b = u >> 6, s2 = u & 63; return ZF + (size_t)(b * 4096 + 64 * (k & 63) + s2) * 512 + (k >> 6) * 256; }
        const int b = (u - 512) >> 2; return ZF + (size_t)(ML + b * 256 + (k & 255)) * 512 + (k >> 8) * 256; };
    attn::bf16x8 v[8];
    int u = nb - 1 - bid;
    if (u < nu) fft::ld_rows(v, [&](int k) { return rowp(u, k); }, 0);
    for (; u < nu; u += nb) {
        const int un = u + nb;
        attn::bf16x8 bfr[8];
        bf16_t* stg = (bf16_t*)(lds + STG) + w * 2048;
        if (u < 512) {
            const int b = u >> 6, s2 = u & 63;
            float2 twv = make_float2(0.f, 0.f); if (w == 0) twv = TW[s2 * lane];
            attn::f32x16 acc[4];
#pragma unroll
            for (int t = 0; t < 4; ++t) acc[t] = attn::f32x16{};
            __syncthreads();
            fft::st_tile(lds, v); if (w == 0) *(float2*)(lds + fft::TWL + lane * 8) = twv;
            __syncthreads();
            if (un < nu) fft::ld_rows(v, [&](int k) { return rowp(un, k); }, 0);
            fft::rd_tile(bfr, lds);
            const char* wrow = lds + WL + r32 * 256; const int x = r32 & 15;
#pragma unroll
            for (int t = 0; t < 4; ++t)
#pragma unroll
                for (int ks = 0; ks < 8; ++ks) {
                    const attn::bf16x8 wfr = *(const attn::bf16x8*)(wrow + t * 8192 + (((2 * ks + hi) ^ x) << 4));
                    acc[t] = __builtin_amdgcn_mfma_f32_32x32x16_bf16(wfr, bfr[ks], acc[t], 0, 0, 0);
                }
            const char* twb = lds + fft::TWL + hi * 32;
#pragma unroll
            for (int tt = 0; tt < 2; ++tt) {
#pragma unroll
                for (int r = 0; r < 16; ++r) {
                    const float2 cs = *(const float2*)(twb + (32 * tt + attn::crow(r, 0)) * 8);
                    const float yr = acc[tt][r], yi = acc[tt + 2][r];
                    const unsigned pk = pg8::cvt_pk_bf16(yr * cs.x + yi * cs.y, yi * cs.x - yr * cs.y);
                    stg[attn::crow(r, hi) * 64 + r32] = (bf16_t)(pk & 0xffffu); stg[attn::crow(r, hi) * 64 + 32 + r32] = (bf16_t)(pk >> 16);
                }
                asm volatile("s_waitcnt lgkmcnt(0)" ::: "memory");
#pragma unroll
                for (int i = 0; i < 4; ++i) { const int s1p = 32 * tt + i * 8 + (lane >> 3), c8 = lane & 7;
                    const v4u vv = *(const v4u*)(stg + (i * 8 + (lane >> 3)) * 64 + c8 * 8);
                    *(v4u*)(YB + ((size_t)((b * 64 + s1p) * 64 + s2)) * 512 + (c8 >> 2) * 256 + 32 * w + (c8 & 3) * 8) = vv; }
                asm volatile("s_waitcnt lgkmcnt(0)" ::: "memory");
            }
        } else {
            const int b = (u - 512) >> 2, tq = (u - 512) & 3;
            attn::f32x16 acc[2]; acc[0] = attn::f32x16{}; acc[1] = attn::f32x16{};
            attn::bf16x8 wf[2][8];
#pragma unroll 1
            for (int c = 0; c < 4; ++c) {
                __syncthreads(); fft::st_tile(lds, v); __syncthreads();
                fft::ld_w<512>(wf, ws_fwc(p) + (size_t)(64 * tq) * 512, 0, c);
                __builtin_amdgcn_sched_barrier(0);
                if (c < 3) fft::ld_rows(v, [&](int k) { return rowp(u, k); }, c + 1);
                __builtin_amdgcn_sched_barrier(0);
                fft::rd_tile(bfr, lds);
                fft::mac2(acc[0], acc[1], wf, bfr);
            }
#pragma unroll
            for (int t = 0; t < 2; ++t)
#pragma unroll
                for (int r = 0; r < 16; ++r) stg[(32 * t + attn::crow(r, hi)) * 32 + r32] = f2bf(acc[t][r]);
            asm volatile("s_waitcnt lgkmcnt(0)" ::: "memory");
#pragma unroll
            for (int i = 0; i < 4; ++i) { const int rr = i * 16 + (lane >> 2), c4 = lane & 3; const v4u vv = *(const v4u*)(stg + rr * 32 + c4 * 8);
                *(v4u*)(MIX + (size_t)(ML + b * 256 + 64 * tq + rr) * 1024 + 32 * w + c4 * 8) = vv; }
            asm volatile("s_waitcnt lgkmcnt(0)" ::: "memory");
        }
    }
    __syncthreads();
}
__device__ __forceinline__ void fp_fft_b(const P& p, LAS unsigned char* ldsl, int bid, int nb) {
    char* lds = (char*)ldsl;
    const int tid = tidx(), w = tid >> 6, lane = tid & 63, r32 = lane & 31, hi = lane >> 5;
    const bf16_t* YB = ws_yb(p); bf16_t* MIX = ws_mix(p);
    constexpr int WL = 65536, STG = 98304;
#pragma unroll
    for (int i = 0; i < 2; ++i) { const int q = tid + 512 * i, row = q >> 4, c = q & 15; *(v4u*)(lds + WL + row * 256 + ((c ^ (row & 15)) << 4)) = *(const v4u*)(ws_fwb(p) + row * 128 + c * 8); }
    auto rowp = [&](int u, int k) -> const bf16_t* { const int b = u >> 6, s1p = u & 63; return YB + ((size_t)((b * 64 + s1p) * 64 + (k & 63))) * 512 + (k >> 6) * 256; };
    attn::bf16x8 v[8];
    int u = bid;
    if (u < 512) fft::ld_rows(v, [&](int k) { return rowp(u, k); }, 0);
    for (; u < 512; u += nb) {
        const int b = u >> 6, s1p = u & 63, un = u + nb;
        attn::bf16x8 bfr[8];
        attn::f32x16 acc[2]; acc[0] = attn::f32x16{}; acc[1] = attn::f32x16{};
        __syncthreads(); fft::st_tile(lds, v); __syncthreads();
        if (un < 512) fft::ld_rows(v, [&](int k) { return rowp(un, k); }, 0);
        fft::rd_tile(bfr, lds);
        const char* wrow = lds + WL + r32 * 256; const int x = r32 & 15;
#pragma unroll
        for (int t = 0; t < 2; ++t)
#pragma unroll
            for (int ks = 0; ks < 8; ++ks) {
                const attn::bf16x8 wfr = *(const attn::bf16x8*)(wrow + t * 8192 + (((2 * ks + hi) ^ x) << 4));
                acc[t] = __builtin_amdgcn_mfma_f32_32x32x16_bf16(wfr, bfr[ks], acc[t], 0, 0, 0);
            }
        bf16_t* stg = (bf16_t*)(lds + STG) + w * 2048;
#pragma unroll
        for (int t = 0; t < 2; ++t)
#pragma unroll
            for (int r = 0; r < 16; ++r) stg[(32 * t + attn::crow(r, hi)) * 32 + r32] = f2bf(acc[t][r]);
        asm volatile("s_waitcnt lgkmcnt(0)" ::: "memory");
#pragma unroll
        for (int i = 0; i < 4; ++i) { const int rr = i * 16 + (lane >> 2), c4 = lane & 3; const v4u vv = *(const v4u*)(stg + rr * 32 + c4 * 8);
            *(v4u*)(MIX + (size_t)(b * 4096 + s1p + 64 * rr) * 1024 + 32 * w + c4 * 8) = vv; }
        asm volatile("s_waitcnt lgkmcnt(0)" ::: "memory");
    }
    __syncthreads();
}

namespace hta {
using bf16x8 = __attribute__((ext_vector_type(8))) short;
using s16x4  = __attribute__((ext_vector_type(4))) short;
using f32x16 = __attribute__((ext_vector_type(16))) float;
using u32x4  = __attribute__((ext_vector_type(4))) unsigned;
constexpr int NW = 8, QBLK = 32, KVBLK = 64, NSLOT = 3, SLOTV = 8192;
constexpr float LOG2E = 1.4426950408889634f;
template <int MODE> struct Cfg;
template <> struct Cfg<0> { static constexpr int KD = 96; };
template <> struct Cfg<1> { static constexpr int KD = 64; };
template <int KD> struct Lds { static constexpr int SLOTK = KD * 128, K = 0, V = NSLOT * SLOTK, WS = V + NSLOT * SLOTV, OST = WS + NW * 64 * 4, BYTES = OST + NW * 4096; };
__device__ __forceinline__ int crow(int r, int hi) { return (r & 3) + 8 * (r >> 2) + 4 * hi; }
#define SBAR() __builtin_amdgcn_sched_barrier(0)
__device__ __forceinline__ void glds16(const void* gsrc, unsigned lds_dst) { unsigned keep;
  asm volatile("s_mov_b32 %0, m0\n\ts_mov_b32 m0, %2\n\ts_nop 0\n\tglobal_load_lds_dwordx4 %1, off\n\ts_mov_b32 m0, %0" : "=&s"(keep) : "v"(gsrc), "s"(lds_dst) : "memory"); }
__device__ __forceinline__ float max3f(float a, float b, float c) { float r; asm("v_max3_f32 %0, %1, %2, %3" : "=v"(r) : "v"(a), "v"(b), "v"(c)); return r; }
__device__ __forceinline__ float max2f(float a, float b) { float r; asm("v_max_f32_e32 %0, %1, %2" : "=v"(r) : "v"(a), "v"(b)); return r; }
__device__ __forceinline__ float fadd_s(float a, float b) { float r; asm("v_add_f32_e32 %0, %1, %2" : "=v"(r) : "v"(a), "v"(b)); return r; }
__device__ __forceinline__ float fsub_s(float a, float b) { float r; asm("v_sub_f32_e32 %0, %1, %2" : "=v"(r) : "v"(a), "v"(b)); return r; }
typedef float f32x2_t __attribute__((ext_vector_type(2))); typedef __bf16 bf16x2_t __attribute__((ext_vector_type(2)));
__device__ __forceinline__ unsigned cvtpk_s(float lo, float hi) { f32x2_t v = {lo, hi}; bf16x2_t b = __builtin_convertvector(v, bf16x2_t); return __builtin_bit_cast(unsigned, b); }
#define WAIT_BAR(N) asm volatile("s_waitcnt vmcnt(" #N ") lgkmcnt(0)\n\ts_barrier" ::: "memory")
typedef __attribute__((address_space(3))) const char* lds_cptr;
typedef short v4i16_t __attribute__((ext_vector_type(4)));
__device__ __forceinline__ void kload2(bf16x8* kf, lds_cptr kp, int j) { kf[2 * j] = *(const __attribute__((address_space(3))) bf16x8*)(kp + j * 2048); kf[2 * j + 1] = *(const __attribute__((address_space(3))) bf16x8*)(kp + j * 2048 + 512); }
__device__ __forceinline__ s16x4 vtr(lds_cptr p) { return __builtin_bit_cast(s16x4, __builtin_amdgcn_ds_read_tr16_b64_v4i16((__attribute__((address_space(3))) v4i16_t*)p)); }
__device__ __forceinline__ float rowmax(const f32x16& p0, const f32x16& p1) {
  float a = max3f(p0[0], p0[1], p1[0]), b = max3f(p0[2], p0[3], p1[1]); a = max3f(a, p1[2], p1[3]);
#pragma unroll
  for (int r = 4; r < 16; r += 4) { a = max3f(a, p0[r], p0[r + 1]); b = max3f(b, p0[r + 2], p0[r + 3]); a = max3f(a, p1[r], p1[r + 1]); b = max3f(b, p1[r + 2], p1[r + 3]); }
  const float m = max2f(a, b);
  auto rr = __builtin_amdgcn_permlane32_swap(__float_as_uint(m), __float_as_uint(m), false, false);
  return max2f(__uint_as_float(rr[0]), __uint_as_float(rr[1]));
}
__device__ __forceinline__ void pv(f32x16* o, int vb, bf16x8 pa0, bf16x8 pa1, bf16x8 pa2, bf16x8 pa3) {
#pragma unroll
  for (int d0 = 0; d0 < 2; ++d0) { s16x4 lo[4], hi[4];
#pragma unroll
    for (int ks = 0; ks < 4; ++ks) {
      asm volatile("ds_read_b64_tr_b16 %0,%1 offset:%c2" : "=&v"(lo[ks]) : "v"(vb), "i"(d0 * 4096 + ks * 1024) : "memory");
      asm volatile("ds_read_b64_tr_b16 %0,%1 offset:%c2" : "=&v"(hi[ks]) : "v"(vb), "i"(d0 * 4096 + ks * 1024 + 512) : "memory"); }
    asm volatile("s_waitcnt lgkmcnt(0)" ::: "memory"); SBAR();
#define PK(k) (bf16x8){lo[k][0], lo[k][1], lo[k][2], lo[k][3], hi[k][0], hi[k][1], hi[k][2], hi[k][3]}
    o[d0] = __builtin_amdgcn_mfma_f32_32x32x16_bf16(pa0, PK(0), o[d0], 0, 0, 0);
    o[d0] = __builtin_amdgcn_mfma_f32_32x32x16_bf16(pa1, PK(1), o[d0], 0, 0, 0);
    o[d0] = __builtin_amdgcn_mfma_f32_32x32x16_bf16(pa2, PK(2), o[d0], 0, 0, 0);
    o[d0] = __builtin_amdgcn_mfma_f32_32x32x16_bf16(pa3, PK(3), o[d0], 0, 0, 0);
#undef PK
  }
}
__device__ __forceinline__ void wmask(f32x16& p0, f32x16& p1, int kbase, int qpos, int hi) {
  const float NEG = -INFINITY;
#pragma unroll
  for (int r = 0; r < 16; ++r) { const int k0 = kbase + crow(r, hi) - qpos, k1 = k0 + 32;
    if (k0 > 128 || k0 < -128) p0[r] = NEG;
    if (k1 > 128 || k1 < -128) p1[r] = NEG; }
}

template <int MODE, int THRL>
__device__ __forceinline__ void unit(const P& p, int l, bool isctx, int b, int h, int q0, char* shm) {
  constexpr int KD = Cfg<MODE>::KD, NS = KD / 16, SLOTK = Lds<KD>::SLOTK, LDS_K = Lds<KD>::K, LDS_V = Lds<KD>::V, LDS_WS = Lds<KD>::WS, LDS_OST = Lds<KD>::OST;
  const int tid = tidx(), lane = tid & 63, r32 = lane & 31, hi = lane >> 5; const int wid = __builtin_amdgcn_readfirstlane(tid >> 6);
  const int qrow0 = isctx ? ML + b * 256 : b * 4096 + q0;
  const int qrow = qrow0 + wid * QBLK + r32, qpos = q0 + wid * QBLK + r32;
  const int kvh = h / 3;
  int kstart = 0, NT;
  if (MODE == 0) NT = isctx ? 4 : 68;
  else { if (isctx) NT = 4; else { kstart = max(0, q0 - 128); const int kend = min(S, q0 + 384); NT = 4 + (kend - kstart) / 64; } }
#define RB(t) (isctx ? ML + b * 256 + (t) * 64 : (MODE == 0 ? ((t) < 64 ? b * 4096 + (t) * 64 : ML + b * 256 + ((t) - 64) * 64) : ((t) < 4 ? ML + b * 256 + (t) * 64 : b * 4096 + kstart + ((t) - 4) * 64)))
  const unsigned lds0 = (unsigned)(uintptr_t)shm;
  float* wsf = (float*)(shm + LDS_WS) + wid * 64;
  const bf16_t* ksrc = (MODE == 0 ? ws_kn(p) + (size_t)(h * 8 + wid) * 512 : ws_ks(p) + (size_t)(kvh * 8 + wid) * 512) + lane * 8;
  const bf16_t* ksrc2 = ws_kr(p) + (size_t)(wid & 3) * 512 + lane * 8;
  const bf16_t* vsrc = (MODE == 0 ? ws_vm(p) + (size_t)(h * 2 + (wid >> 2)) * 2048 : ws_vs(p) + (size_t)(kvh * 2 + (wid >> 2)) * 2048) + (wid & 3) * 512 + lane * 8;
  constexpr int NH = MODE == 0 ? 6 : 2;
  const unsigned kdst = lds0 + LDS_K + wid * 1024, kdst2 = lds0 + LDS_K + (8 + (wid & 3)) * 1024, vdst = lds0 + LDS_V + wid * 1024;
#define KSL(x) (KD == 96 ? (x) + ((x) >> 1) : (x))
#define DMA_K(t, slot) do { const int tl_ = RB(t) >> 6; glds16(ksrc + (size_t)tl_ * (NH * 8 * 512), (unsigned)__builtin_amdgcn_readfirstlane(kdst + KSL(slot))); \
    if (MODE == 0) glds16(ksrc2 + (size_t)tl_ * (4 * 512), (unsigned)__builtin_amdgcn_readfirstlane(kdst2 + KSL(slot))); } while (0)
#define DMA_V(t, slot) glds16(vsrc + (size_t)(RB(t) >> 6) * (NH * 2 * 2048), (unsigned)__builtin_amdgcn_readfirstlane(vdst + (slot)))
  const int vb0 = (int)(lds0 + LDS_V) + ((lane >> 4) & 1) * 32 + (lane & 3) * 8 + (4 * hi + ((lane & 15) >> 2)) * 64;
  bf16x8 kf[2 * NS];
  const lds_cptr shm3 = (lds_cptr)shm; const lds_cptr kp0 = shm3 + LDS_K + hi * 1024 + r32 * 16; const lds_cptr vp0 = shm3 + LDS_V + ((lane >> 4) & 1) * 32 + (lane & 3) * 8 + (4 * hi + ((lane & 15) >> 2)) * 64;
  DMA_K(0, 0); DMA_V(0, 0); DMA_K(1, SLOTV);
  bf16x8 qr[NS];
  if (MODE == 0) {
    const bf16_t* Qw = ws_qm(p) + (size_t)qrow * QMW + hi * 8;
#pragma unroll
    for (int d0 = 0; d0 < 4; ++d0) qr[d0] = *reinterpret_cast<const bf16x8*>(Qw + h * 64 + d0 * 16);
#pragma unroll
    for (int d0 = 4; d0 < NS; ++d0) qr[d0] = *reinterpret_cast<const bf16x8*>(Qw + 384 + h * 32 + (d0 - 4) * 16);
  } else {
    const bf16_t* Qw = ws_qs(p) + (size_t)qrow * 384 + h * 64 + hi * 8;
#pragma unroll
    for (int d0 = 0; d0 < NS; ++d0) qr[d0] = *reinterpret_cast<const bf16x8*>(Qw + d0 * 16);
  }
  float mhat = 0.f, l_reg = 0.f; f32x16 o[2]; o[0] = f32x16{}; o[1] = f32x16{}; f32x16 negm = f32x16{}; asm volatile("" : "+v"(negm));
#define CMASK(P0, P1, t) do { if (MODE == 1 && !isctx && (t) >= 4) { const int d_ = kstart + ((t) - 4) * 64 - (q0 + wid * QBLK); if (d_ < -97 || d_ > 65) wmask(P0, P1, kstart + ((t) - 4) * 64, qpos, hi); } } while (0)
  bool resc = false;
#define START(P0, P1) do { const float rm = rowmax(P0, P1); resc = false; \
    { const float dl = rm; mhat = fadd_s(mhat, dl); \
      _Pragma("unroll") for (int r = 0; r < 16; ++r) { P0[r] = fsub_s(P0[r], dl); P1[r] = fsub_s(P1[r], dl); } \
      _Pragma("unroll") for (int r = 0; r < 16; ++r) negm[r] = -mhat; asm volatile("" : "+v"(negm)); } \
    _Pragma("unroll") for (int r = 0; r < 16; ++r) P0[r] = __builtin_amdgcn_exp2f(P0[r]); } while (0)
#define RESC() do { if (resc) { asm volatile("s_waitcnt lgkmcnt(0)" ::: "memory"); \
      _Pragma("unroll") for (int d_ = 0; d_ < 2; ++d_) _Pragma("unroll") for (int r = 0; r < 16; ++r) o[d_][r] *= wsf[crow(r, hi)]; } } while (0)
  f32x16 pA0, pA1, pB0, pB1;
  int sl_prev = 0, sl_cur = 0, sl_next = SLOTV;
#define ROT() do { sl_prev = sl_cur; sl_cur = sl_next; sl_next = (sl_next == (NSLOT - 1) * SLOTV) ? 0 : sl_next + SLOTV; } while (0)
  DMA_K(2, 2 * SLOTV);
  WAIT_BAR(0);
  { const char* kb = shm + LDS_K + hi * 1024 + r32 * 16;
#pragma unroll
    for (int d0 = 0; d0 < NS; ++d0) {
      const bf16x8 b0 = *reinterpret_cast<const bf16x8*>(kb + d0 * 2048);
      const bf16x8 b1 = *reinterpret_cast<const bf16x8*>(kb + d0 * 2048 + 512);
      if (d0 == 0) { pA0 = __builtin_amdgcn_mfma_f32_32x32x16_bf16(b0, qr[0], negm, 0, 0, 0); pA1 = __builtin_amdgcn_mfma_f32_32x32x16_bf16(b1, qr[0], negm, 0, 0, 0); }
      else { pA0 = __builtin_amdgcn_mfma_f32_32x32x16_bf16(b0, qr[d0], pA0, 0, 0, 0); pA1 = __builtin_amdgcn_mfma_f32_32x32x16_bf16(b1, qr[d0], pA1, 0, 0, 0); } } }
  asm volatile("s_nop 15\n\ts_nop 7" : "+v"(pA0), "+v"(pA1)); CMASK(pA0, pA1, 0);
  START(pA0, pA1);
  _Pragma("unroll") for (int r = 0; r < 16; ++r) pA1[r] = __builtin_amdgcn_exp2f(pA1[r]);
  WAIT_BAR(0);
  DMA_K(3, 0); DMA_V(1, SLOTV);
  ROT();
#pragma unroll
  for (int j = 0; j < NS; ++j) kload2(kf, kp0 + KSL(sl_cur), j);
  if (MODE == 0) WAIT_BAR(3); else WAIT_BAR(2);
  s16x4 vlo[8], vhi[8]; u32x4 pw0, pw1, pw2, pw3;
#define PKW(P, B) cvtpk_s(P[B], P[B + 1])
#define PAF(k) __builtin_bit_cast(bf16x8, pw##k)
#define VFR(i) (bf16x8){vlo[i][0], vlo[i][1], vlo[i][2], vlo[i][3], vhi[i][0], vhi[i][1], vhi[i][2], vhi[i][3]}
#define PIN(x) asm volatile("" : "+v"(x))
#define MX3(a, b, c) __builtin_fmaxf(__builtin_fmaxf((a), (b)), (c))
#define PR(P, i) __builtin_shufflevector(P, P, i, (i) + 1)
#define GAPA(MF, PA, PB, W0, W1, PW) do { MF; s2 += PA; s2 += PB; PIN(s2); W0; W1; PIN(PW); SBAR(); } while (0)
#define GAPA1(MF, PA, W0, W1, PW) do { MF; s2 += PA; PIN(s2); W0; W1; PIN(PW); SBAR(); } while (0)
#define GAPA0(MF) do { MF; SBAR(); } while (0)
#define EX(v) __builtin_amdgcn_exp2f(v)
#define GAPB(MF, X, B) do { MF; X[B] = EX(X[B]); X[B + 1] = EX(X[B + 1]); X[B + 2] = EX(X[B + 2]); X[B + 3] = EX(X[B + 3]); PIN(X); SBAR(); } while (0)
#define VRD(i) do { vlo[i] = vtr(vp_ + (((i) >> 2) * 4096 + ((i) & 3) * 1024)); vhi[i] = vtr(vp_ + (((i) >> 2) * 4096 + ((i) & 3) * 1024 + 512)); } while (0)
#define KRD(G, j) do { if (G) { kload2(kf, kp0 + KSL(sl_next), j); SBAR(); } } while (0)
#define STEP(C0, C1, P0, P1, t, GK, GV, GL) do { SBAR(); \
    const lds_cptr vp_ = vp0 + sl_prev; \
    f32x2_t s2 = PR(P0, 0); \
    if constexpr (NS == 4) { VRD(0); SBAR(); \
    GAPA(C0 = __builtin_amdgcn_mfma_f32_32x32x16_bf16(kf[0], qr[0], negm, 0, 0, 0), PR(P0, 2), PR(P0, 4),     pw0[0] = PKW(P0, 0), pw0[1] = PKW(P0, 2), pw0); \
    VRD(4); SBAR(); GAPA(C1 = __builtin_amdgcn_mfma_f32_32x32x16_bf16(kf[1], qr[0], negm, 0, 0, 0), PR(P0, 6), PR(P0, 8),     pw0[2] = PKW(P0, 4), pw0[3] = PKW(P0, 6), pw0); \
    VRD(1); SBAR(); GAPA(C0 = __builtin_amdgcn_mfma_f32_32x32x16_bf16(kf[2], qr[1], C0, 0, 0, 0),   PR(P0, 10), PR(P0, 12), pw1[0] = PKW(P0, 8), pw1[1] = PKW(P0, 10), pw1); \
    VRD(5); SBAR(); GAPA(C1 = __builtin_amdgcn_mfma_f32_32x32x16_bf16(kf[3], qr[1], C1, 0, 0, 0),   PR(P0, 14), PR(P1, 0),   pw1[2] = PKW(P0, 12), pw1[3] = PKW(P0, 14), pw1); \
    VRD(2); SBAR(); GAPA(C0 = __builtin_amdgcn_mfma_f32_32x32x16_bf16(kf[4], qr[2], C0, 0, 0, 0),   PR(P1, 2), PR(P1, 4),     pw2[0] = PKW(P1, 0), pw2[1] = PKW(P1, 2), pw2); \
    VRD(6); SBAR(); GAPA(C1 = __builtin_amdgcn_mfma_f32_32x32x16_bf16(kf[5], qr[2], C1, 0, 0, 0),   PR(P1, 6), PR(P1, 8),     pw2[2] = PKW(P1, 4), pw2[3] = PKW(P1, 6), pw2); \
    VRD(3); SBAR(); GAPA(C0 = __builtin_amdgcn_mfma_f32_32x32x16_bf16(kf[6], qr[3], C0, 0, 0, 0),   PR(P1, 10), PR(P1, 12), pw3[0] = PKW(P1, 8), pw3[1] = PKW(P1, 10), pw3); \
    VRD(7); SBAR(); GAPA1(C1 = __builtin_amdgcn_mfma_f32_32x32x16_bf16(kf[7], qr[3], C1, 0, 0, 0),   PR(P1, 14),       pw3[2] = PKW(P1, 12), pw3[3] = PKW(P1, 14), pw3); \
    } else { \
    VRD(0); SBAR(); C0 = __builtin_amdgcn_mfma_f32_32x32x16_bf16(kf[0], qr[0], negm, 0, 0, 0); s2 += PR(P0, 2); PIN(s2); pw0[0] = PKW(P0, 0); pw0[1] = PKW(P0, 2); PIN(pw0); SBAR(); \
    VRD(4); SBAR(); C1 = __builtin_amdgcn_mfma_f32_32x32x16_bf16(kf[1], qr[0], negm, 0, 0, 0); s2 += PR(P0, 4); PIN(s2); pw0[2] = PKW(P0, 4); PIN(pw0); SBAR(); \
    C0 = __builtin_amdgcn_mfma_f32_32x32x16_bf16(kf[2], qr[1], C0, 0, 0, 0); s2 += PR(P0, 6); s2 += PR(P0, 8); PIN(s2); pw0[3] = PKW(P0, 6); PIN(pw0); SBAR(); \
    VRD(1); SBAR(); C1 = __builtin_amdgcn_mfma_f32_32x32x16_bf16(kf[3], qr[1], C1, 0, 0, 0); s2 += PR(P0, 10); PIN(s2); pw1[0] = PKW(P0, 8); pw1[1] = PKW(P0, 10); PIN(pw1); SBAR(); \
    VRD(5); SBAR(); C0 = __builtin_amdgcn_mfma_f32_32x32x16_bf16(kf[4], qr[2], C0, 0, 0, 0); s2 += PR(P0, 12); PIN(s2); pw1[2] = PKW(P0, 12); PIN(pw1); SBAR(); \
    C1 = __builtin_amdgcn_mfma_f32_32x32x16_bf16(kf[5], qr[2], C1, 0, 0, 0); s2 += PR(P0, 14); s2 += PR(P1, 0); PIN(s2); pw1[3] = PKW(P0, 14); PIN(pw1); SBAR(); \
    VRD(2); SBAR(); C0 = __builtin_amdgcn_mfma_f32_32x32x16_bf16(kf[6], qr[3], C0, 0, 0, 0); s2 += PR(P1, 2); PIN(s2); pw2[0] = PKW(P1, 0); pw2[1] = PKW(P1, 2); PIN(pw2); SBAR(); \
    VRD(6); SBAR(); C1 = __builtin_amdgcn_mfma_f32_32x32x16_bf16(kf[7], qr[3], C1, 0, 0, 0); s2 += PR(P1, 4); PIN(s2); pw2[2] = PKW(P1, 4); PIN(pw2); SBAR(); \
    C0 = __builtin_amdgcn_mfma_f32_32x32x16_bf16(kf[8], qr[4], C0, 0, 0, 0); s2 += PR(P1, 6); s2 += PR(P1, 8); PIN(s2); pw2[3] = PKW(P1, 6); PIN(pw2); SBAR(); \
    VRD(3); SBAR(); C1 = __builtin_amdgcn_mfma_f32_32x32x16_bf16(kf[9], qr[4], C1, 0, 0, 0); s2 += PR(P1, 10); PIN(s2); pw3[0] = PKW(P1, 8); pw3[1] = PKW(P1, 10); PIN(pw3); SBAR(); \
    VRD(7); SBAR(); C0 = __builtin_amdgcn_mfma_f32_32x32x16_bf16(kf[10], qr[5], C0, 0, 0, 0); s2 += PR(P1, 12); PIN(s2); pw3[2] = PKW(P1, 12); PIN(pw3); SBAR(); \
    C1 = __builtin_amdgcn_mfma_f32_32x32x16_bf16(kf[11], qr[5], C1, 0, 0, 0); s2 += PR(P1, 14); PIN(s2); pw3[3] = PKW(P1, 14); PIN(pw3); SBAR(); \
    } \
    l_reg += s2[0] + s2[1]; \
    if (GK) { DMA_K((t) + 3, sl_cur); } if (GV) { DMA_V((t) + 1, sl_next); } \
    CMASK(C0, C1, t); \
    { float a = MX3(C0[0], C0[1], C1[0]), b_ = MX3(C0[2], C0[3], C1[1]); a = MX3(a, C1[2], C1[3]); \
      _Pragma("unroll") for (int r = 4; r < 16; r += 4) { a = MX3(a, C0[r], C0[r + 1]); b_ = MX3(b_, C0[r + 2], C0[r + 3]); a = MX3(a, C1[r], C1[r + 1]); b_ = MX3(b_, C1[r + 2], C1[r + 3]); } \
      float rm = __builtin_fmaxf(a, b_); { auto rr = __builtin_amdgcn_permlane32_swap(__float_as_uint(rm), __float_as_uint(rm), false, false); rm = __builtin_fmaxf(__uint_as_float(rr[0]), __uint_as_float(rr[1])); } \
      resc = false; \
      if (__builtin_expect(__any(rm > (float)THRL), 0)) { const float dl = __builtin_fmaxf(rm, 0.f); mhat += dl; \
        _Pragma("unroll") for (int r = 0; r < 16; ++r) { C0[r] -= dl; C1[r] -= dl; } \
        _Pragma("unroll") for (int r = 0; r < 16; ++r) negm[r] = -mhat; asm volatile("" : "+v"(negm)); \
        const float f = __builtin_amdgcn_exp2f(-dl); l_reg *= f; if (hi == 0) wsf[r32] = f; resc = true; } } \
    SBAR(); \
    GAPB(o[0] = __builtin_amdgcn_mfma_f32_32x32x16_bf16(PAF(0), VFR(0), o[0], 0, 0, 0), C0, 0); \
    GAPB(o[1] = __builtin_amdgcn_mfma_f32_32x32x16_bf16(PAF(0), VFR(4), o[1], 0, 0, 0), C0, 4); \
    KRD(GL, 0); GAPB(o[0] = __builtin_amdgcn_mfma_f32_32x32x16_bf16(PAF(1), VFR(1), o[0], 0, 0, 0), C0, 8); \
    KRD(GL, 1); GAPB(o[1] = __builtin_amdgcn_mfma_f32_32x32x16_bf16(PAF(1), VFR(5), o[1], 0, 0, 0), C0, 12); \
    KRD(GL, 2); GAPB(o[0] = __builtin_amdgcn_mfma_f32_32x32x16_bf16(PAF(2), VFR(2), o[0], 0, 0, 0), C1, 0); \
    KRD(GL, 3); GAPB(o[1] = __builtin_amdgcn_mfma_f32_32x32x16_bf16(PAF(2), VFR(6), o[1], 0, 0, 0), C1, 4); \
    if constexpr (NS == 6) { KRD(GL, 4); } GAPB(o[0] = __builtin_amdgcn_mfma_f32_32x32x16_bf16(PAF(3), VFR(3), o[0], 0, 0, 0), C1, 8); \
    if constexpr (NS == 6) { KRD(GL, 5); } GAPB(o[1] = __builtin_amdgcn_mfma_f32_32x32x16_bf16(PAF(3), VFR(7), o[1], 0, 0, 0), C1, 12); \
    } while (0)
#define WB_FULL() do { if (MODE == 0) WAIT_BAR(3); else WAIT_BAR(2); } while (0)
  int t = 1;
  for (; t + 5 < NT; t += 2) {
    STEP(pB0, pB1, pA0, pA1, t, true, true, true);     WB_FULL(); RESC(); ROT();
    STEP(pA0, pA1, pB0, pB1, t + 1, true, true, true); WB_FULL(); RESC(); ROT();
  }
#define ENDW(tt) do { if ((tt) + 3 < NT) { WB_FULL(); } else if ((tt) + 2 < NT) { WAIT_BAR(1); } else { WAIT_BAR(0); } } while (0)
  for (; t + 1 < NT; t += 2) {
    STEP(pB0, pB1, pA0, pA1, t, (t + 3 < NT), (t + 1 < NT), (t + 1 < NT));       ENDW(t);     RESC(); ROT();
    STEP(pA0, pA1, pB0, pB1, t + 1, (t + 4 < NT), (t + 2 < NT), (t + 2 < NT));   ENDW(t + 1); RESC(); ROT();
  }
  STEP(pB0, pB1, pA0, pA1, NT - 1, false, false, false); RESC();
  { float sacc = pB0[0] + pB0[1]; _Pragma("unroll") for (int r = 2; r < 16; ++r) sacc += pB0[r]; _Pragma("unroll") for (int r = 0; r < 16; ++r) sacc += pB1[r]; l_reg += sacc;
    pw0 = (u32x4){PKW(pB0, 0), PKW(pB0, 2), PKW(pB0, 4), PKW(pB0, 6)}; pw1 = (u32x4){PKW(pB0, 8), PKW(pB0, 10), PKW(pB0, 12), PKW(pB0, 14)}; pw2 = (u32x4){PKW(pB1, 0), PKW(pB1, 2), PKW(pB1, 4), PKW(pB1, 6)}; pw3 = (u32x4){PKW(pB1, 8), PKW(pB1, 10), PKW(pB1, 12), PKW(pB1, 14)};
    SBAR(); pv(o, vb0 + sl_cur, PAF(0), PAF(1), PAF(2), PAF(3)); }
#undef PKW
#undef PAF
#undef VFR
#undef PIN
#undef MX3
#undef GAPA
#undef GAPA1
#undef PR
#undef GAPA0
#undef GAPB
#undef EX
#undef VRD
#undef KRD
#undef STEP
#undef ENDW
#undef WB_FULL
  { auto rr = __builtin_amdgcn_permlane32_swap(__float_as_uint(l_reg), __float_as_uint(l_reg), false, false); l_reg = __uint_as_float(rr[0]) + __uint_as_float(rr[1]); }
  if (MODE == 1) l_reg += __builtin_amdgcn_exp2f(p.sink[l * 6 + h] * LOG2E - mhat);
  if (hi == 0) wsf[32 + r32] = l_reg; asm volatile("s_waitcnt lgkmcnt(0)" ::: "memory");
  float rli[16];
#pragma unroll
  for (int r = 0; r < 16; ++r) rli[r] = __builtin_amdgcn_rcpf(wsf[32 + crow(r, hi)]);
  bf16_t* Ow = ws_mix(p) + (size_t)(qrow0 + wid * QBLK) * 1024 + (MODE == 0 ? 640 : 256) + h * 64;
  { bf16_t* stg = (bf16_t*)(shm + LDS_OST) + wid * 2048;
#pragma unroll
    for (int r = 0; r < 16; ++r) { const int orow = crow(r, hi);
#pragma unroll
      for (int d0 = 0; d0 < 2; ++d0) stg[orow * 64 + d0 * 32 + r32] = f2bf(o[d0][r] * rli[r]); }
    asm volatile("s_waitcnt lgkmcnt(0)" ::: "memory");
#pragma unroll
    for (int i = 0; i < 4; ++i) { const int row = i * 8 + (lane >> 3), ch = lane & 7; const u32x4 v = *(const u32x4*)(stg + row * 64 + ch * 8); *(u32x4*)(Ow + (size_t)row * 1024 + ch * 8) = v; } }
  asm volatile("s_waitcnt lgkmcnt(0)\n\ts_barrier" ::: "memory");
#undef DMA_K
#undef DMA_V
#undef KSL
#undef RB
#undef CMASK
#undef START
#undef RESC
#undef ROT
}
#undef SBAR
#undef WAIT_BAR
}

__device__ __forceinline__ void fp_attn(const P& p, int l, bool with_ctx, LAS unsigned char* lds, int bid, int nb) {
    const int n_lat = 8 * 6 * 16, n_ctx = with_ctx ? 8 * 6 : 0, per = n_lat + n_ctx;
    const int vcu = (nb % 8 == 0) ? (bid % 8) * (nb / 8) + bid / 8 : bid;
    for (int u = vcu; u < 2 * per; u += nb) {
        const int mode = u / per; int r = u % per;
        bool isctx = false; int b, h, q0;
        if (r < n_lat) { b = r / 96; const int r2 = r % 96; h = r2 / 16; q0 = (r2 % 16) * 256; }
        else { isctx = true; r -= n_lat; b = r / 6; h = r % 6; q0 = 0; }
        if (mode == 0) hta::unit<0, 8>(p, l, isctx, b, h, q0, (char*)lds);
        else hta::unit<1, 8>(p, l, isctx, b, h, q0, (char*)lds);
    }
}


__device__ __forceinline__ void fp_final(const P& p, int bid, int nb) {
    const int lane = tidx() & 63, gw = bid * 8 + (tidx() >> 6), nw = nb * 8;
    for (int row = gw; row < ML; row += nw) {
        const float pr = lane < 16 ? ws_rssh(p)[(size_t)row * 16 + lane] : 0.f;
        const float r = 1.0f / sqrtf(wave_sum(pr) * (1.0f / 1024.0f) + EPS);
        const v4u* x = (const v4u*)(ws_xn(p) + (size_t)row * 1024); f32x4* o = (f32x4*)(p.out + (size_t)row * D);
#pragma unroll
        for (int j = 0; j < 2; ++j) { const v4u w = x[lane + 64 * j];
            __builtin_nontemporal_store((f32x4){__uint_as_float(w.x << 16), __uint_as_float(w.x & 0xffff0000u), __uint_as_float(w.y << 16), __uint_as_float(w.y & 0xffff0000u)} * r, o + 2 * (lane + 64 * j));
            __builtin_nontemporal_store((f32x4){__uint_as_float(w.z << 16), __uint_as_float(w.z & 0xffff0000u), __uint_as_float(w.w << 16), __uint_as_float(w.w & 0xffff0000u)} * r, o + 2 * (lane + 64 * j) + 1); }
    }
}


struct CtxSplitOrder {
    int G, c;
    __device__ __forceinline__ bool next(int i, pg8::Unit& u) const { const int v = i * G + c; if (v >= 256) return false; const int t = v & 31, ks = v >> 5; u.pm = ML / 256 + (t >> 2); u.pn = t & 3; u.ko = ks * 512; return true; }
    __device__ __forceinline__ void a_ready(const pg8::Unit&) const {}
    __device__ __forceinline__ void done(const pg8::Unit&) const {}
};
struct EpiSlab {
    static constexpr bool PERM = true, AFTER_DRAIN = false; static constexpr bool DRAIN_AFTER = false;
    float* slab;
    __device__ __forceinline__ void operator()(const pg8::f32x4 (&acc)[2][2][4][2], const pg8::Unit& u, int wr, int wc, int fr, int fq) const {
        float* base = slab + (size_t)(u.ko >> 9) * MC * 1024 + u.pn * 256 + wc * 32 + 8 * fq;
#pragma unroll
        for (int ai = 0; ai < 2; ++ai)
#pragma unroll
            for (int m = 0; m < 4; ++m) {
                float* o = base + (size_t)(u.pm * 256 - ML + ai * 128 + wr * 64 + m * 16 + fr) * 1024;
#pragma unroll
                for (int bj = 0; bj < 2; ++bj) { *(pg8::f32x4*)(o + bj * 128) = acc[ai][bj][m][0]; *(pg8::f32x4*)(o + bj * 128 + 4) = acc[ai][bj][m][1]; }
            }
    }
};
__device__ __forceinline__ void fp_ctx_finalize(const P& p, int bid, int nb) {
    const int tid = tidx(), lane = tid & 63, gw = bid * 8 + (tid >> 6), NGW = nb * 8;
    const float* slab = (const float*)(p.ws + O_MIX);
    const float* gate = ws_mod(p) + (size_t)8 * 6144 + 5120; const float* gm = ws_gm(p, 1, 0) + 8 * 1024; const float* gmi = ws_gm(p, 0, 1) + 8 * 1024;
    for (int r = gw; r < MC; r += NGW) {
        bf16_t* xr = ws_xn(p) + (size_t)(ML + r) * 1024; float ss = 0.f;
#pragma unroll
        for (int j = 0; j < 4; ++j) {
            const int c = 4 * lane + 256 * j;
            f32x4 s = *(const f32x4*)(slab + (size_t)r * 1024 + c);
#pragma unroll
            for (int ks = 1; ks < 8; ++ks) s += *(const f32x4*)(slab + ((size_t)ks * MC + r) * 1024 + c);
            const v2u w_ = *(const v2u*)(xr + c); const f32x4 gi = *(const f32x4*)(gmi + c);
            const f32x4 ho = (f32x4){__uint_as_float(w_.x << 16) / gi.x, __uint_as_float(w_.x & 0xffff0000u) / gi.y, __uint_as_float(w_.y << 16) / gi.z, __uint_as_float(w_.y & 0xffff0000u) / gi.w};
            const f32x4 hn = ho + *(const f32x4*)(gate + c) * s;
            ss += (hn.x * hn.x + hn.y * hn.y) + (hn.z * hn.z + hn.w * hn.w);
            const f32x4 y = hn * *(const f32x4*)(gm + c);
            v2u w; w.x = pk2(y.x, y.y); w.y = pk2(y.z, y.w); *(v2u*)(xr + c) = w;
        }
        ss = wave_sum(ss);
        if (lane < 16) ws_rssh(p)[(size_t)(ML + r) * 16 + lane] = lane == 0 ? ss : 0.f;
    }
}
__device__ __forceinline__ void run_fast(const P& p_arg, int l, int ph, LAS unsigned char* lds, int bid, int nb) {
#if MEGA && defined(__HIP_DEVICE_COMPILE__)
    const __attribute__((address_space(4))) P* kp = (const __attribute__((address_space(4))) P*)__builtin_amdgcn_kernarg_segment_ptr();
    asm volatile("" : "+s"(kp));
    const P p = *kp;
#else
    const P& p = p_arg;
#endif
    const bool last = (l == DEPTH - 1);
    const int nrows = last ? ML : MT;
    switch (ph) {
        case 100: fp_mods(p, lds, bid, nb); fp_tables(p, bid, nb); fp_fftw(p, bid, nb); fp_weights(p, lds, bid, nb); break;
        case 112: fp_weights_in(p, lds, bid, nb); fp_gm(p, bid, nb); break;
        case 114: fp_bias(p, bid, nb); break;
        case 113: fp_final(p, bid, nb); break;
        case 110: fp_fft_a(p, !last, lds, bid, nb); break;
        case 111: fp_fft_b(p, lds, bid, nb); break;
        case 101: fp_xn(p, l, 0, MT, bid, nb); break;
        case 102: { pg8::Gemm g{ws_xn(p), ws_win_t(p, l), MT, NIN_PAD, 1024, 1024, 0}; pg8::StaticOrder S; S.init(MT, NIN_PAD, nb, bid);
                    EpiInproj E{ws_zf(p), ws_qs(p), ws_ks(p), ws_vs(p), ws_cq(p), ws_ckv(p), ws_kr(p), ws_rssq(p), ws_rsskv(p), ws_cosh(p), ws_sinh(p), ws_cosr(p), ws_sinr(p),
                                l == 0 ? nullptr : ws_rssh(p), ws_bias1(p)};
                    pg8::gemm_phase<EpiInproj, pg8::StaticOrder, true, true>(lds, g, S, E); } break;
        case 108: { pg8::Gemm g{ws_cq(p), ws_wuq_t(p, l), nrows, NUQ_PAD, 256, 256, 0}; pg8::StaticOrder S; S.init(nrows, NUQ_PAD, nb, bid);
                    EpiUpQ E{ws_qm(p), ws_rssq(p), ws_cosr(p), ws_sinr(p)}; pg8::gemm_phase<EpiUpQ, pg8::StaticOrder, true, true>(lds, g, S, E); } break;
        case 109: { pg8::Gemm g{ws_ckv(p), ws_wukv_t(p, l), MT, NUKV, 128, 128, 0}; pg8::StaticOrder S; S.init(MT, NUKV, nb, bid);
                    EpiUpKV E{ws_kn(p), ws_vm(p), ws_rsskv(p)}; pg8::gemm_phase<EpiUpKV, pg8::StaticOrder, true, true>(lds, g, S, E); } break;
        case 107: fp_attn(p, l, !last, lds, bid, nb); break;
        case 103: { pg8::Gemm g{ws_mix(p), ws_wout_t(p, l), nrows, 1024, 1024, 1024, 0}; pg8::StaticOrder S; S.init(nrows, 1024, nb, bid);
                    EpiResidA<false> E{nullptr, nullptr, ws_gm(p, 1, 0), nullptr, ws_mod(p) + (size_t)(l * 9) * 6144 + 2048, ws_gm(p, l, 1), ws_xn(p), ws_rssh(p)};
                    pg8::gemm_phase<EpiResidA<false>, pg8::StaticOrder, true, true>(lds, g, S, E); } break;
        case 119: { pg8::Gemm g{ws_mix(p), ws_wout_t(p, l), nrows, 1024, 1024, 1024, 0}; pg8::StaticOrder S; S.init(nrows, 1024, nb, bid);
                    EpiResidA<true> E{p.x, p.ctx, ws_gm(p, 1, 0), nullptr, ws_mod(p) + (size_t)(l * 9) * 6144 + 2048, ws_gm(p, l, 1), ws_xn(p), ws_rssh(p)};
                    pg8::gemm_phase<EpiResidA<true>, pg8::StaticOrder, true, true>(lds, g, S, E); } break;
        case 104: fp_xn(p, l, 1, nrows, bid, nb); break;
        case 105: { pg8::Gemm g{ws_xn(p), ws_w1_t(p, l), nrows, DFF, 1024, 1024, 0}; pg8::StaticOrder S; S.init(nrows, DFF, nb, bid);
                    EpiMlp1 E{ws_hid(p), ws_rssh(p), ws_bias2(p, l)}; pg8::gemm_phase<EpiMlp1, pg8::StaticOrder, true, true>(lds, g, S, E); } break;
        case 106: { const int mrows = ML;
                    pg8::Gemm g{ws_hid(p), ws_w2_t(p, l), mrows, 1024, DFF, DFF, 1}; pg8::StaticOrder S; S.init(mrows, 1024, nb, bid);
                    EpiResidA<false> E{nullptr, nullptr, ws_gm(p, l, 1), nullptr, ws_mod(p) + (size_t)(l * 9) * 6144 + 5120, last ? ws_gfin(p) : ws_gm(p, 1, 0), ws_xn(p), ws_rssh(p)};
                    pg8::gemm_phase<EpiResidA<false>, pg8::StaticOrder, true, true>(lds, g, S, E); } break;
        case 117: { pg8::Gemm g{ws_hid(p), ws_w2_t(p, 0), MT, 1024, 512, DFF, 1}; CtxSplitOrder S{nb, bid};
                    EpiSlab E{(float*)(p.ws + O_MIX)}; pg8::gemm_phase<EpiSlab, CtxSplitOrder, true, true>(lds, g, S, E); } break;
        case 118: fp_ctx_finalize(p, bid, nb); break;
    }
}
typedef GAS unsigned gu32;
#define RLX_AGENT __ATOMIC_RELAXED, __HIP_MEMORY_SCOPE_AGENT
#define XB_TMO      128
#define XB_XCNT(j)  (256  + 64 * (j))
#define XB_XSUB(j)  (1280 + 64 * (j))
#define XB_XGEN(j)  (2304 + 64 * (j))
#define XB_TOP      3328
#define XB_TOPGEN   3392
#define XCD_BAR_WORDS 3456
#define XB_SPIN_CAP (1u << 18)

__device__ __forceinline__ unsigned xb_ld(unsigned* p)              { return __hip_atomic_load(p, __ATOMIC_RELAXED, __HIP_MEMORY_SCOPE_AGENT); }
__device__ __forceinline__ unsigned xb_add(unsigned* p, unsigned v) { return __hip_atomic_fetch_add(p, v, __ATOMIC_RELAXED, __HIP_MEMORY_SCOPE_AGENT); }
__device__ __forceinline__ unsigned xb_xcc_id() { return (unsigned)__builtin_amdgcn_s_getreg((3 << 11) | 20) & 0xFu; }
#define XB_SPIN(cond, bar) do { unsigned _sp = 0; while (cond) { __builtin_amdgcn_s_sleep(1); \
    if ((++_sp & 255u) == 0u) { if (xb_ld(&(bar)[XB_TMO])) break; if (_sp > XB_SPIN_CAP) { atomicAdd(&(bar)[XB_TMO], 1u); break; } } } } while (0)

struct XcdBarrier {
    unsigned* bar; unsigned x;
    volatile LAS unsigned* st;
};

__device__ __forceinline__ XcdBarrier xcd_barrier_post(unsigned* bar, volatile LAS unsigned* st) {
    XcdBarrier b; b.bar = bar; b.x = xb_xcc_id(); b.st = st;
    if (threadIdx.x == 0) (void)xb_add(&bar[XB_XCNT(b.x)], 1u);
    return b;
}
__device__ __forceinline__ void xcd_barrier_complete(unsigned* bar, unsigned x, unsigned& nloc, unsigned& nx) {
    const unsigned G = gridDim.x * gridDim.y * gridDim.z;
    unsigned sum, cnt, mine, msk, sp = 0u;
    for (;;) {
        sum = 0u; cnt = 0u; mine = 0u; msk = 0u;
#pragma unroll
        for (unsigned j = 0; j < 16; ++j) { const unsigned c = xb_ld(&bar[XB_XCNT(j)]); sum += c; cnt += (c > 0u) ? 1u : 0u; msk |= (c > 0u) ? (1u << j) : 0u; mine = (j == x) ? c : mine; }
        if (sum == G) break;
        __builtin_amdgcn_s_sleep(1);
        if ((++sp & 255u) == 0u) { if (xb_ld(&bar[XB_TMO])) break; if (sp > XB_SPIN_CAP) { atomicAdd(&bar[XB_TMO], 1u); break; } }
    }
    nloc = mine > 0u ? mine : 1u; nx = msk != 0u ? msk : (1u << x);
}

__device__ __forceinline__ void xcd_barrier(const XcdBarrier& b) {
    asm volatile("s_waitcnt vmcnt(0)" ::: "memory");
    __syncthreads();
    if (threadIdx.x == 0) {
        unsigned* bar = b.bar;
        __builtin_amdgcn_s_waitcnt(0);
        unsigned nloc = b.st[0], nx = b.st[1];
        if (nloc == 0u) { xcd_barrier_complete(bar, b.x, nloc, nx); b.st[0] = nloc; b.st[1] = nx; }
        const unsigned old = xb_add(&bar[XB_XSUB(b.x)], 1u);
        const unsigned gen = old / nloc;
        if (old + 1u == (gen + 1u) * nloc) {
            __builtin_amdgcn_fence(__ATOMIC_RELEASE, "agent");
            asm volatile("s_waitcnt vmcnt(0)" ::: "memory");
            (void)xb_add(&bar[XB_XGEN(b.x)], 1u);
        }
        { unsigned sp_ = 0u;
          for (;;) {
              unsigned f[8], done = 0u;
#pragma unroll
              for (unsigned j = 0; j < 8; ++j) f[j] = xb_ld(&bar[XB_XGEN(j)]);
#pragma unroll
              for (unsigned j = 0; j < 8; ++j) done |= (f[j] > gen) ? (1u << j) : 0u;
              if (nx >> 8) {
#pragma unroll
                  for (unsigned j = 8; j < 16; ++j) f[j - 8] = xb_ld(&bar[XB_XGEN(j)]);
#pragma unroll
                  for (unsigned j = 8; j < 16; ++j) done |= (f[j - 8] > gen) ? (1u << j) : 0u;
              }
              if ((done & nx) == nx) break;
              __builtin_amdgcn_s_sleep(1);
              if ((++sp_ & 255u) == 0u) { if (xb_ld(&bar[XB_TMO])) break; if (sp_ > XB_SPIN_CAP) { atomicAdd(&bar[XB_TMO], 1u); break; } }
          } }
        __builtin_amdgcn_fence(__ATOMIC_ACQUIRE, "agent");
        asm volatile("s_waitcnt vmcnt(0)" ::: "memory");
    }
    __syncthreads();
}

#if MEGA
constexpr size_t O_CTL = 476 * MiB; constexpr size_t CTL_BYTES = 65536;
constexpr int LDS_MISC_OFF = 131072 + 320;
__device__ __forceinline__ void gsync(LAS unsigned char* lds) {
#if defined(__HIP_DEVICE_COMPILE__)
    const __attribute__((address_space(4))) P* kp = (const __attribute__((address_space(4))) P*)__builtin_amdgcn_kernarg_segment_ptr();
    asm volatile("" : "+s"(kp));
    XcdBarrier b; b.bar = (unsigned*)(kp->ws + O_CTL); b.x = xb_xcc_id(); b.st = (volatile LAS unsigned*)(lds + LDS_MISC_OFF) + 8;
    xcd_barrier(b);
    __builtin_amdgcn_s_waitcnt(0);
#endif
}
__global__ void __launch_bounds__(FAST_THREADS, 2) mega_kernel(P p) {
    extern __shared__ __attribute__((aligned(16))) unsigned char lds_raw[];
    LAS unsigned char* lds = (LAS unsigned char*)lds_raw;
    cg::grid_group grid = cg::this_grid();
    const int bid = blockIdx.x, nb = gridDim.x;
    volatile LAS unsigned* MISC = (volatile LAS unsigned*)(lds + LDS_MISC_OFF);
    if (threadIdx.x < 32) MISC[threadIdx.x] = 0u;
    __syncthreads();
    (void)xcd_barrier_post((unsigned*)(p.ws + O_CTL), MISC + 8);
#define PH(l, ph) do { run_fast(p, l, ph, lds, bid, nb); if (PROBE_PH == (ph)) { gsync(lds); run_fast(p, l, ph, lds, bid, nb); } } while (0)
#define GSYNC() gsync(lds)
    if (nb == 0x7fffffff) grid.sync();
    PH(0, 100); GSYNC();
    PH(0, 112); PH(0, 101); GSYNC();
#pragma unroll 1
    for (int l = 0; l < DEPTH; ++l) {
        PH(l, 102); GSYNC();
        PH(l, 108); PH(l, 109); PH(l, 110); if (l == 0) PH(l, 114); GSYNC();
        PH(l, 107); PH(l, 111); GSYNC();
        if (l == 0) PH(l, 119); else PH(l, 103);
        GSYNC();
        PH(l, 105); GSYNC();
        PH(l, 106); if (l == 0) PH(l, 117); GSYNC();
        if (l == 0) { PH(l, 118); GSYNC(); }
    }
    PH(0, 113);
}
#else
template <int PH> __global__ void __launch_bounds__(FAST_THREADS, 2) k_fast(P p, int l) {
    extern __shared__ __attribute__((aligned(16))) unsigned char lds_raw[];
    run_fast(p, l, PH, (LAS unsigned char*)lds_raw, blockIdx.x, gridDim.x);
}
#endif

extern "C" void kernel_launch(void* const* d_in, const int* in_sizes, int n_in, void* d_out, int out_size, void* d_ws, size_t ws_size, hipStream_t stream) {
    if (n_in != 19 || ws_size < WS_NEED) { fprintf(stderr, "kernel_launch: unexpected n_in %d / ws_size %zu\n", n_in, ws_size); return; }
    P p{};
    p.x = (const float*)d_in[0]; p.c = (const float*)d_in[1]; p.ctx = (const float*)d_in[2]; p.c_ctx = (const float*)d_in[3];
    p.w_ada = (const float*)d_in[4]; p.b_ada = (const float*)d_in[5]; p.n1g = (const float*)d_in[6]; p.n2g = (const float*)d_in[7];
    p.w_in = (const float*)d_in[8]; p.w_f = (const float*)d_in[9]; p.sink = (const float*)d_in[10]; p.qn_g = (const float*)d_in[11];
    p.w_uq = (const float*)d_in[12]; p.kvn_g = (const float*)d_in[13]; p.w_ukv = (const float*)d_in[14]; p.w_out = (const float*)d_in[15];
    p.w_mlp1 = (const float*)d_in[16]; p.w_mlp2 = (const float*)d_in[17]; p.fin_g = (const float*)d_in[18];
    p.out = (float*)d_out; p.ws = (unsigned char*)d_ws;
#if MEGA
    static int grid_blocks = 0;
    if (!grid_blocks) {
        if (hipFuncSetAttribute((const void*)mega_kernel, hipFuncAttributeMaxDynamicSharedMemorySize, FAST_LDS) != hipSuccess) { fprintf(stderr, "hipFuncSetAttribute failed\n"); return; }
        int dev = 0, cus = 0, per_cu = 0;
        hipGetDevice(&dev);
        hipDeviceGetAttribute(&cus, hipDeviceAttributeMultiprocessorCount, dev);
        hipOccupancyMaxActiveBlocksPerMultiprocessor(&per_cu, mega_kernel, FAST_THREADS, FAST_LDS);
        if (per_cu < 1) { fprintf(stderr, "occupancy query says %d blocks per CU\n", per_cu); return; }
        grid_blocks = cus;
    }
    if (hipMemsetAsync((char*)d_ws + O_CTL, 0, CTL_BYTES, stream) != hipSuccess) { fprintf(stderr, "hipMemsetAsync failed\n"); return; }
    void* args[] = {&p};
    hipError_t e = hipLaunchCooperativeKernel((void*)mega_kernel, dim3(grid_blocks), dim3(FAST_THREADS), args, FAST_LDS, stream);
    if (e != hipSuccess) fprintf(stderr, "cooperative launch failed: %s (grid %d)\n", hipGetErrorString(e), grid_blocks);
#else
    static int init = 0;
    if (!init) {
#define SETA(PH) if (hipFuncSetAttribute((const void*)k_fast<PH>, hipFuncAttributeMaxDynamicSharedMemorySize, FAST_LDS) != hipSuccess) { fprintf(stderr, "hipFuncSetAttribute failed\n"); return; }
        SETA(100) SETA(101) SETA(102) SETA(103) SETA(104) SETA(105) SETA(106) SETA(107) SETA(108) SETA(109) SETA(110) SETA(111) SETA(112) SETA(113) SETA(114) SETA(117) SETA(118) SETA(119)
        init = 1; }
    const int GF = 256;
#define FAST(l, ph) k_fast<ph><<<GF, FAST_THREADS, FAST_LDS, stream>>>(p, l)
    FAST(0, 100); FAST(0, 112);
    for (int l = 0; l < DEPTH; ++l) {
        if (l == 0) FAST(l, 101); FAST(l, 102); FAST(l, 108); FAST(l, 109); FAST(l, 110); if (l == 0) FAST(l, 114); FAST(l, 107); FAST(l, 111);
        if (l == 0) FAST(l, 119); else FAST(l, 103); FAST(l, 105); FAST(l, 106); if (l == 0) { FAST(l, 117); FAST(l, 118); }
    }
    FAST(0, 113);
#endif
}
```
